# Optimizing an MI355X kernel written in HIP

```python
import jax, jax.numpy as jnp
from jax import lax
import numpy as np

D_MODEL = 1024
BATCH = 4
SEQ = 4096
DEPTH = 1

PLE_DIM = 256
EPS = 1e-6
A_HEADS = 4
A_DK = 128
A_DV = 128
A_CONV = 4
A_CHUNK = 64
A_WIDTH = A_HEADS * A_DV
A_CONV_CH = 2 * A_HEADS * A_DK + A_WIDTH
B_HEADS = 8
B_KV_HEADS = 2
B_HD = 64
B_WIDTH = B_HEADS * B_HD
IDX_HEADS = 8
IDX_DIM = 128
TOPK_MAX = 256
Q_BLOCK = 128

MIX_WIDTH = A_WIDTH + B_WIDTH
IN_SIZES = (
    A_HEADS * A_DK,
    A_HEADS * A_DK,
    A_WIDTH,
    A_WIDTH,
    A_HEADS,
    A_HEADS,
    B_WIDTH,
    B_KV_HEADS * B_HD,
    B_KV_HEADS * B_HD,
    B_WIDTH,
    IDX_HEADS * IDX_DIM,
    IDX_DIM,
    IDX_HEADS,
)
IN_WIDTH = sum(IN_SIZES)
IN_OFFSETS = tuple(int(s) for s in np.cumsum(IN_SIZES)[:-1])

kernel_name = "hybrid_gdn_dsa_parallel_heads"


def rms_norm(x, gain):
    xf = x.astype(jnp.float32)
    y = xf * lax.rsqrt(jnp.mean(xf * xf, axis=-1, keepdims=True) + EPS)
    return (y * gain.astype(jnp.float32)).astype(x.dtype)


def l2_norm(x):
    return x * lax.rsqrt(jnp.sum(x * x, axis=-1, keepdims=True) + EPS)


def causal_dwconv(x, w):
    c = x.shape[-1]
    return lax.conv_general_dilated(
        x, w[:, None, :].astype(x.dtype), window_strides=(1,), padding=[(A_CONV - 1, 0)],
        dimension_numbers=('NWC', 'WIO', 'NWC'), feature_group_count=c)


def gated_delta_rule_chunked(q, k, v, g, beta):
    bn, seq_len, nh, dk = q.shape
    dv = v.shape[-1]
    c = A_CHUNK
    nc = seq_len // c

    def chunks(t):
        t = jnp.moveaxis(t, 2, 1)
        return t.reshape(bn, nh, nc, c, *t.shape[3:])

    q, k, v, g, beta = chunks(q), chunks(k), chunks(v), chunks(g), chunks(beta)
    g_cum = jnp.cumsum(g, axis=-1)
    tril = jnp.tril(jnp.ones((c, c), dtype=bool))
    strict = jnp.tril(jnp.ones((c, c), dtype=bool), -1)
    diff = g_cum[..., :, None] - g_cum[..., None, :]
    decay = jnp.where(tril, jnp.exp(jnp.where(tril, diff, 0.0)), 0.0)
    k_beta = k * beta[..., None]
    v_beta = v * beta[..., None]
    eye = jnp.eye(c, dtype=jnp.float32)
    kkt = jnp.einsum('bhncd,bhnsd->bhncs', k_beta, k) * decay
    a_mat = eye + jnp.where(strict, kkt, 0.0)
    t_mat = lax.linalg.triangular_solve(a_mat, jnp.broadcast_to(eye, a_mat.shape),
                                        left_side=True, lower=True, unit_diagonal=True)
    value = jnp.einsum('bhncs,bhnse->bhnce', t_mat, v_beta)
    k_cumdecay = jnp.einsum('bhncs,bhnsd->bhncd', t_mat, k_beta * jnp.exp(g_cum)[..., None])
    attn_intra = jnp.einsum('bhncd,bhnsd->bhncs', q, k) * decay
    q_decay = q * jnp.exp(g_cum)[..., None]
    k_decay = k * jnp.exp(g_cum[..., -1:] - g_cum)[..., None]
    g_last = jnp.exp(g_cum[..., -1])

    def step(state, inp):
        qd, kd, val, kcd, att, gl = inp
        v_new = val - jnp.einsum('bhcd,bhde->bhce', kcd, state)
        o = jnp.einsum('bhcd,bhde->bhce', qd, state) + jnp.einsum('bhcs,bhse->bhce', att, v_new)
        state = state * gl[..., None, None] + jnp.einsum('bhcd,bhce->bhde', kd, v_new)
        return state, o

    xs = tuple(jnp.moveaxis(t, 2, 0) for t in (q_decay, k_decay, value, k_cumdecay, attn_intra, g_last))
    s0 = jnp.zeros((bn, nh, dk, dv), jnp.float32)
    _, o = lax.scan(step, s0, xs)
    return o.transpose(1, 0, 3, 2, 4).reshape(bn, seq_len, nh, dv)


def dsa_sparse_attention(q, k, v, iq, ik, iw):
    bn, seq_len = q.shape[:2]
    n_sel = min(TOPK_MAX, seq_len // 4)
    n_blocks = seq_len // Q_BLOCK
    rep = B_HEADS // B_KV_HEADS
    qg = q.reshape(bn, seq_len, B_KV_HEADS, rep, B_HD)
    key_pos = jnp.arange(seq_len)
    scale = B_HD ** -0.5
    gather = jax.vmap(lambda tb, ib: tb[ib])

    def block(i):
        start = i * Q_BLOCK
        q_b = lax.dynamic_slice_in_dim(qg, start, Q_BLOCK, axis=1)
        iq_b = lax.dynamic_slice_in_dim(iq, start, Q_BLOCK, axis=1)
        iw_b = lax.dynamic_slice_in_dim(iw, start, Q_BLOCK, axis=1)
        q_pos = start + jnp.arange(Q_BLOCK)
        logits = jnp.einsum('bqhd,bsd->bqhs', iq_b, ik)
        score = jnp.einsum('bqh,bqhs->bqs', iw_b.astype(jnp.float32),
                           jax.nn.relu(logits.astype(jnp.float32)))
        causal = key_pos[None, :] <= q_pos[:, None]
        score = jnp.where(causal[None], score, -jnp.inf)
        _, idx = lax.top_k(score, n_sel)
        k_sel = gather(k, idx)
        v_sel = gather(v, idx)
        s = jnp.einsum('bqgrd,bqkgd->bqgrk', q_b, k_sel).astype(jnp.float32) * scale
        valid = idx <= q_pos[None, :, None]
        s = jnp.where(valid[:, :, None, None, :], s, -jnp.inf)
        prob = jax.nn.softmax(s, axis=-1).astype(v.dtype)
        o = jnp.einsum('bqgrk,bqkgd->bqgrd', prob, v_sel)
        return o.reshape(bn, Q_BLOCK, B_WIDTH)

    out = lax.map(block, jnp.arange(n_blocks))
    return out.transpose(1, 0, 2, 3).reshape(bn, seq_len, B_WIDTH)


def setup_inputs(seed: int = 0) -> dict:
    key = jax.random.key(seed)
    ks = jax.random.split(key, 16)
    f32 = jnp.float32
    x = jax.random.normal(ks[0], (BATCH, SEQ, D_MODEL), f32)
    p = jax.random.normal(ks[1], (DEPTH, BATCH, SEQ, PLE_DIM), f32)
    attn_norm_w = 1.0 + 0.02 * jax.random.normal(ks[2], (DEPTH, D_MODEL), f32)
    w_in = jax.random.normal(ks[3], (DEPTH, D_MODEL, IN_WIDTH), f32) * D_MODEL ** -0.5
    conv_w = jax.random.normal(ks[4], (DEPTH, A_CONV, A_CONV_CH), f32) * A_CONV ** -0.5
    a_log = jnp.log(jax.random.uniform(ks[5], (DEPTH, A_HEADS), f32, minval=1.0, maxval=16.0))
    dt = jnp.exp(jax.random.uniform(ks[6], (DEPTH, A_HEADS), f32,
                                    minval=float(np.log(1e-3)), maxval=float(np.log(1e-1))))
    dt_bias = dt + jnp.log(-jnp.expm1(-dt))
    a_out_norm_w = 1.0 + 0.02 * jax.random.normal(ks[7], (DEPTH, A_DV), f32)
    b_q_norm_w = 1.0 + 0.02 * jax.random.normal(ks[8], (DEPTH, B_HD), f32)
    b_k_norm_w = 1.0 + 0.02 * jax.random.normal(ks[9], (DEPTH, B_HD), f32)
    w_out = jax.random.normal(ks[10], (DEPTH, MIX_WIDTH, D_MODEL), f32) * MIX_WIDTH ** -0.5
    w_ple = jax.random.normal(ks[11], (DEPTH, PLE_DIM, D_MODEL), f32) * PLE_DIM ** -0.5
    ple_gate_norm_w = 1.0 + 0.02 * jax.random.normal(ks[12], (DEPTH, D_MODEL), f32)
    w_ple_gate = jax.random.normal(ks[13], (DEPTH, D_MODEL, D_MODEL), f32) * D_MODEL ** -0.5
    b_ple_gate = 0.01 * jax.random.normal(ks[14], (DEPTH, D_MODEL), f32)
    return {"x": x, "p": p, "attn_norm_w": attn_norm_w, "w_in": w_in, "conv_w": conv_w,
            "a_log": a_log, "dt_bias": dt_bias, "a_out_norm_w": a_out_norm_w,
            "b_q_norm_w": b_q_norm_w, "b_k_norm_w": b_k_norm_w, "w_out": w_out,
            "w_ple": w_ple, "ple_gate_norm_w": ple_gate_norm_w, "w_ple_gate": w_ple_gate,
            "b_ple_gate": b_ple_gate}


def reference(x, p, attn_norm_w, w_in, conv_w, a_log, dt_bias, a_out_norm_w, b_q_norm_w,
              b_k_norm_w, w_out, w_ple, ple_gate_norm_w, w_ple_gate, b_ple_gate):
    bn, seq_len, _ = x.shape
    f32 = jnp.float32
    for i in range(DEPTH):
        h = rms_norm(x, attn_norm_w[i])
        proj = h @ w_in[i]
        (a_q, a_k, a_v, a_z, a_b, a_a, b_q, b_k, b_v, b_z,
         i_q, i_k, i_w) = jnp.split(proj, IN_OFFSETS, axis=-1)

        qkv = jax.nn.silu(causal_dwconv(jnp.concatenate([a_q, a_k, a_v], axis=-1), conv_w[i]))
        aq, ak, av = jnp.split(qkv, (A_HEADS * A_DK, 2 * A_HEADS * A_DK), axis=-1)
        aq = l2_norm(aq.astype(f32).reshape(bn, seq_len, A_HEADS, A_DK)) * (A_DK ** -0.5)
        ak = l2_norm(ak.astype(f32).reshape(bn, seq_len, A_HEADS, A_DK))
        av = av.astype(f32).reshape(bn, seq_len, A_HEADS, A_DV)
        beta = jax.nn.sigmoid(a_b.astype(f32))
        g = -jnp.exp(a_log[i].astype(f32)) * jax.nn.softplus(a_a.astype(f32) + dt_bias[i].astype(f32))
        o_a = gated_delta_rule_chunked(aq, ak, av, g, beta)
        o_a = rms_norm(o_a, a_out_norm_w[i]).reshape(bn, seq_len, A_WIDTH).astype(x.dtype)
        o_a = o_a * jax.nn.silu(a_z)

        bq = rms_norm(b_q.reshape(bn, seq_len, B_HEADS, B_HD), b_q_norm_w[i])
        bk = rms_norm(b_k.reshape(bn, seq_len, B_KV_HEADS, B_HD), b_k_norm_w[i])
        bv = b_v.reshape(bn, seq_len, B_KV_HEADS, B_HD)
        iq = i_q.reshape(bn, seq_len, IDX_HEADS, IDX_DIM)
        iw = i_w * (IDX_HEADS ** -0.5 * IDX_DIM ** -0.5)
        o_b = dsa_sparse_attention(bq, bk, bv, iq, i_k, iw) * jax.nn.silu(b_z)

        x = x + jnp.concatenate([o_a, o_b], axis=-1) @ w_out[i]

        gate = jax.nn.sigmoid(rms_norm(x, ple_gate_norm_w[i]) @ w_ple_gate[i] + b_ple_gate[i])
        x = x + (p[i] @ w_ple[i]) * gate
    return x
```

```cpp
#include <hip/hip_runtime.h>
#include <hip/hip_cooperative_groups.h>
#include <cstdio>
namespace cg = cooperative_groups;

typedef unsigned short u16;
typedef unsigned int u32;
typedef unsigned long long u64;
using bf16x8 = __attribute__((ext_vector_type(8))) short;
using f32x16 = __attribute__((ext_vector_type(16))) float;
using f32x4 = __attribute__((ext_vector_type(4))) float;
using u32x4 = __attribute__((ext_vector_type(4))) unsigned;
#define DI __device__ __forceinline__
#define MFMA32(a, b, c) __builtin_amdgcn_mfma_f32_32x32x16_bf16((a), (b), (c), 0, 0, 0)
#define MFMA16(a, b, c) __builtin_amdgcn_mfma_f32_16x16x32_bf16((a), (b), (c), 0, 0, 0)

constexpr int T_ = 16384;
constexpr float EPS = 1e-6f;

constexpr size_t OFF_WT_IN = 0;
constexpr size_t OFF_WT_OUT = OFF_WT_IN + (size_t)4608 * 1024 * 2;
constexpr size_t OFF_WT_GATE = OFF_WT_OUT + (size_t)1024 * 1024 * 2;
constexpr size_t OFF_WT_PLE = OFF_WT_GATE + (size_t)1024 * 1024 * 2;
constexpr size_t OFF_PB = OFF_WT_PLE + (size_t)1024 * 256 * 2;
constexpr size_t OFF_SUMSQ = OFF_PB + (size_t)T_ * 256 * 2;
constexpr size_t OFF_QKV = OFF_SUMSQ + (size_t)T_ * 4;
constexpr size_t OFF_MIXA = OFF_QKV;
constexpr size_t OFF_AZ = OFF_QKV + (size_t)T_ * 1536 * 2;
constexpr size_t OFF_BQ = OFF_AZ + (size_t)T_ * 512 * 2;
constexpr size_t OFF_BKV = OFF_BQ + (size_t)T_ * 512 * 2;
constexpr size_t OFF_BZ = OFF_BKV + (size_t)T_ * 256 * 2;
constexpr size_t OFF_IQ = OFF_BZ + (size_t)T_ * 512 * 2;
constexpr size_t OFF_IK = OFF_IQ + (size_t)T_ * 1024 * 2;
constexpr size_t OFF_SMALL = OFF_IK + (size_t)T_ * 128 * 2;
constexpr size_t OFF_H = OFF_SMALL + (size_t)T_ * 16 * 4;
constexpr size_t OFF_WNEG = OFF_H;
constexpr size_t OFF_KDT = OFF_WNEG + (size_t)1024 * 8192 * 2;
constexpr size_t OFF_UT = OFF_H + (size_t)T_ * 1024 * 2;
constexpr size_t OFF_QD = OFF_UT + (size_t)1024 * 8192 * 2;
constexpr size_t OFF_ATT = OFF_QD + (size_t)1024 * 8192 * 2;
constexpr size_t OFF_GL = OFF_ATT + (size_t)1024 * 4096 * 2;
constexpr size_t OFF_BAR = OFF_GL + 4096;
constexpr size_t OFF_MIXB = OFF_BAR + 16384;
constexpr size_t WS_END = OFF_MIXB + (size_t)T_ * 512 * 2;
constexpr size_t OFF_X1 = OFF_AZ;
constexpr size_t OFF_X1B = OFF_X1 + (size_t)T_ * 1024 * 4;
static_assert(OFF_X1B + (size_t)T_ * 1024 * 2 <= OFF_UT, "x1 alias overlaps live data");
static_assert(WS_END <= (size_t)256 * 1024 * 1024, "ws too small");
constexpr size_t OOFF_HST = 0;
constexpr size_t OOFF_VNT = OOFF_HST + (size_t)1024 * 16384 * 2;
constexpr size_t OOFF_IDX = OOFF_VNT + (size_t)1024 * 8192 * 2;
static_assert(OOFF_IDX + (size_t)T_ * 256 * 2 <= (size_t)T_ * 1024 * 4, "d_out scratch");

constexpr int LDS_BYTES = 72 * 1024;

struct Params {
  const float *x, *p, *attn_norm_w, *w_in, *conv_w, *a_log, *dt_bias, *a_out_norm_w, *b_q_norm_w, *b_k_norm_w,
      *w_out, *w_ple, *ple_gate_norm_w, *w_ple_gate, *b_ple_gate;
  float* out;
  char* ws;
};

DI int otid() { int t = threadIdx.x; asm volatile("" : "+v"(t)); return t; }
DI float dpp_xor1(float v) { return __int_as_float(__builtin_amdgcn_update_dpp(0, __float_as_int(v), 0xB1, 0xF, 0xF, true)); }
DI float dpp_xor2(float v) { return __int_as_float(__builtin_amdgcn_update_dpp(0, __float_as_int(v), 0x4E, 0xF, 0xF, true)); }
DI float dpp_xor8(float v) { return __int_as_float(__builtin_amdgcn_update_dpp(0, __float_as_int(v), 0x128, 0xF, 0xF, true)); }
using u32x2 = __attribute__((ext_vector_type(2))) unsigned;
DI void nt_st1(void* p, u32 a) { __builtin_nontemporal_store(a, (u32*)p); }
DI void nt_st2(void* p, u32 a, u32 b) { u32x2 v = {a, b}; __builtin_nontemporal_store(v, (u32x2*)p); }
DI void nt_st4(void* p, uint4 o) { u32x4 v = {o.x, o.y, o.z, o.w}; __builtin_nontemporal_store(v, (u32x4*)p); }
DI u32x4 nt_ld4(const void* p) { return __builtin_nontemporal_load((const u32x4*)p); }
DI u16 f2bf(float x) { u32 u = __float_as_uint(x); u += 0x7fffu + ((u >> 16) & 1u); return (u16)(u >> 16); }
DI float bf2f(u16 v) { return __uint_as_float(((u32)v) << 16); }
DI u32 pack2(float a, float b) { return (u32)f2bf(a) | ((u32)f2bf(b) << 16); }
DI float bflo(u32 v) { return __uint_as_float(v << 16); }
DI float bfhi(u32 v) { return __uint_as_float(v & 0xffff0000u); }
DI float sigmoidf_(float x) { return 1.f / (1.f + __expf(-x)); }
DI float siluf_(float x) { return x / (1.f + __expf(-x)); }
DI f32x16 zero16() { f32x16 z; for (int i = 0; i < 16; ++i) z[i] = 0.f; return z; }
DI f32x4 zero4() { f32x4 z; for (int i = 0; i < 4; ++i) z[i] = 0.f; return z; }


#define XB_TMO      128
#define XB_XCNT(j)  (256  + 64 * (j))
#define XB_XSUB(j)  (1280 + 64 * (j))
#define XB_XGEN(j)  (2304 + 64 * (j))
#define XB_TOP      3328
#define XB_TOPGEN   3392
#define XCD_BAR_WORDS 3456
#define XB_SPIN_CAP (1u << 22)
#define LAS __attribute__((address_space(3)))
DI unsigned xb_ld(unsigned* p) { return __hip_atomic_load(p, __ATOMIC_RELAXED, __HIP_MEMORY_SCOPE_AGENT); }
DI unsigned xb_add(unsigned* p, unsigned v) { return __hip_atomic_fetch_add(p, v, __ATOMIC_RELAXED, __HIP_MEMORY_SCOPE_AGENT); }
DI unsigned xb_xcc_id() { return (unsigned)__builtin_amdgcn_s_getreg((3 << 11) | 20) & 0xFu; }
#define XB_SPIN(cond, bar) do { unsigned _sp = 0; while (cond) { __builtin_amdgcn_s_sleep(1); \
    if ((++_sp & 255u) == 0u) { if (xb_ld(&(bar)[XB_TMO])) break; if (_sp > XB_SPIN_CAP) { atomicAdd(&(bar)[XB_TMO], 1u); break; } } } } while (0)
struct XcdBarrier { unsigned* bar; unsigned x; volatile LAS unsigned* st; };
DI XcdBarrier xcd_barrier_post(unsigned* bar, volatile LAS unsigned* st) {
  XcdBarrier b; b.bar = bar; b.x = xb_xcc_id(); b.st = st;
  if (threadIdx.x == 0) (void)xb_add(&bar[XB_XCNT(b.x)], 1u);
  return b;
}
DI void xcd_barrier_complete(unsigned* bar, unsigned x, unsigned& nloc, unsigned& nx) {
  const unsigned G = gridDim.x * gridDim.y * gridDim.z;
  unsigned sum, cnt, mine, sp = 0u;
  for (;;) {
    sum = 0u; cnt = 0u; mine = 0u;
#pragma unroll
    for (unsigned j = 0; j < 16; ++j) { const unsigned c = xb_ld(&bar[XB_XCNT(j)]); sum += c; cnt += (c > 0u) ? 1u : 0u; mine = (j == x) ? c : mine; }
    if (sum == G) break;
    __builtin_amdgcn_s_sleep(1);
    if ((++sp & 255u) == 0u) { if (xb_ld(&bar[XB_TMO])) break; if (sp > XB_SPIN_CAP) { atomicAdd(&bar[XB_TMO], 1u); break; } }
  }
  nloc = mine > 0u ? mine : 1u; nx = cnt > 0u ? cnt : 1u;
}
DI void xcd_barrier(const XcdBarrier& b) {
  asm volatile("s_waitcnt vmcnt(0)" ::: "memory");
  __syncthreads();
  if (threadIdx.x == 0) {
    unsigned* bar = b.bar;
    __builtin_amdgcn_s_waitcnt(0);
    unsigned nloc = b.st[0], nx = b.st[1];
    if (nloc == 0u) { xcd_barrier_complete(bar, b.x, nloc, nx); b.st[0] = nloc; b.st[1] = nx; }
    const unsigned old = xb_add(&bar[XB_XSUB(b.x)], 1u);
    const unsigned gen = old / nloc;
    if (old + 1u == (gen + 1u) * nloc) {
      __builtin_amdgcn_fence(__ATOMIC_RELEASE, "agent");
      asm volatile("s_waitcnt vmcnt(0)" ::: "memory");
      const unsigned og = xb_add(&bar[XB_TOP], 1u);
      const unsigned tg = og / nx;
      if (og + 1u == (tg + 1u) * nx) xb_add(&bar[XB_TOPGEN], 1u);
      else XB_SPIN(xb_ld(&bar[XB_TOPGEN]) == tg, bar);
      __builtin_amdgcn_fence(__ATOMIC_ACQUIRE, "agent");
      xb_add(&bar[XB_XGEN(b.x)], 1u);
      asm volatile("s_waitcnt vmcnt(0)" ::: "memory");
    } else {
      XB_SPIN(xb_ld(&bar[XB_XGEN(b.x)]) == gen, bar);
      __builtin_amdgcn_fence(__ATOMIC_ACQUIRE, "agent");
      asm volatile("s_waitcnt vmcnt(0)" ::: "memory");
    }
  }
  __syncthreads();
}

template <bool SCALE>
DI void transpose_w(const float* __restrict__ W, int ldw, int K, int NP, int NV, u16* __restrict__ wt,
                    const float* __restrict__ scale, bool remap, size_t gtid, size_t gsz) {
  const int kchunks = K / 8;
  for (size_t it = gtid; it < (size_t)NP * kchunks; it += gsz) {
    int j = (int)(it % NP), kc = (int)(it / NP);
    uint4 o = make_uint4(0, 0, 0, 0);
    if (j < NV) {
      int src = j;
      if (remap) src = j < 2048 ? j : (j < 4480 ? j + 8 : (j < 4488 ? 2048 + (j - 4480) : j));
      float v[8];
#pragma unroll
      for (int i = 0; i < 8; ++i) {
        v[i] = W[(size_t)(kc * 8 + i) * ldw + src];
        if (SCALE) v[i] *= scale[kc * 8 + i];
      }
      o.x = pack2(v[0], v[1]); o.y = pack2(v[2], v[3]); o.z = pack2(v[4], v[5]); o.w = pack2(v[6], v[7]);
    }
    *(uint4*)(wt + (size_t)j * K + kc * 8) = o;
  }
}

DI void phase0(const Params& P) {
  const int tid = otid(), lane = tid & 63, wave = tid >> 6;
  const size_t gtid = (size_t)blockIdx.x * 256 + tid, gsz = (size_t)gridDim.x * 256;
  char* ws = P.ws;
  transpose_w<false>(P.w_in, 4496, 1024, 4608, 4496, (u16*)(ws + OFF_WT_IN), nullptr, true, gtid, gsz);
  transpose_w<false>(P.w_out, 1024, 1024, 1024, 1024, (u16*)(ws + OFF_WT_OUT), nullptr, false, gtid, gsz);
  transpose_w<true>(P.w_ple_gate, 1024, 1024, 1024, 1024, (u16*)(ws + OFF_WT_GATE), P.ple_gate_norm_w, false, gtid, gsz);
  transpose_w<false>(P.w_ple, 1024, 256, 1024, 1024, (u16*)(ws + OFF_WT_PLE), nullptr, false, gtid, gsz);
  {
    u16* pb = (u16*)(ws + OFF_PB);
    for (size_t it = gtid; it < (size_t)T_ * 256 / 8; it += gsz) {
      float4 a = *(const float4*)(P.p + it * 8), b = *(const float4*)(P.p + it * 8 + 4);
      uint4 o; o.x = pack2(a.x, a.y); o.y = pack2(a.z, a.w); o.z = pack2(b.x, b.y); o.w = pack2(b.z, b.w);
      *(uint4*)(pb + it * 8) = o;
    }
  }
  {
    float* ss = (float*)(ws + OFF_SUMSQ);
    for (size_t it = gtid; it < (size_t)T_; it += gsz) ss[it] = 0.f;
  }
  {
    u16* H = (u16*)(ws + OFF_H);
    const int gw = blockIdx.x * 4 + wave, nw = gridDim.x * 4;
    for (int row0 = gw * 4; row0 < T_; row0 += nw * 4) {
      float4 v[4][4];
#pragma unroll
      for (int rr = 0; rr < 4; ++rr)
#pragma unroll
        for (int i = 0; i < 4; ++i) v[rr][i] = *(const float4*)(P.x + (size_t)(row0 + rr) * 1024 + lane * 4 + 256 * i);
      float4 g[4];
#pragma unroll
      for (int i = 0; i < 4; ++i) g[i] = *(const float4*)(P.attn_norm_w + lane * 4 + 256 * i);
#pragma unroll
      for (int rr = 0; rr < 4; ++rr) {
        float ss = 0.f;
#pragma unroll
        for (int i = 0; i < 4; ++i) ss += v[rr][i].x * v[rr][i].x + v[rr][i].y * v[rr][i].y + v[rr][i].z * v[rr][i].z + v[rr][i].w * v[rr][i].w;
#pragma unroll
        for (int d = 1; d < 64; d <<= 1) ss += __shfl_xor(ss, d);
        const float r = rsqrtf(ss * (1.f / 1024.f) + EPS);
#pragma unroll
        for (int i = 0; i < 4; ++i) {
          uint2 o; o.x = pack2(v[rr][i].x * r * g[i].x, v[rr][i].y * r * g[i].y); o.y = pack2(v[rr][i].z * r * g[i].z, v[rr][i].w * r * g[i].w);
          *(uint2*)(H + (size_t)(row0 + rr) * 1024 + lane * 4 + 256 * i) = o;
        }
      }
    }
  }
}

template <int MT>
DI void gemm_mainloop(const u16* __restrict__ A, int lda, const u16* __restrict__ Bt, int ldb, int K, int m0, int n0,
                      char* lds, f32x16 (&acc)[MT][2]) {
  const int tid = otid(), lane = tid & 63, wave = tid >> 6;
  const int wm = wave & 1, wn = wave >> 1, l31 = lane & 31, hh = lane >> 5;
  constexpr int BM = 64 * MT;
  char* ldsA = lds;
  char* ldsB = lds + BM * 128;
  const int lrow = tid >> 3, kc = tid & 7;
  const u16* ga = A + (size_t)(m0 + lrow) * lda + kc * 8;
  const u16* gb = Bt + (size_t)(n0 + lrow) * ldb + kc * 8;
  u32x4 ra[2 * MT], rb[4];
#pragma unroll
  for (int i = 0; i < 2 * MT; ++i) ra[i] = *(const u32x4*)(ga + (size_t)(32 * i) * lda);
#pragma unroll
  for (int i = 0; i < 4; ++i) rb[i] = *(const u32x4*)(gb + (size_t)(32 * i) * ldb);
  const int woff = lrow * 128 + ((kc ^ ((lrow >> 1) & 7)) << 4);
  const int nk = K >> 6;
  for (int kt = 0; kt < nk; ++kt) {
    __syncthreads();
#pragma unroll
    for (int i = 0; i < 2 * MT; ++i) *(u32x4*)(ldsA + woff + i * 4096) = ra[i];
#pragma unroll
    for (int i = 0; i < 4; ++i) *(u32x4*)(ldsB + woff + i * 4096) = rb[i];
    __syncthreads();
    if (kt + 1 < nk) {
#pragma unroll
      for (int i = 0; i < 2 * MT; ++i) ra[i] = *(const u32x4*)(ga + (size_t)(32 * i) * lda + (kt + 1) * 64);
#pragma unroll
      for (int i = 0; i < 4; ++i) rb[i] = *(const u32x4*)(gb + (size_t)(32 * i) * ldb + (kt + 1) * 64);
    }
#pragma unroll
    for (int s = 0; s < 4; ++s) {
      bf16x8 af[MT], bfr[2];
      const int c = 2 * s + hh;
#pragma unroll
      for (int i = 0; i < MT; ++i) {
        int row = wm * (32 * MT) + i * 32 + l31;
        af[i] = *(const bf16x8*)(ldsA + row * 128 + ((c ^ ((row >> 1) & 7)) << 4));
      }
#pragma unroll
      for (int j = 0; j < 2; ++j) {
        int rowb = wn * 64 + j * 32 + l31;
        bfr[j] = *(const bf16x8*)(ldsB + rowb * 128 + ((c ^ ((rowb >> 1) & 7)) << 4));
      }
#pragma unroll
      for (int i = 0; i < MT; ++i)
#pragma unroll
        for (int j = 0; j < 2; ++j) acc[i][j] = MFMA32(af[i], bfr[j], acc[i][j]);
    }
  }
}

DI void phase1(const Params& P, char* lds) {
  char* ws = P.ws;
  const u16* H = (const u16*)(ws + OFF_H);
  const u16* WT = (const u16*)(ws + OFF_WT_IN);
  const int lane = otid() & 63, wave = otid() >> 6;
  const int wm = wave & 1, wn = wave >> 1, l31 = lane & 31, hh = lane >> 5;
  const bool xswz = (gridDim.x & 7) == 0;
  const int xq = blockIdx.x >> 3, xn = gridDim.x >> 3, xx = blockIdx.x & 7;
  for (int tile = xswz ? xq : (int)blockIdx.x; tile < (xswz ? 8 * 36 : 64 * 36); tile += (xswz ? xn : (int)gridDim.x)) {
    const int mt = xswz ? 8 * xx + (tile & 7) : tile / 36, nt = xswz ? (tile >> 3) : tile % 36;
    f32x16 acc[4][2];
#pragma unroll
    for (int i = 0; i < 4; ++i)
#pragma unroll
      for (int j = 0; j < 2; ++j) acc[i][j] = zero16();
    gemm_mainloop<4>(H, 1024, WT, 1024, 1024, mt * 256, nt * 128, lds, acc);
    const int n0 = nt * 128;
    if (n0 < 4480) {
      u16* base; int ld, c0;
      if (n0 < 1536) { base = (u16*)(ws + OFF_QKV); ld = 1536; c0 = n0; }
      else if (n0 < 2048) { base = (u16*)(ws + OFF_AZ); ld = 512; c0 = n0 - 1536; }
      else if (n0 < 2560) { base = (u16*)(ws + OFF_BQ); ld = 512; c0 = n0 - 2048; }
      else if (n0 < 2816) { base = (u16*)(ws + OFF_BKV); ld = 256; c0 = n0 - 2560; }
      else if (n0 < 3328) { base = (u16*)(ws + OFF_BZ); ld = 512; c0 = n0 - 2816; }
      else if (n0 < 4352) { base = (u16*)(ws + OFF_IQ); ld = 1024; c0 = n0 - 3328; }
      else { base = (u16*)(ws + OFF_IK); ld = 128; c0 = n0 - 4352; }
      const bool qn = (n0 >= 2048 && n0 < 2560), kn = (n0 == 2560);
      float w0 = 1.f, w1 = 1.f;
      if (qn) { w0 = P.b_q_norm_w[l31] * 0.125f; w1 = P.b_q_norm_w[32 + l31] * 0.125f; }
      if (kn) { w0 = P.b_k_norm_w[l31]; w1 = P.b_k_norm_w[32 + l31]; }
      const int rowbase = mt * 256 + wm * 128;
      char* p0; int rs, ts, c1;
      if (n0 == 4352) {
        const int ca = wn * 64 + l31;
        p0 = (char*)base + (size_t)(rowbase >> 5) * 8192 + hh * 64 + ((ca >> 4) * 512 + ((ca >> 3) & 1) * 256 + (ca & 7)) * 2;
        rs = 16; ts = 8192; c1 = 2048;
      } else {
        p0 = (char*)base + ((size_t)(rowbase + 4 * hh) * ld + c0 + wn * 64 + l31) * 2;
        rs = ld * 2; ts = 64 * ld; c1 = 64;
      }
#pragma unroll
      for (int i = 0; i < 4; ++i) {
        char* pr = p0 + (size_t)i * ts;
#pragma unroll
        for (int r = 0; r < 16; ++r) {
          float v0 = acc[i][0][r], v1 = acc[i][1][r];
          if (qn || kn) {
            float ss = v0 * v0 + v1 * v1;
            ss += dpp_xor1(ss); ss += dpp_xor2(ss); ss += __shfl_xor(ss, 4); ss += dpp_xor8(ss); ss += __shfl_xor(ss, 16);
            const float rsq = rsqrtf(ss * (1.f / 64.f) + EPS);
            v0 *= rsq * w0; v1 *= rsq * w1;
          }
          *(u16*)pr = f2bf(v0);
          *(u16*)(pr + c1) = f2bf(v1);
          pr += ((r & 3) == 3) ? 5 * rs : rs;
          asm volatile("" : "+v"(pr));
        }
      }
    } else {
      if (wn == 0 && l31 < 16) {
        float* sp = (float*)(ws + OFF_SMALL) + (size_t)(mt * 256 + wm * 128 + 4 * hh) * 16 + l31;
#pragma unroll
        for (int i = 0; i < 4; ++i)
#pragma unroll
          for (int r = 0; r < 16; ++r) {
            *sp = acc[i][0][r];
            sp += ((r & 3) == 3) ? 5 * 16 : 16;
            asm volatile("" : "+v"(sp));
          }
      }
    }
  }
}

DI void knorm_all(const Params& P) {
  const int lane = otid() & 63, wave = otid() >> 6;
  u32* BKV = (u32*)(P.ws + OFF_BKV);
  const int gw = blockIdx.x * 4 + wave, nw = gridDim.x * 4;
  const float w0 = P.b_k_norm_w[(2 * lane) & 63], w1 = P.b_k_norm_w[(2 * lane + 1) & 63];
  for (int tok = gw; tok < T_; tok += nw) {
    u32 v = BKV[(size_t)tok * 128 + lane];
    float a = bflo(v), b = bfhi(v);
    float ss = a * a + b * b;
#pragma unroll
    for (int d = 1; d < 32; d <<= 1) ss += __shfl_xor(ss, d);
    float r = rsqrtf(ss * (1.f / 64.f) + EPS);
    BKV[(size_t)tok * 128 + lane] = pack2(a * r * w0, b * r * w1);
  }
}

DI int perm16(int x) { return (x & 3) | ((x & 8) >> 1) | ((x & 4) << 1); }

DI void ka1_item(const Params& P, int ch, char* lds) {
  const int tid = otid(), lane = tid & 63, wave = tid >> 6, hh = lane >> 5, l31 = lane & 31;
  const int b = ch >> 8, h = (ch >> 6) & 3, n = ch & 63;
  const int tok0 = b * 4096 + n * 64;
  char* ws = P.ws;
  u16* QV = (u16*)lds;
  u16* Ks = (u16*)(lds + 18432);
  u16* KBT = (u16*)(lds + 18432 + 17408);
  float* Am = (float*)(lds + 18432 + 17408 + 18432);
  u16* Tm = Ks;
  float* sm = (float*)(lds + 18432 + 17408 + 18432 + 16384);
  const u16* QKV = (const u16*)(ws + OFF_QKV);
  const float* SMALL = (const float*)(ws + OFF_SMALL);
  u16* QD = (u16*)(ws + OFF_QD) + (size_t)ch * 8192;
  u16* ATT = (u16*)(ws + OFF_ATT) + (size_t)ch * 4096;
  u16* KDT = (u16*)(ws + OFF_KDT) + (size_t)ch * 8192;
  u16* WNEG = (u16*)(ws + OFF_WNEG) + (size_t)ch * 8192;
  u16* UT = (u16*)(ws + OFF_UT) + (size_t)ch * 8192;
  __syncthreads();
  if (wave == 0) {
    float ab = SMALL[(size_t)(tok0 + lane) * 16 + h];
    float aa = SMALL[(size_t)(tok0 + lane) * 16 + 4 + h];
    float beta = sigmoidf_(ab);
    float xs = aa + P.dt_bias[h];
    float sp = fmaxf(xs, 0.f) + log1pf(__expf(-fabsf(xs)));
    float g = -__expf(P.a_log[h]) * sp;
#pragma unroll
    for (int d = 1; d < 64; d <<= 1) { float t = __shfl_up(g, d); if (lane >= d) g += t; }
    float glast = __shfl(g, 63);
    sm[lane] = g; sm[64 + lane] = beta; sm[128 + lane] = __expf(g); sm[192 + lane] = __expf(glast - g);
  }
  __syncthreads();
  const float* cw = P.conv_w;
  {
    const int cq = h * 128 + 2 * lane, ck = 512 + cq;
    float wq[4][2], wk[4][2];
#pragma unroll
    for (int j = 0; j < 4; ++j) {
      wq[j][0] = cw[j * 1536 + cq]; wq[j][1] = cw[j * 1536 + cq + 1];
      wk[j][0] = cw[j * 1536 + ck]; wk[j][1] = cw[j * 1536 + ck + 1];
    }
    const int i0 = wave * 16;
    float xq[3][2], xk[3][2];
#pragma unroll
    for (int j = 0; j < 3; ++j) {
      int pos = n * 64 + i0 - 3 + j;
      u32 vq = 0, vk = 0;
      if (pos >= 0) {
        const u16* rp = QKV + (size_t)(tok0 + i0 - 3 + j) * 1536;
        vq = *(const u32*)(rp + cq); vk = *(const u32*)(rp + ck);
      }
      xq[j][0] = bflo(vq); xq[j][1] = bfhi(vq); xk[j][0] = bflo(vk); xk[j][1] = bfhi(vk);
    }
    u32 rq_[16], rk_[16];
#pragma unroll
    for (int ii = 0; ii < 16; ++ii) {
      const u16* rp = QKV + (size_t)(tok0 + i0 + ii) * 1536;
      rq_[ii] = *(const u32*)(rp + cq); rk_[ii] = *(const u32*)(rp + ck);
    }
#pragma unroll
    for (int ii = 0; ii < 16; ++ii) {
      const int i = i0 + ii;
      const u32 vq = rq_[ii], vk = rk_[ii];
      float cq0 = bflo(vq), cq1 = bfhi(vq), ck0 = bflo(vk), ck1 = bfhi(vk);
      float yq0 = wq[0][0] * xq[0][0] + wq[1][0] * xq[1][0] + wq[2][0] * xq[2][0] + wq[3][0] * cq0;
      float yq1 = wq[0][1] * xq[0][1] + wq[1][1] * xq[1][1] + wq[2][1] * xq[2][1] + wq[3][1] * cq1;
      float yk0 = wk[0][0] * xk[0][0] + wk[1][0] * xk[1][0] + wk[2][0] * xk[2][0] + wk[3][0] * ck0;
      float yk1 = wk[0][1] * xk[0][1] + wk[1][1] * xk[1][1] + wk[2][1] * xk[2][1] + wk[3][1] * ck1;
      xq[0][0] = xq[1][0]; xq[0][1] = xq[1][1]; xq[1][0] = xq[2][0]; xq[1][1] = xq[2][1]; xq[2][0] = cq0; xq[2][1] = cq1;
      xk[0][0] = xk[1][0]; xk[0][1] = xk[1][1]; xk[1][0] = xk[2][0]; xk[1][1] = xk[2][1]; xk[2][0] = ck0; xk[2][1] = ck1;
      yq0 = siluf_(yq0); yq1 = siluf_(yq1); yk0 = siluf_(yk0); yk1 = siluf_(yk1);
      float sq = yq0 * yq0 + yq1 * yq1, sk = yk0 * yk0 + yk1 * yk1;
#pragma unroll
      for (int d = 1; d < 64; d <<= 1) { sq += __shfl_xor(sq, d); sk += __shfl_xor(sk, d); }
      const float rq = rsqrtf(sq + EPS) * 0.08838834764831845f, rk = rsqrtf(sk + EPS);
      yq0 *= rq; yq1 *= rq; yk0 *= rk; yk1 *= rk;
      *(u32*)(QV + i * 136 + 2 * lane) = pack2(yq0, yq1);
      *(u32*)(Ks + i * 136 + 2 * lane) = pack2(yk0, yk1);
      KBT[(2 * lane) * 72 + i] = f2bf(yk0);
      KBT[(2 * lane + 1) * 72 + i] = f2bf(yk1);
      const float eg = sm[128 + i];
      nt_st1(QD + i * 128 + 2 * lane, pack2(yq0 * eg, yq1 * eg));
    }
  }
  __syncthreads();
  {
    const int mt = wave & 1, nt = wave >> 1;
    f32x16 akk = zero16(), aqk = zero16();
#pragma unroll
    for (int s = 0; s < 8; ++s) {
      const int kof = 16 * s + 8 * hh;
      bf16x8 aq = *(const bf16x8*)(QV + (32 * mt + l31) * 136 + kof);
      bf16x8 ak = *(const bf16x8*)(Ks + (32 * mt + l31) * 136 + kof);
      bf16x8 bk = *(const bf16x8*)(Ks + (32 * nt + l31) * 136 + kof);
      akk = MFMA32(ak, bk, akk);
      aqk = MFMA32(aq, bk, aqk);
    }
    const int j = 32 * nt + l31;
    const float gj = sm[j];
#pragma unroll
    for (int r = 0; r < 16; ++r) {
      const int i = 32 * mt + (r & 3) + 8 * (r >> 2) + 4 * hh;
      const float gi = sm[i], bi = sm[64 + i];
      const float dec = (j <= i) ? __expf(gi - gj) : 0.f;
      Am[i * 64 + j] = (j < i) ? bi * akk[r] * dec : 0.f;
      ATT[i * 64 + j] = f2bf(aqk[r] * dec);
    }
  }
  {
    const int dk = tid >> 1, th = tid & 1;
    u16* kr = KBT + dk * 72 + th * 32;
#pragma unroll
    for (int g2 = 0; g2 < 2; ++g2) {
      u16 ov[16];
#pragma unroll
      for (int x = 0; x < 16; ++x) {
        const int tok = th * 32 + g2 * 16 + x;
        const float kv = bf2f(kr[g2 * 16 + x]);
        ov[perm16(x)] = f2bf(kv * sm[192 + tok]);
        kr[g2 * 16 + x] = f2bf(kv * sm[64 + tok] * sm[128 + tok]);
      }
      uint4 o0, o1;
      o0.x = ov[0] | ((u32)ov[1] << 16); o0.y = ov[2] | ((u32)ov[3] << 16); o0.z = ov[4] | ((u32)ov[5] << 16); o0.w = ov[6] | ((u32)ov[7] << 16);
      o1.x = ov[8] | ((u32)ov[9] << 16); o1.y = ov[10] | ((u32)ov[11] << 16); o1.z = ov[12] | ((u32)ov[13] << 16); o1.w = ov[14] | ((u32)ov[15] << 16);
      nt_st4(KDT + dk * 64 + th * 32 + g2 * 16, o0);
      nt_st4(KDT + dk * 64 + th * 32 + g2 * 16 + 8, o1);
    }
  }
  __syncthreads();
  {
    u16* VBT = QV;
    const int cv = 1024 + h * 128 + 2 * lane;
    float wv[4][2];
#pragma unroll
    for (int j = 0; j < 4; ++j) { wv[j][0] = cw[j * 1536 + cv]; wv[j][1] = cw[j * 1536 + cv + 1]; }
    const int i0 = wave * 16;
    float xv[3][2];
#pragma unroll
    for (int j = 0; j < 3; ++j) {
      int pos = n * 64 + i0 - 3 + j;
      u32 vv = 0;
      if (pos >= 0) vv = *(const u32*)(QKV + (size_t)(tok0 + i0 - 3 + j) * 1536 + cv);
      xv[j][0] = bflo(vv); xv[j][1] = bfhi(vv);
    }
    u32 rv_[16];
#pragma unroll
    for (int ii = 0; ii < 16; ++ii) rv_[ii] = *(const u32*)(QKV + (size_t)(tok0 + i0 + ii) * 1536 + cv);
#pragma unroll
    for (int ii = 0; ii < 16; ++ii) {
      const int i = i0 + ii;
      const u32 vv = rv_[ii];
      float c0 = bflo(vv), c1 = bfhi(vv);
      float y0 = wv[0][0] * xv[0][0] + wv[1][0] * xv[1][0] + wv[2][0] * xv[2][0] + wv[3][0] * c0;
      float y1 = wv[0][1] * xv[0][1] + wv[1][1] * xv[1][1] + wv[2][1] * xv[2][1] + wv[3][1] * c1;
      xv[0][0] = xv[1][0]; xv[0][1] = xv[1][1]; xv[1][0] = xv[2][0]; xv[1][1] = xv[2][1]; xv[2][0] = c0; xv[2][1] = c1;
      const float bi = sm[64 + i];
      VBT[(2 * lane) * 72 + i] = f2bf(siluf_(y0) * bi);
      VBT[(2 * lane + 1) * 72 + i] = f2bf(siluf_(y1) * bi);
    }
  }
  if (wave == 0) {
    float Tc[63];
#pragma unroll
    for (int i = 0; i < 64; ++i) {
      float a = (i == lane) ? 1.f : 0.f;
#pragma unroll
      for (int j = 0; j < i; ++j) a -= Am[i * 64 + j] * Tc[j];
      if (i < 63) Tc[i] = a;
      Tm[i * 72 + lane] = f2bf(a);
      if ((i & 3) == 3) __builtin_amdgcn_sched_barrier(0);
    }
  }
  __syncthreads();
  {
    const u16* VBT = QV;
    f32x16 c0 = zero16(), c1 = zero16(), d0 = zero16(), d1 = zero16();
#pragma unroll
    for (int s = 0; s < 4; ++s) {
      const int kof = 16 * s + 8 * hh;
      bf16x8 t0 = *(const bf16x8*)(Tm + l31 * 72 + kof);
      bf16x8 t1 = *(const bf16x8*)(Tm + (32 + l31) * 72 + kof);
      bf16x8 a = *(const bf16x8*)(KBT + (32 * wave + l31) * 72 + kof);
      bf16x8 bv = *(const bf16x8*)(VBT + (32 * wave + l31) * 72 + kof);
      c0 = MFMA32(a, t0, c0);
      c1 = MFMA32(a, t1, c1);
      d0 = MFMA32(t0, bv, d0);
      d1 = MFMA32(t1, bv, d1);
    }
#pragma unroll
    for (int rg = 0; rg < 4; ++rg) {
      const int dkpos = 16 * (2 * wave + (rg >> 1)) + 8 * hh + 4 * (rg & 1);
      uint2 o;
      o.x = pack2(-c0[4 * rg], -c0[4 * rg + 1]); o.y = pack2(-c0[4 * rg + 2], -c0[4 * rg + 3]);
      nt_st2(WNEG + (l31) * 128 + dkpos, o.x, o.y);
      o.x = pack2(-c1[4 * rg], -c1[4 * rg + 1]); o.y = pack2(-c1[4 * rg + 2], -c1[4 * rg + 3]);
      nt_st2(WNEG + (32 + l31) * 128 + dkpos, o.x, o.y);
      const int dv = 32 * wave + l31;
      o.x = pack2(d0[4 * rg], d0[4 * rg + 1]); o.y = pack2(d0[4 * rg + 2], d0[4 * rg + 3]);
      nt_st2(UT + rg * 1024 + dv * 8 + 4 * hh, o.x, o.y);
      o.x = pack2(d1[4 * rg], d1[4 * rg + 1]); o.y = pack2(d1[4 * rg + 2], d1[4 * rg + 3]);
      nt_st2(UT + (4 + rg) * 1024 + dv * 8 + 4 * hh, o.x, o.y);
    }
    if (tid == 0) ((float*)(ws + OFF_GL))[ch] = sm[128 + 63];
  }
}

#define ATT_UNROLL 4
typedef __bf16 bf2_t __attribute__((ext_vector_type(2)));
DI float fdot2(u32 a, u32 b, float c) { return __builtin_amdgcn_fdot2_f32_bf16(__builtin_bit_cast(bf2_t, a), __builtin_bit_cast(bf2_t, b), c, false); }
DI float dot8(const uint4& k, const u32* q, float acc) {
  acc = fdot2(k.x, q[0], acc);
  acc = fdot2(k.y, q[1], acc);
  acc = fdot2(k.z, q[2], acc);
  acc = fdot2(k.w, q[3], acc);
  return acc;
}

DI void kb2_query(const Params& P, int t, float* Sw, const u16* idxp) {
  const int lane = otid() & 63;
  char* ws = P.ws;
  const int b = t >> 12, pos = t & 4095;
  const int nvalid = pos + 1 < 256 ? pos + 1 : 256;
  const bool uselist = pos >= 255;
  const u16* BKVb = (const u16*)(ws + OFF_BKV) + (size_t)b * 4096 * 256;
  float inv;
  {
    const int l15 = lane & 15, g4 = lane >> 4;
    bf16x8 qf[4];
    {
      const u16* qrow = (const u16*)(ws + OFF_BQ) + (size_t)t * 512;
#pragma unroll
      for (int s = 0; s < 4; ++s) {
        bf16x8 z = {0, 0, 0, 0, 0, 0, 0, 0};
        if (l15 < 8 && (l15 >> 2) == (s >> 1)) z = *(const bf16x8*)(qrow + l15 * 64 + 32 * (s & 1) + 8 * g4);
        qf[s] = z;
      }
    }
    float sum = 0.f;
#pragma unroll 4
    for (int tau = 0; tau < 16; ++tau) {
      const int slotA = 16 * tau + l15;
      int kidx = uselist ? (int)idxp[slotA] : slotA;
      if (slotA >= nvalid) kidx = 0;
      const u16* row = BKVb + (size_t)kidx * 256 + 8 * g4;
      bf16x8 ka[4];
#pragma unroll
      for (int s = 0; s < 4; ++s) ka[s] = *(const bf16x8*)(row + 32 * s);
      f32x4 c = zero4();
#pragma unroll
      for (int s = 0; s < 4; ++s) c = MFMA16(ka[s], qf[s], c);
#pragma unroll
      for (int r = 0; r < 4; ++r) {
        const int slot = 16 * tau + 4 * g4 + r;
        const float pe = (slot < nvalid) ? __expf(c[r]) : 0.f;
        sum += pe;
        if (l15 < 8) Sw[slot * 8 + l15] = pe;
      }
    }
    sum += __shfl_xor(sum, 16); sum += __shfl_xor(sum, 32);
    inv = 1.f / sum;
  }
  const int dc = (lane & 3) | (((lane >> 3) & 1) << 2);
  const int ks = ((lane >> 2) & 1) | ((lane >> 4) << 1);
  float o[8][8];
#pragma unroll
  for (int hd = 0; hd < 8; ++hd)
#pragma unroll
    for (int d = 0; d < 8; ++d) o[hd][d] = 0.f;
#pragma unroll ATT_UNROLL
  for (int it = 0; it < 32; ++it) {
    const int slot = it * 8 + ks;
    int kidx = uselist ? (int)idxp[slot] : slot;
    if (slot >= nvalid) kidx = 0;
    const u16* row = BKVb + (size_t)kidx * 256;
    const uint4 v0 = *(const uint4*)(row + 128 + dc * 8);
    const uint4 v1 = *(const uint4*)(row + 192 + dc * 8);
    const f32x4 pa = *(const f32x4*)(Sw + slot * 8);
    const f32x4 pb = *(const f32x4*)(Sw + slot * 8 + 4);
    float f0[8] = {bflo(v0.x), bfhi(v0.x), bflo(v0.y), bfhi(v0.y), bflo(v0.z), bfhi(v0.z), bflo(v0.w), bfhi(v0.w)};
    float f1[8] = {bflo(v1.x), bfhi(v1.x), bflo(v1.y), bfhi(v1.y), bflo(v1.z), bfhi(v1.z), bflo(v1.w), bfhi(v1.w)};
#pragma unroll
    for (int r = 0; r < 4; ++r) {
#pragma unroll
      for (int d = 0; d < 8; ++d) { o[r][d] += pa[r] * f0[d]; o[4 + r][d] += pb[r] * f1[d]; }
    }
  }
  float o4[4][8];
  {
    const bool up = ks & 4;
#pragma unroll
    for (int i = 0; i < 4; ++i)
#pragma unroll
      for (int d = 0; d < 8; ++d) { float keep = up ? o[4 + i][d] : o[i][d]; float send = up ? o[i][d] : o[4 + i][d]; o4[i][d] = keep + __shfl_xor(send, 32); }
  }
  float o2[2][8];
  {
    const bool up = ks & 2;
#pragma unroll
    for (int i = 0; i < 2; ++i)
#pragma unroll
      for (int d = 0; d < 8; ++d) { float keep = up ? o4[2 + i][d] : o4[i][d]; float send = up ? o4[i][d] : o4[2 + i][d]; o2[i][d] = keep + __shfl_xor(send, 16); }
  }
  float o1[8];
  {
    const bool up = ks & 1;
#pragma unroll
    for (int d = 0; d < 8; ++d) { float keep = up ? o2[1][d] : o2[0][d]; float send = up ? o2[0][d] : o2[1][d]; o1[d] = keep + __shfl_xor(send, 4); }
  }
  const float invh = __shfl(inv, ks);
  const u16* bz = (const u16*)(ws + OFF_BZ) + (size_t)t * 512 + ks * 64 + dc * 8;
  uint4 zz = *(const uint4*)bz;
  float zf[8] = {bflo(zz.x), bfhi(zz.x), bflo(zz.y), bfhi(zz.y), bflo(zz.z), bfhi(zz.z), bflo(zz.w), bfhi(zz.w)};
  uint4 ov;
  ov.x = pack2(o1[0] * invh * siluf_(zf[0]), o1[1] * invh * siluf_(zf[1]));
  ov.y = pack2(o1[2] * invh * siluf_(zf[2]), o1[3] * invh * siluf_(zf[3]));
  ov.z = pack2(o1[4] * invh * siluf_(zf[4]), o1[5] * invh * siluf_(zf[5]));
  ov.w = pack2(o1[6] * invh * siluf_(zf[6]), o1[7] * invh * siluf_(zf[7]));
  nt_st4((u16*)(ws + OFF_MIXB) + (size_t)t * 512 + ks * 64 + dc * 8, ov);
}

DI void kb_item(const Params& P, int item, char* lds) {
  const int tid = otid();
  const int lane = tid & 63, wave = __builtin_amdgcn_readfirstlane(tid >> 6), hh = lane >> 5, l31 = lane & 31;
  const int b = item & 3, qt = 1023 - (item >> 2), t0 = qt * 4;
  char* ws = P.ws;
  float* Sl = (float*)lds;
  u16* myidx = (u16*)(lds + wave * 16384);
  float* mySw = (float*)(lds + wave * 16384 + 1024);
  if (t0 + 3 < 255) {
    __syncthreads();
    kb2_query(P, b * 4096 + t0 + wave, mySw, myidx);
    return;
  }
  const u16* IQ = (const u16*)(ws + OFF_IQ);
  const u16* IK = (const u16*)(ws + OFF_IK);
  const float* SMALL = (const float*)(ws + OFF_SMALL);
  const int T0 = b * 4096 + t0;
  __syncthreads();
  {
    bf16x8 af[8];
    const u16* src = IQ + (size_t)(T0 + ((l31 >> 2) & 1) + 2 * ((l31 >> 4) & 1)) * 1024 + ((l31 & 3) + 4 * ((l31 >> 3) & 1)) * 128 + 8 * hh;
#pragma unroll
    for (int s = 0; s < 8; ++s) af[s] = *(const bf16x8*)(src + 16 * s);
    float wv[16];
#pragma unroll
    for (int r = 0; r < 16; ++r) wv[r] = SMALL[(size_t)(T0 + hh + 2 * (r >> 3)) * 16 + 8 + (r & 3) + 4 * ((r >> 2) & 1)] * 0.03125f;
    const int ntile = (t0 + 4 + 31) >> 5;
    const u16* kbase = IK + (size_t)b * 128 * 4096 + lane * 8;
    const int nmine = ntile > wave ? (ntile - wave + 3) >> 2 : 0;
    bf16x8 c0[8], c1[8];
    {
      const int k0 = wave, k1 = nmine > 1 ? wave + 4 : wave;
      if (nmine > 0) {
#pragma unroll
        for (int s = 0; s < 8; ++s) { c0[s] = *(const bf16x8*)(kbase + (size_t)k0 * 4096 + 512 * s); c1[s] = *(const bf16x8*)(kbase + (size_t)k1 * 4096 + 512 * s); }
      }
    }
    for (int j = 0; j < nmine; j += 2) {
      const int kt0 = wave + 4 * j, kt1 = kt0 + 4;
      const bool has1 = j + 1 < nmine;
      bf16x8 n0[8], n1[8];
      {
        const int ka = j + 2 < nmine ? kt0 + 8 : kt0, kb2 = j + 3 < nmine ? kt0 + 12 : kt0;
#pragma unroll
        for (int s = 0; s < 8; ++s) { n0[s] = *(const bf16x8*)(kbase + (size_t)ka * 4096 + 512 * s); n1[s] = *(const bf16x8*)(kbase + (size_t)kb2 * 4096 + 512 * s); }
      }
      f32x16 acc0 = zero16(), acc1 = zero16();
#pragma unroll
      for (int s = 0; s < 8; ++s) { acc0 = MFMA32(af[s], c0[s], acc0); acc1 = MFMA32(af[s], c1[s], acc1); }
#pragma unroll
      for (int s = 0; s < 8; ++s) { c0[s] = n0[s]; c1[s] = n1[s]; }
      float sa0 = 0.f, sa1 = 0.f, sb0 = 0.f, sb1 = 0.f;
#pragma unroll
      for (int i = 0; i < 8; ++i) {
        sa0 += wv[i] * fmaxf(acc0[i], 0.f); sa1 += wv[8 + i] * fmaxf(acc0[8 + i], 0.f);
        sb0 += wv[i] * fmaxf(acc1[i], 0.f); sb1 += wv[8 + i] * fmaxf(acc1[8 + i], 0.f);
      }
      Sl[hh * 4096 + kt0 * 32 + l31] = sa0;
      Sl[(hh + 2) * 4096 + kt0 * 32 + l31] = sa1;
      if (has1) {
        Sl[hh * 4096 + kt1 * 32 + l31] = sb0;
        Sl[(hh + 2) * 4096 + kt1 * 32 + l31] = sb1;
      }
    }
  }
  __syncthreads();
  const int pos = t0 + wave;
  if (pos >= 255) {
    const int nchunk = (pos >> 10) + 1;
    u32 key[64];
#pragma unroll
    for (int c4 = 0; c4 < 4; ++c4) {
      if (c4 < nchunk) {
#pragma unroll
        for (int ii = 0; ii < 16; ++ii) {
          const int i = c4 * 16 + ii;
          const int idx = lane + 64 * i;
          float v = Sl[wave * 4096 + idx] + 0.0f;
          u32 u = __float_as_uint(v);
          u = (u & 0x80000000u) ? ~u : (u | 0x80000000u);
          key[i] = (idx <= pos) ? u : 0u;
        }
      } else {
#pragma unroll
        for (int ii = 0; ii < 16; ++ii) key[c4 * 16 + ii] = 0u;
      }
    }
    u32 g0 = key[0], g1 = key[1], g2 = key[2], g3 = key[3];
#pragma unroll
    for (int i = 4; i < 64; i += 4) { g0 = max(g0, key[i]); g1 = max(g1, key[i + 1]); g2 = max(g2, key[i + 2]); g3 = max(g3, key[i + 3]); }
    u32 lo = min(min(g0, g1), min(g2, g3)), hi = max(max(g0, g1), max(g2, g3));
#pragma unroll
    for (int d = 1; d < 64; d <<= 1) { lo = min(lo, (u32)__shfl_xor((int)lo, d)); hi = max(hi, (u32)__shfl_xor((int)hi, d)); }
    lo = __builtin_amdgcn_readfirstlane(lo); hi = __builtin_amdgcn_readfirstlane(hi);
    const u32 diff = lo ^ hi;
    const int topbit = diff ? 31 - __builtin_clz(diff) : -1;
    u32 Pv = topbit >= 31 ? 0u : (topbit < 0 ? lo : (lo & ~((2u << topbit) - 1u)));
    bool exact = false;
    for (int bit = topbit; bit >= 0; --bit) {
      const u32 cand = Pv | (1u << bit);
      int c = 0;
#pragma unroll
      for (int c4 = 0; c4 < 4; ++c4) {
        if (c4 < nchunk) {
#pragma unroll
          for (int ii = 0; ii < 16; ++ii) {
            c += __popcll(__ballot(key[c4 * 16 + ii] >= cand));
            if ((ii & 7) == 7) __builtin_amdgcn_sched_barrier(0);
          }
        }
      }
      if (c >= 256) {
        Pv = cand;
        if (c == 256) { exact = true; break; }
      }
    }
    int need = 1 << 30;
    if (!exact) {
      int cgt = 0;
#pragma unroll
      for (int c4 = 0; c4 < 4; ++c4) {
        if (c4 < nchunk) {
#pragma unroll
          for (int ii = 0; ii < 16; ++ii) {
            cgt += __popcll(__ballot(key[c4 * 16 + ii] > Pv));
            if ((ii & 7) == 7) __builtin_amdgcn_sched_barrier(0);
          }
        }
      }
      need = 256 - cgt;
    }
    u16* out = myidx;
    if (exact) {
      u32 mlo = 0u, mhi = 0u;
#pragma unroll
      for (int c4 = 0; c4 < 4; ++c4) {
        if (c4 < nchunk) {
#pragma unroll
          for (int ii = 0; ii < 16; ++ii) {
            const int i = c4 * 16 + ii;
            const u32 bit = (key[i] >= Pv) ? (1u << (i & 31)) : 0u;
            if (i < 32) mlo |= bit; else mhi |= bit;
          }
        }
      }
      const int cnt = __popc(mlo) + __popc(mhi);
      int incl = cnt;
#pragma unroll
      for (int d = 1; d < 64; d <<= 1) { const int tv = __shfl_up(incl, d); if (lane >= d) incl += tv; }
      int off = incl - cnt;
      while (mlo) { const int i = __ffs((int)mlo) - 1; out[off++] = (u16)(lane + 64 * i); mlo &= mlo - 1u; }
      while (mhi) { const int i = __ffs((int)mhi) - 1; out[off++] = (u16)(lane + 64 * (32 + i)); mhi &= mhi - 1u; }
    } else {
    int off = 0, eqseen = 0;
    const u64 ltmask = (1ull << lane) - 1ull;
#pragma unroll
    for (int c4 = 0; c4 < 4; ++c4) {
      if (c4 < nchunk) {
#pragma unroll
        for (int ii = 0; ii < 16; ++ii) {
          const int i = c4 * 16 + ii;
          const bool gt = key[i] > Pv, eq = key[i] == Pv;
          const u64 meq = __ballot(eq);
          const int rank = eqseen + __popcll(meq & ltmask);
          const bool sel = gt || (eq && rank < need);
          const u64 ms = __ballot(sel);
          if (sel) out[off + __popcll(ms & ltmask)] = (u16)(lane + 64 * i);
          off += __popcll(ms);
          eqseen += __popcll(meq);
          if ((ii & 3) == 3) __builtin_amdgcn_sched_barrier(0);
        }
      }
    }
    }
  }
  kb2_query(P, T0 + wave, mySw, myidx);
}

constexpr int KB_SPLIT = 1536;
DI int pull_item(unsigned* ctr, char* lds) {
  volatile LAS unsigned* slot = (volatile LAS unsigned*)(lds + LDS_BYTES - 8);
  __syncthreads();
  if (threadIdx.x == 0) *slot = __hip_atomic_fetch_add(ctr, 1u, __ATOMIC_RELAXED, __HIP_MEMORY_SCOPE_AGENT);
  __syncthreads();
  return (int)*slot;
}
DI void phase2(const Params& P, char* lds) {
  for (int it = blockIdx.x; it < 1024; it += gridDim.x) ka1_item(P, it, lds);
  if ((gridDim.x & 3) == 0) {
    const int bb = blockIdx.x & 3;
    unsigned* ctr = (unsigned*)(P.ws + OFF_BAR) + 16 * bb;
    for (;;) {
      const int k = pull_item(ctr, lds);
      if (k >= KB_SPLIT / 4) break;
      kb_item(P, 4 * k + bb, lds);
    }
  } else {
    for (int it = blockIdx.x; it < KB_SPLIT; it += gridDim.x) kb_item(P, it, lds);
  }
}

DI void ka2_scan(const Params& P, int bh, char* lds) {
  const int tid = otid(), lane = tid & 63, wave = tid >> 6, hh = lane >> 5, l31 = lane & 31;
  char* ws = P.ws;
  const int dv = 32 * wave + l31;
  const u16* WNEG = (const u16*)(ws + OFF_WNEG) + (size_t)bh * 64 * 8192;
  const u16* KDT = (const u16*)(ws + OFF_KDT) + (size_t)bh * 64 * 8192;
  const u16* UT = (const u16*)(ws + OFF_UT) + (size_t)bh * 64 * 8192 + dv * 8 + 4 * hh;
  const float* GL = (const float*)(ws + OFF_GL) + bh * 64;
  u16* HST = (u16*)((char*)P.out + OOFF_HST) + (size_t)bh * 64 * 16384 + dv * 8 + 4 * hh;
  u16* VNT = (u16*)((char*)P.out + OOFF_VNT) + (size_t)bh * 64 * 8192 + dv * 8 + 4 * hh;
  const int wbase = (tid >> 4) * 272 + ((tid & 15) << 4);
  const int kbase = 17408 + (tid >> 3) * 144 + ((tid & 7) << 4);
  u32x4 sw[4], sk[4];
  uint2 un[8];
  float gln;
  __syncthreads();
#pragma unroll
  for (int i = 0; i < 4; ++i) {
    sw[i] = nt_ld4(WNEG + (size_t)(tid + 256 * i) * 8);
    sk[i] = nt_ld4(KDT + (size_t)(tid + 256 * i) * 8);
  }
#pragma unroll
  for (int i = 0; i < 8; ++i) un[i] = *(const uint2*)(UT + i * 1024);
  gln = GL[0];
#pragma unroll
  for (int i = 0; i < 4; ++i) { *(u32x4*)(lds + wbase + i * 4352) = sw[i]; *(u32x4*)(lds + kbase + i * 4608) = sk[i]; }
  __syncthreads();
  f32x16 S[4];
#pragma unroll
  for (int m = 0; m < 4; ++m) S[m] = zero16();
  for (int n = 0; n < 64; ++n) {
    const char* buf = lds + (n & 1) * 35840;
    char* nbuf = lds + ((n + 1) & 1) * 35840;
    f32x16 vn[2];
#pragma unroll
    for (int tt = 0; tt < 2; ++tt) {
#pragma unroll
      for (int rg = 0; rg < 4; ++rg) {
        const uint2 u = un[4 * tt + rg];
        vn[tt][4 * rg] = bflo(u.x); vn[tt][4 * rg + 1] = bfhi(u.x); vn[tt][4 * rg + 2] = bflo(u.y); vn[tt][4 * rg + 3] = bfhi(u.y);
      }
    }
    const float gl = gln;
    if (n + 1 < 64) {
      const size_t o = (size_t)(n + 1) * 8192;
#pragma unroll
      for (int i = 0; i < 4; ++i) {
        sw[i] = nt_ld4(WNEG + o + (size_t)(tid + 256 * i) * 8);
        sk[i] = nt_ld4(KDT + o + (size_t)(tid + 256 * i) * 8);
      }
#pragma unroll
      for (int i = 0; i < 8; ++i) un[i] = *(const uint2*)(UT + o + i * 1024);
      gln = GL[n + 1];
    }
    u16* hst = HST + (size_t)n * 16384;
    u16* vnt = VNT + (size_t)n * 8192;
#pragma unroll
    for (int m = 0; m < 4; ++m) {
      u32 pk[8];
#pragma unroll
      for (int r = 0; r < 8; ++r) pk[r] = pack2(S[m][2 * r], S[m][2 * r + 1]);
#pragma unroll
      for (int rg = 0; rg < 4; ++rg) nt_st2(hst + (4 * m + rg) * 1024, pk[2 * rg], pk[2 * rg + 1]);
      u32x4 f0 = {pk[0], pk[1], pk[2], pk[3]}, f1 = {pk[4], pk[5], pk[6], pk[7]};
      const bf16x8 sf0 = __builtin_bit_cast(bf16x8, f0), sf1 = __builtin_bit_cast(bf16x8, f1);
#pragma unroll
      for (int tt = 0; tt < 2; ++tt) {
        bf16x8 a0 = *(const bf16x8*)(buf + (l31 * 272 + 16 * hh) + (tt * 8704 + 32 * (2 * m)));
        bf16x8 a1 = *(const bf16x8*)(buf + (l31 * 272 + 16 * hh) + (tt * 8704 + 32 * (2 * m + 1)));
        vn[tt] = MFMA32(a0, sf0, vn[tt]);
        vn[tt] = MFMA32(a1, sf1, vn[tt]);
      }
      __builtin_amdgcn_sched_barrier(0);
    }
    bf16x8 vf[4];
#pragma unroll
    for (int tt = 0; tt < 2; ++tt) {
      u32 pk[8];
#pragma unroll
      for (int r = 0; r < 8; ++r) pk[r] = pack2(vn[tt][2 * r], vn[tt][2 * r + 1]);
#pragma unroll
      for (int rg = 0; rg < 4; ++rg) nt_st2(vnt + (4 * tt + rg) * 1024, pk[2 * rg], pk[2 * rg + 1]);
      u32x4 f0 = {pk[0], pk[1], pk[2], pk[3]}, f1 = {pk[4], pk[5], pk[6], pk[7]};
      vf[2 * tt] = __builtin_bit_cast(bf16x8, f0);
      vf[2 * tt + 1] = __builtin_bit_cast(bf16x8, f1);
    }
#pragma unroll
    for (int m = 0; m < 4; ++m) {
#pragma unroll
      for (int r = 0; r < 16; ++r) S[m][r] *= gl;
    }
#pragma unroll
    for (int ks = 0; ks < 4; ++ks) {
#pragma unroll
      for (int m = 0; m < 4; ++m) {
        bf16x8 a = *(const bf16x8*)(buf + 17408 + (l31 * 144 + 16 * hh) + (m * 4608 + 32 * ks));
        S[m] = MFMA32(a, vf[ks], S[m]);
      }
      __builtin_amdgcn_sched_barrier(0);
    }
    if (n + 1 < 64) {
#pragma unroll
      for (int i = 0; i < 4; ++i) { *(u32x4*)(nbuf + wbase + i * 4352) = sw[i]; *(u32x4*)(nbuf + kbase + i * 4608) = sk[i]; }
    }
    __syncthreads();
  }
}

DI void phase3(const Params& P, char* lds) {
  const int G = gridDim.x;
  const int nscan = G > 32 ? 16 : 0;
  int first = KB_SPLIT + (int)blockIdx.x - nscan, stride = G - nscan;
  if ((int)blockIdx.x < 16 || nscan == 0) {
    for (int bh = blockIdx.x; bh < 16; bh += G) ka2_scan(P, bh, lds);
    if (nscan) first = 4096;
  }
  if (nscan && (G & 3) == 0) {
    if ((int)blockIdx.x >= 16) {
      const int bb = blockIdx.x & 3;
      unsigned* ctr = (unsigned*)(P.ws + OFF_BAR) + 64 + 16 * bb;
      for (;;) {
        const int k = KB_SPLIT / 4 + pull_item(ctr, lds);
        if (k >= 1024) break;
        kb_item(P, 4 * k + bb, lds);
      }
    }
  } else {
    for (int it = first; it < 4096; it += stride) kb_item(P, it, lds);
  }
}

DI void phase4(const Params& P, char* lds) {
  const int tid4 = otid(), lane = tid4 & 63, wave = tid4 >> 6, l15 = lane & 15, g4 = lane >> 4;
  char* ws = P.ws;
  float nw[8];
#pragma unroll
  for (int nt = 0; nt < 8; ++nt) nw[nt] = P.a_out_norm_w[16 * nt + l15];
  for (int ch = blockIdx.x; ch < 1024; ch += gridDim.x) {
    const int b = ch >> 8, h = (ch >> 6) & 3, n = ch & 63;
    const int tok0 = b * 4096 + n * 64;
    const u16* QD = (const u16*)(ws + OFF_QD) + (size_t)ch * 8192;
    const u16* ATT = (const u16*)(ws + OFF_ATT) + (size_t)ch * 4096;
    const u16* HST = (const u16*)((const char*)P.out + OOFF_HST) + (size_t)ch * 16384;
    const u16* VNT = (const u16*)((const char*)P.out + OOFF_VNT) + (size_t)ch * 8192;
    __syncthreads();
    {
      u32x4 st[12];
#pragma unroll
      for (int i = 0; i < 8; ++i) st[i] = *(const u32x4*)(HST + (size_t)(tid4 + 256 * i) * 8);
#pragma unroll
      for (int i = 0; i < 4; ++i) st[8 + i] = *(const u32x4*)(VNT + (size_t)(tid4 + 256 * i) * 8);
#pragma unroll
      for (int i = 0; i < 8; ++i) *(u32x4*)(lds + (tid4 + 256 * i) * 16) = st[i];
#pragma unroll
      for (int i = 0; i < 4; ++i) *(u32x4*)(lds + 32768 + (tid4 + 256 * i) * 16) = st[8 + i];
    }
    __syncthreads();
    const u16* HSl = (const u16*)lds;
    const u16* VNl = (const u16*)(lds + 32768);
    f32x4 acc[8];
#pragma unroll
    for (int nt = 0; nt < 8; ++nt) acc[nt] = zero4();
#pragma unroll
    for (int ks = 0; ks < 4; ++ks) {
      bf16x8 a = *(const bf16x8*)(QD + (16 * wave + l15) * 128 + 32 * ks + 8 * g4);
#pragma unroll
      for (int nt = 0; nt < 8; ++nt) {
        bf16x8 bb = *(const bf16x8*)(HSl + (4 * ks + g4) * 1024 + (16 * nt + l15) * 8);
        acc[nt] = MFMA16(a, bb, acc[nt]);
      }
    }
#pragma unroll
    for (int ks = 0; ks < 2; ++ks) {
      bf16x8 a = *(const bf16x8*)(ATT + (16 * wave + l15) * 64 + 32 * ks + 8 * g4);
#pragma unroll
      for (int nt = 0; nt < 8; ++nt) {
        bf16x8 bb = *(const bf16x8*)(VNl + (4 * ks + g4) * 1024 + (16 * nt + l15) * 8);
        acc[nt] = MFMA16(a, bb, acc[nt]);
      }
    }
    float zg[4][8];
#pragma unroll
    for (int r = 0; r < 4; ++r) {
      const u16* az = (const u16*)(ws + OFF_AZ) + (size_t)(tok0 + 16 * wave + 4 * g4 + r) * 512 + h * 128;
#pragma unroll
      for (int nt = 0; nt < 8; ++nt) zg[r][nt] = bf2f(az[16 * nt + l15]);
    }
#pragma unroll
    for (int r = 0; r < 4; ++r) {
      float ss = 0.f;
#pragma unroll
      for (int nt = 0; nt < 8; ++nt) ss += acc[nt][r] * acc[nt][r];
      ss += __shfl_xor(ss, 1); ss += __shfl_xor(ss, 2); ss += __shfl_xor(ss, 4); ss += __shfl_xor(ss, 8);
      const float rs = rsqrtf(ss * (1.f / 128.f) + EPS);
      const int t = tok0 + 16 * wave + 4 * g4 + r;
      u16* mix = (u16*)(ws + OFF_MIXA) + (size_t)t * 512 + h * 128;
#pragma unroll
      for (int nt = 0; nt < 8; ++nt) {
        const int dv = 16 * nt + l15;
        mix[dv] = f2bf(acc[nt][r] * rs * nw[nt] * siluf_(zg[r][nt]));
      }
    }
  }
}

DI void phase5(const Params& P, char* lds) {
  char* ws = P.ws;
  const u16* MIXA = (const u16*)(ws + OFF_MIXA);
  const u16* MIXB = (const u16*)(ws + OFF_MIXB);
  const u16* WT = (const u16*)(ws + OFF_WT_OUT);
  float* X1 = (float*)(ws + OFF_X1);
  u16* X1B = (u16*)(ws + OFF_X1B);
  float* SS = (float*)(ws + OFF_SUMSQ);
  const int lane = otid() & 63, wave = otid() >> 6;
  const int wm = wave & 1, wn = wave >> 1, l31 = lane & 31, hh = lane >> 5;
  const bool xswz = (gridDim.x & 7) == 0;
  const int xq = blockIdx.x >> 3, xn = gridDim.x >> 3, xx = blockIdx.x & 7;
  for (int tile = xswz ? xq : (int)blockIdx.x; tile < (xswz ? 64 : 512); tile += (xswz ? xn : (int)gridDim.x)) {
    const int mt = xswz ? 8 * xx + (tile & 7) : (tile >> 3), nt = xswz ? (tile >> 3) : (tile & 7);
    f32x16 acc[4][2];
#pragma unroll
    for (int i = 0; i < 4; ++i)
#pragma unroll
      for (int j = 0; j < 2; ++j) acc[i][j] = zero16();
    gemm_mainloop<4>(MIXA, 512, WT, 1024, 512, mt * 256, nt * 128, lds, acc);
    gemm_mainloop<4>(MIXB, 512, WT + 512, 1024, 512, mt * 256, nt * 128, lds, acc);
    {
      const size_t e0 = (size_t)(mt * 256 + wm * 128 + 4 * hh) * 1024 + nt * 128 + wn * 64 + l31;
      float* ssp0 = SS + (mt * 256 + wm * 128 + 4 * hh);
#pragma unroll
      for (int i = 0; i < 4; ++i) {
        float xa[16], xb[16];
        {
          const float* xp = P.x + e0 + (size_t)i * 32 * 1024;
#pragma unroll
          for (int r = 0; r < 16; ++r) {
            xa[r] = xp[0]; xb[r] = xp[32];
            xp += (((r & 3) == 3) ? 5 : 1) * 1024;
            asm volatile("" : "+v"(xp));
          }
        }
        float* x1p = X1 + e0 + (size_t)i * 32 * 1024;
        u16* x1bp = X1B + e0 + (size_t)i * 32 * 1024;
        float* ssp = ssp0 + i * 32;
#pragma unroll
        for (int r = 0; r < 16; ++r) {
          const float va = xa[r] + acc[i][0][r], vb = xb[r] + acc[i][1][r];
          x1p[0] = va; x1p[32] = vb;
          x1bp[0] = f2bf(va); x1bp[32] = f2bf(vb);
          float ss = va * va + vb * vb;
          ss += dpp_xor1(ss); ss += dpp_xor2(ss); ss += __shfl_xor(ss, 4); ss += dpp_xor8(ss); ss += __shfl_xor(ss, 16);
          if (l31 == 0) atomicAdd(ssp, ss);
          const int step = ((r & 3) == 3) ? 5 : 1;
          x1p += step * 1024; x1bp += step * 1024; ssp += step;
          asm volatile("" : "+v"(x1p), "+v"(x1bp), "+v"(ssp));
        }
      }
    }
  }
}

DI void phase6(const Params& P, char* lds) {
  char* ws = P.ws;
  const u16* X1B = (const u16*)(ws + OFF_X1B);
  const float* X1 = (const float*)(ws + OFF_X1);
  const u16* WG = (const u16*)(ws + OFF_WT_GATE);
  const u16* WP = (const u16*)(ws + OFF_WT_PLE);
  const u16* PB = (const u16*)(ws + OFF_PB);
  const float* SS = (const float*)(ws + OFF_SUMSQ);
  const int lane = otid() & 63, wave = otid() >> 6;
  const int wm = wave & 1, wn = wave >> 1, l31 = lane & 31, hh = lane >> 5;
  const bool xswz = (gridDim.x & 7) == 0;
  const int xq = blockIdx.x >> 3, xn = gridDim.x >> 3, xx = blockIdx.x & 7;
  for (int tile = xswz ? xq : (int)blockIdx.x; tile < (xswz ? 128 : 1024); tile += (xswz ? xn : (int)gridDim.x)) {
    const int mt = xswz ? 16 * xx + (tile & 15) : (tile >> 3), nt = xswz ? (tile >> 4) : (tile & 7);
    f32x16 ag[2][2], ap[2][2];
#pragma unroll
    for (int i = 0; i < 2; ++i)
#pragma unroll
      for (int j = 0; j < 2; ++j) { ag[i][j] = zero16(); ap[i][j] = zero16(); }
    gemm_mainloop<2>(X1B, 1024, WG, 1024, 1024, mt * 128, nt * 128, lds, ag);
    gemm_mainloop<2>(PB, 256, WP, 256, 256, mt * 128, nt * 128, lds, ap);
    const size_t e0 = (size_t)(mt * 128 + wm * 64 + 4 * hh) * 1024 + nt * 128 + wn * 64 + l31;
    const float b0 = P.b_ple_gate[nt * 128 + wn * 64 + l31], b1 = P.b_ple_gate[nt * 128 + wn * 64 + 32 + l31];
    const float* ssp0 = SS + (mt * 128 + wm * 64 + 4 * hh);
#pragma unroll
    for (int i = 0; i < 2; ++i) {
      float rsv[16], xa[16], xb[16];
#pragma unroll
      for (int r = 0; r < 16; ++r) rsv[r] = ssp0[i * 32 + (r & 3) + 8 * (r >> 2)];
      {
        const float* x1p = X1 + e0 + (size_t)i * 32 * 1024;
#pragma unroll
        for (int r = 0; r < 16; ++r) {
          xa[r] = x1p[0]; xb[r] = x1p[32];
          x1p += (((r & 3) == 3) ? 5 : 1) * 1024;
          asm volatile("" : "+v"(x1p));
        }
      }
      float* op = P.out + e0 + (size_t)i * 32 * 1024;
#pragma unroll
      for (int r = 0; r < 16; ++r) {
        const float rs = rsqrtf(rsv[r] * (1.f / 1024.f) + EPS);
        op[0] = xa[r] + ap[i][0][r] * sigmoidf_(rs * ag[i][0][r] + b0);
        op[32] = xb[r] + ap[i][1][r] * sigmoidf_(rs * ag[i][1][r] + b1);
        op += (((r & 3) == 3) ? 5 : 1) * 1024;
        asm volatile("" : "+v"(op));
      }
    }
  }
}

template <int PH>
DI void run_phase(const Params& P, char* lds) {
  if (PH == 0) phase0(P);
  else if (PH == 1) phase1(P, lds);
  else if (PH == 2) phase2(P, lds);
  else if (PH == 3) phase3(P, lds);
  else if (PH == 4) phase4(P, lds);
  else if (PH == 5) phase5(P, lds);
  else phase6(P, lds);
}

template <int PH>
__global__ void __launch_bounds__(256, 2) phase_kernel(Params P) {
  __shared__ __attribute__((aligned(16))) char lds[LDS_BYTES];
  run_phase<PH>(P, lds);
}

__global__ void __launch_bounds__(256, 2) mega(Params P) {
  __shared__ __attribute__((aligned(16))) char lds[LDS_BYTES];
  volatile LAS unsigned* st = (volatile LAS unsigned*)(lds + LDS_BYTES - 16);
  if (threadIdx.x == 0) { st[0] = 0u; st[1] = 0u; }
  __syncthreads();
  if (P.ws == nullptr) cg::this_grid().sync();
  XcdBarrier xb = xcd_barrier_post((unsigned*)(P.ws + OFF_BAR), st);
  run_phase<0>(P, lds); xcd_barrier(xb);
  run_phase<1>(P, lds); xcd_barrier(xb);
  run_phase<2>(P, lds); xcd_barrier(xb);
  run_phase<3>(P, lds); xcd_barrier(xb);
  run_phase<4>(P, lds); xcd_barrier(xb);
  run_phase<5>(P, lds); xcd_barrier(xb);
  run_phase<6>(P, lds);
}

extern "C" void kernel_launch(void* const* d_in, const int* in_sizes, int n_in, void* d_out, int out_size, void* d_ws,
                              size_t ws_size, hipStream_t stream) {
  Params P{};
  P.x = (const float*)d_in[0]; P.p = (const float*)d_in[1]; P.attn_norm_w = (const float*)d_in[2];
  P.w_in = (const float*)d_in[3]; P.conv_w = (const float*)d_in[4]; P.a_log = (const float*)d_in[5];
  P.dt_bias = (const float*)d_in[6]; P.a_out_norm_w = (const float*)d_in[7]; P.b_q_norm_w = (const float*)d_in[8];
  P.b_k_norm_w = (const float*)d_in[9]; P.w_out = (const float*)d_in[10]; P.w_ple = (const float*)d_in[11];
  P.ple_gate_norm_w = (const float*)d_in[12]; P.w_ple_gate = (const float*)d_in[13]; P.b_ple_gate = (const float*)d_in[14];
  P.out = (float*)d_out; P.ws = (char*)d_ws;
  static int grid_blocks = 0;
  if (!grid_blocks) {
    int dev = 0, cus = 0, per_cu = 0;
    (void)hipGetDevice(&dev);
    (void)hipDeviceGetAttribute(&cus, hipDeviceAttributeMultiprocessorCount, dev);
    (void)hipOccupancyMaxActiveBlocksPerMultiprocessor(&per_cu, mega, 256, 0);
    if (per_cu > 2) per_cu = 2;
    if (per_cu < 1) per_cu = 1;
    grid_blocks = cus * per_cu;
  }
#ifdef MULTI_LAUNCH
  hipLaunchKernelGGL(phase_kernel<0>, dim3(grid_blocks), dim3(256), 0, stream, P);
  hipLaunchKernelGGL(phase_kernel<1>, dim3(grid_blocks), dim3(256), 0, stream, P);
  hipLaunchKernelGGL(phase_kernel<2>, dim3(grid_blocks), dim3(256), 0, stream, P);
  hipLaunchKernelGGL(phase_kernel<3>, dim3(grid_blocks), dim3(256), 0, stream, P);
  hipLaunchKernelGGL(phase_kernel<4>, dim3(grid_blocks), dim3(256), 0, stream, P);
  hipLaunchKernelGGL(phase_kernel<5>, dim3(grid_blocks), dim3(256), 0, stream, P);
  hipLaunchKernelGGL(phase_kernel<6>, dim3(grid_blocks), dim3(256), 0, stream, P);
#else
  (void)hipMemsetAsync((char*)d_ws + OFF_BAR, 0, XCD_BAR_WORDS * 4, stream);
  void* args[] = {&P};
  hipError_t e = hipLaunchCooperativeKernel((void*)mega, dim3(grid_blocks), dim3(256), args, 0, stream);
  if (e != hipSuccess) fprintf(stderr, "cooperative launch failed: %s (grid %d)\n", hipGetErrorString(e), grid_blocks);
#endif
}
```

```cpp
#include <hip/hip_runtime.h>
#include <hip/hip_cooperative_groups.h>
#include <cstdio>
namespace cg = cooperative_groups;

typedef unsigned short u16;
typedef unsigned int u32;
typedef unsigned long long u64;
using bf16x8 = __attribute__((ext_vector_type(8))) short;
using f32x16 = __attribute__((ext_vector_type(16))) float;
using f32x4 = __attribute__((ext_vector_type(4))) float;
using u32x4 = __attribute__((ext_vector_type(4))) unsigned;
#define DI __device__ __forceinline__
#define MFMA32(a, b, c) __builtin_amdgcn_mfma_f32_32x32x16_bf16((a), (b), (c), 0, 0, 0)
#define MFMA16(a, b, c) __builtin_amdgcn_mfma_f32_16x16x32_bf16((a), (b), (c), 0, 0, 0)

constexpr int T_ = 16384;
constexpr float EPS = 1e-6f;

constexpr size_t OFF_WT_IN = 0;
constexpr size_t OFF_WT_OUT = OFF_WT_IN + (size_t)4608 * 1024 * 2;
constexpr size_t OFF_WT_GATE = OFF_WT_OUT + (size_t)1024 * 1024 * 2;
constexpr size_t OFF_WT_PLE = OFF_WT_GATE + (size_t)1024 * 1024 * 2;
constexpr size_t OFF_PB = OFF_WT_PLE + (size_t)1024 * 256 * 2;
constexpr size_t OFF_SUMSQ = OFF_PB + (size_t)T_ * 256 * 2;
constexpr size_t OFF_QKV = OFF_SUMSQ + (size_t)T_ * 4;
constexpr size_t OFF_MIXA = OFF_QKV;
constexpr size_t OFF_AZ = OFF_QKV + (size_t)T_ * 1536 * 2;
constexpr size_t OFF_BQ = OFF_AZ + (size_t)T_ * 512 * 2;
constexpr size_t OFF_BKV = OFF_BQ + (size_t)T_ * 512 * 2;
constexpr size_t OFF_BZ = OFF_BKV + (size_t)T_ * 256 * 2;
constexpr size_t OFF_IQ = OFF_BZ + (size_t)T_ * 512 * 2;
constexpr size_t OFF_IK = OFF_IQ + (size_t)T_ * 1024 * 2;
constexpr size_t OFF_SMALL = OFF_IK + (size_t)T_ * 128 * 2;
constexpr size_t OFF_H = OFF_SMALL + (size_t)T_ * 16 * 4;
constexpr size_t OFF_WNEG = OFF_H;
constexpr size_t OFF_KDT = OFF_WNEG + (size_t)1024 * 8192 * 2;
constexpr size_t OFF_UT = OFF_H + (size_t)T_ * 1024 * 2;
constexpr size_t OFF_QD = OFF_UT + (size_t)1024 * 8192 * 2;
constexpr size_t OFF_ATT = OFF_QD + (size_t)1024 * 8192 * 2;
constexpr size_t OFF_GL = OFF_ATT + (size_t)1024 * 4096 * 2;
constexpr size_t OFF_BAR = OFF_GL + 4096;
constexpr size_t OFF_MIXB = OFF_BAR + 16384;
constexpr size_t WS_END = OFF_MIXB + (size_t)T_ * 512 * 2;
constexpr size_t OFF_X1 = OFF_AZ;
constexpr size_t OFF_X1B = OFF_X1 + (size_t)T_ * 1024 * 4;
static_assert(OFF_X1B + (size_t)T_ * 1024 * 2 <= OFF_UT, "x1 alias overlaps live data");
static_assert(WS_END <= (size_t)256 * 1024 * 1024, "ws too small");
constexpr size_t OOFF_HST = 0;
constexpr size_t OOFF_VNT = OOFF_HST + (size_t)1024 * 16384 * 2;
constexpr size_t OOFF_IDX = OOFF_VNT + (size_t)1024 * 8192 * 2;
static_assert(OOFF_IDX + (size_t)T_ * 256 * 2 <= (size_t)T_ * 1024 * 4, "d_out scratch");

constexpr int LDS_BYTES = 72 * 1024;

struct Params {
  const float *x, *p, *attn_norm_w, *w_in, *conv_w, *a_log, *dt_bias, *a_out_norm_w, *b_q_norm_w, *b_k_norm_w,
      *w_out, *w_ple, *ple_gate_norm_w, *w_ple_gate, *b_ple_gate;
  float* out;
  char* ws;
};

DI int otid() { int t = threadIdx.x; asm volatile("" : "+v"(t)); return t; }
DI float dpp_xor1(float v) { return __int_as_float(__builtin_amdgcn_update_dpp(0, __float_as_int(v), 0xB1, 0xF, 0xF, true)); }
DI float dpp_xor2(float v) { return __int_as_float(__builtin_amdgcn_update_dpp(0, __float_as_int(v), 0x4E, 0xF, 0xF, true)); }
DI float dpp_xor8(float v) { return __int_as_float(__builtin_amdgcn_update_dpp(0, __float_as_int(v), 0x128, 0xF, 0xF, true)); }
DI u16 f2bf(float x) { u32 u = __float_as_uint(x); u += 0x7fffu + ((u >> 16) & 1u); return (u16)(u >> 16); }
DI float bf2f(u16 v) { return __uint_as_float(((u32)v) << 16); }
DI u32 pack2(float a, float b) { return (u32)f2bf(a) | ((u32)f2bf(b) << 16); }
DI float bflo(u32 v) { return __uint_as_float(v << 16); }
DI float bfhi(u32 v) { return __uint_as_float(v & 0xffff0000u); }
DI float sigmoidf_(float x) { return 1.f / (1.f + __expf(-x)); }
DI float siluf_(float x) { return x / (1.f + __expf(-x)); }
DI f32x16 zero16() { f32x16 z; for (int i = 0; i < 16; ++i) z[i] = 0.f; return z; }
DI f32x4 zero4() { f32x4 z; for (int i = 0; i < 4; ++i) z[i] = 0.f; return z; }


#define XB_TMO      128
#define XB_XCNT(j)  (256  + 64 * (j))
#define XB_XSUB(j)  (1280 + 64 * (j))
#define XB_XGEN(j)  (2304 + 64 * (j))
#define XB_TOP      3328
#define XB_TOPGEN   3392
#define XCD_BAR_WORDS 3456
#define XB_SPIN_CAP (1u << 22)
#define LAS __attribute__((address_space(3)))
DI unsigned xb_ld(unsigned* p) { return __hip_atomic_load(p, __ATOMIC_RELAXED, __HIP_MEMORY_SCOPE_AGENT); }
DI unsigned xb_add(unsigned* p, unsigned v) { return __hip_atomic_fetch_add(p, v, __ATOMIC_RELAXED, __HIP_MEMORY_SCOPE_AGENT); }
DI unsigned xb_xcc_id() { return (unsigned)__builtin_amdgcn_s_getreg((3 << 11) | 20) & 0xFu; }
#define XB_SPIN(cond, bar) do { unsigned _sp = 0; while (cond) { __builtin_amdgcn_s_sleep(1); \
    if ((++_sp & 255u) == 0u) { if (xb_ld(&(bar)[XB_TMO])) break; if (_sp > XB_SPIN_CAP) { atomicAdd(&(bar)[XB_TMO], 1u); break; } } } } while (0)
struct XcdBarrier { unsigned* bar; unsigned x; volatile LAS unsigned* st; };
DI XcdBarrier xcd_barrier_post(unsigned* bar, volatile LAS unsigned* st) {
  XcdBarrier b; b.bar = bar; b.x = xb_xcc_id(); b.st = st;
  if (threadIdx.x == 0) (void)xb_add(&bar[XB_XCNT(b.x)], 1u);
  return b;
}
DI void xcd_barrier_complete(unsigned* bar, unsigned x, unsigned& nloc, unsigned& nx) {
  const unsigned G = gridDim.x * gridDim.y * gridDim.z;
  unsigned sum, cnt, mine, sp = 0u;
  for (;;) {
    sum = 0u; cnt = 0u; mine = 0u;
#pragma unroll
    for (unsigned j = 0; j < 16; ++j) { const unsigned c = xb_ld(&bar[XB_XCNT(j)]); sum += c; cnt += (c > 0u) ? 1u : 0u; mine = (j == x) ? c : mine; }
    if (sum == G) break;
    __builtin_amdgcn_s_sleep(1);
    if ((++sp & 255u) == 0u) { if (xb_ld(&bar[XB_TMO])) break; if (sp > XB_SPIN_CAP) { atomicAdd(&bar[XB_TMO], 1u); break; } }
  }
  nloc = mine > 0u ? mine : 1u; nx = cnt > 0u ? cnt : 1u;
}
DI void xcd_barrier(const XcdBarrier& b) {
  asm volatile("s_waitcnt vmcnt(0)" ::: "memory");
  __syncthreads();
  if (threadIdx.x == 0) {
    unsigned* bar = b.bar;
    __builtin_amdgcn_s_waitcnt(0);
    unsigned nloc = b.st[0], nx = b.st[1];
    if (nloc == 0u) { xcd_barrier_complete(bar, b.x, nloc, nx); b.st[0] = nloc; b.st[1] = nx; }
    const unsigned old = xb_add(&bar[XB_XSUB(b.x)], 1u);
    const unsigned gen = old / nloc;
    if (old + 1u == (gen + 1u) * nloc) {
      __builtin_amdgcn_fence(__ATOMIC_RELEASE, "agent");
      asm volatile("s_waitcnt vmcnt(0)" ::: "memory");
      const unsigned og = xb_add(&bar[XB_TOP], 1u);
      const unsigned tg = og / nx;
      if (og + 1u == (tg + 1u) * nx) xb_add(&bar[XB_TOPGEN], 1u);
      else XB_SPIN(xb_ld(&bar[XB_TOPGEN]) == tg, bar);
      __builtin_amdgcn_fence(__ATOMIC_ACQUIRE, "agent");
      xb_add(&bar[XB_XGEN(b.x)], 1u);
      asm volatile("s_waitcnt vmcnt(0)" ::: "memory");
    } else {
      XB_SPIN(xb_ld(&bar[XB_XGEN(b.x)]) == gen, bar);
      __builtin_amdgcn_fence(__ATOMIC_ACQUIRE, "agent");
      asm volatile("s_waitcnt vmcnt(0)" ::: "memory");
    }
  }
  __syncthreads();
}

template <bool SCALE>
DI void transpose_w(const float* __restrict__ W, int ldw, int K, int NP, int NV, u16* __restrict__ wt,
                    const float* __restrict__ scale, bool remap, size_t gtid, size_t gsz) {
  const int kchunks = K / 8;
  for (size_t it = gtid; it < (size_t)NP * kchunks; it += gsz) {
    int j = (int)(it % NP), kc = (int)(it / NP);
    uint4 o = make_uint4(0, 0, 0, 0);
    if (j < NV) {
      int src = j;
      if (remap) src = j < 2048 ? j : (j < 4480 ? j + 8 : (j < 4488 ? 2048 + (j - 4480) : j));
      float v[8];
#pragma unroll
      for (int i = 0; i < 8; ++i) {
        v[i] = W[(size_t)(kc * 8 + i) * ldw + src];
        if (SCALE) v[i] *= scale[kc * 8 + i];
      }
      o.x = pack2(v[0], v[1]); o.y = pack2(v[2], v[3]); o.z = pack2(v[4], v[5]); o.w = pack2(v[6], v[7]);
    }
    *(uint4*)(wt + (size_t)j * K + kc * 8) = o;
  }
}

DI void phase0(const Params& P) {
  const int tid = otid(), lane = tid & 63, wave = tid >> 6;
  const size_t gtid = (size_t)blockIdx.x * 256 + tid, gsz = (size_t)gridDim.x * 256;
  char* ws = P.ws;
  transpose_w<false>(P.w_in, 4496, 1024, 4608, 4496, (u16*)(ws + OFF_WT_IN), nullptr, true, gtid, gsz);
  transpose_w<false>(P.w_out, 1024, 1024, 1024, 1024, (u16*)(ws + OFF_WT_OUT), nullptr, false, gtid, gsz);
  transpose_w<true>(P.w_ple_gate, 1024, 1024, 1024, 1024, (u16*)(ws + OFF_WT_GATE), P.ple_gate_norm_w, false, gtid, gsz);
  transpose_w<false>(P.w_ple, 1024, 256, 1024, 1024, (u16*)(ws + OFF_WT_PLE), nullptr, false, gtid, gsz);
  {
    u16* pb = (u16*)(ws + OFF_PB);
    for (size_t it = gtid; it < (size_t)T_ * 256 / 8; it += gsz) {
      float4 a = *(const float4*)(P.p + it * 8), b = *(const float4*)(P.p + it * 8 + 4);
      uint4 o; o.x = pack2(a.x, a.y); o.y = pack2(a.z, a.w); o.z = pack2(b.x, b.y); o.w = pack2(b.z, b.w);
      *(uint4*)(pb + it * 8) = o;
    }
  }
  {
    float* ss = (float*)(ws + OFF_SUMSQ);
    for (size_t it = gtid; it < (size_t)T_; it += gsz) ss[it] = 0.f;
  }
  {
    u16* H = (u16*)(ws + OFF_H);
    const int gw = blockIdx.x * 4 + wave, nw = gridDim.x * 4;
    for (int row0 = gw * 4; row0 < T_; row0 += nw * 4) {
      float4 v[4][4];
#pragma unroll
      for (int rr = 0; rr < 4; ++rr)
#pragma unroll
        for (int i = 0; i < 4; ++i) v[rr][i] = *(const float4*)(P.x + (size_t)(row0 + rr) * 1024 + lane * 4 + 256 * i);
      float4 g[4];
#pragma unroll
      for (int i = 0; i < 4; ++i) g[i] = *(const float4*)(P.attn_norm_w + lane * 4 + 256 * i);
#pragma unroll
      for (int rr = 0; rr < 4; ++rr) {
        float ss = 0.f;
#pragma unroll
        for (int i = 0; i < 4; ++i) ss += v[rr][i].x * v[rr][i].x + v[rr][i].y * v[rr][i].y + v[rr][i].z * v[rr][i].z + v[rr][i].w * v[rr][i].w;
#pragma unroll
        for (int d = 1; d < 64; d <<= 1) ss += __shfl_xor(ss, d);
        const float r = rsqrtf(ss * (1.f / 1024.f) + EPS);
#pragma unroll
        for (int i = 0; i < 4; ++i) {
          uint2 o; o.x = pack2(v[rr][i].x * r * g[i].x, v[rr][i].y * r * g[i].y); o.y = pack2(v[rr][i].z * r * g[i].z, v[rr][i].w * r * g[i].w);
          *(uint2*)(H + (size_t)(row0 + rr) * 1024 + lane * 4 + 256 * i) = o;
        }
      }
    }
  }
}

template <int MT>
DI void gemm_mainloop(const u16* __restrict__ A, int lda, const u16* __restrict__ Bt, int ldb, int K, int m0, int n0,
                      char* lds, f32x16 (&acc)[MT][2]) {
  const int tid = otid(), lane = tid & 63, wave = tid >> 6;
  const int wm = wave & 1, wn = wave >> 1, l31 = lane & 31, hh = lane >> 5;
  constexpr int BM = 64 * MT;
  char* ldsA = lds;
  char* ldsB = lds + BM * 128;
  const int lrow = tid >> 3, kc = tid & 7;
  const u16* ga = A + (size_t)(m0 + lrow) * lda + kc * 8;
  const u16* gb = Bt + (size_t)(n0 + lrow) * ldb + kc * 8;
  u32x4 ra[2 * MT], rb[4];
#pragma unroll
  for (int i = 0; i < 2 * MT; ++i) ra[i] = *(const u32x4*)(ga + (size_t)(32 * i) * lda);
#pragma unroll
  for (int i = 0; i < 4; ++i) rb[i] = *(const u32x4*)(gb + (size_t)(32 * i) * ldb);
  const int woff = lrow * 128 + ((kc ^ ((lrow >> 1) & 7)) << 4);
  const int nk = K >> 6;
  for (int kt = 0; kt < nk; ++kt) {
    __syncthreads();
#pragma unroll
    for (int i = 0; i < 2 * MT; ++i) *(u32x4*)(ldsA + woff + i * 4096) = ra[i];
#pragma unroll
    for (int i = 0; i < 4; ++i) *(u32x4*)(ldsB + woff + i * 4096) = rb[i];
    __syncthreads();
    if (kt + 1 < nk) {
#pragma unroll
      for (int i = 0; i < 2 * MT; ++i) ra[i] = *(const u32x4*)(ga + (size_t)(32 * i) * lda + (kt + 1) * 64);
#pragma unroll
      for (int i = 0; i < 4; ++i) rb[i] = *(const u32x4*)(gb + (size_t)(32 * i) * ldb + (kt + 1) * 64);
    }
#pragma unroll
    for (int s = 0; s < 4; ++s) {
      bf16x8 af[MT], bfr[2];
      const int c = 2 * s + hh;
#pragma unroll
      for (int i = 0; i < MT; ++i) {
        int row = wm * (32 * MT) + i * 32 + l31;
        af[i] = *(const bf16x8*)(ldsA + row * 128 + ((c ^ ((row >> 1) & 7)) << 4));
      }
#pragma unroll
      for (int j = 0; j < 2; ++j) {
        int rowb = wn * 64 + j * 32 + l31;
        bfr[j] = *(const bf16x8*)(ldsB + rowb * 128 + ((c ^ ((rowb >> 1) & 7)) << 4));
      }
#pragma unroll
      for (int i = 0; i < MT; ++i)
#pragma unroll
        for (int j = 0; j < 2; ++j) acc[i][j] = MFMA32(af[i], bfr[j], acc[i][j]);
    }
  }
}

DI void phase1(const Params& P, char* lds) {
  char* ws = P.ws;
  const u16* H = (const u16*)(ws + OFF_H);
  const u16* WT = (const u16*)(ws + OFF_WT_IN);
  const int lane = otid() & 63, wave = otid() >> 6;
  const int wm = wave & 1, wn = wave >> 1, l31 = lane & 31, hh = lane >> 5;
  const bool xswz = (gridDim.x & 7) == 0;
  const int xq = blockIdx.x >> 3, xn = gridDim.x >> 3, xx = blockIdx.x & 7;
  for (int tile = xswz ? xq : (int)blockIdx.x; tile < (xswz ? 8 * 36 : 64 * 36); tile += (xswz ? xn : (int)gridDim.x)) {
    const int mt = xswz ? 8 * xx + (tile & 7) : tile / 36, nt = xswz ? (tile >> 3) : tile % 36;
    f32x16 acc[4][2];
#pragma unroll
    for (int i = 0; i < 4; ++i)
#pragma unroll
      for (int j = 0; j < 2; ++j) acc[i][j] = zero16();
    gemm_mainloop<4>(H, 1024, WT, 1024, 1024, mt * 256, nt * 128, lds, acc);
    const int n0 = nt * 128;
    if (n0 < 4480) {
      u16* base; int ld, c0;
      if (n0 < 1536) { base = (u16*)(ws + OFF_QKV); ld = 1536; c0 = n0; }
      else if (n0 < 2048) { base = (u16*)(ws + OFF_AZ); ld = 512; c0 = n0 - 1536; }
      else if (n0 < 2560) { base = (u16*)(ws + OFF_BQ); ld = 512; c0 = n0 - 2048; }
      else if (n0 < 2816) { base = (u16*)(ws + OFF_BKV); ld = 256; c0 = n0 - 2560; }
      else if (n0 < 3328) { base = (u16*)(ws + OFF_BZ); ld = 512; c0 = n0 - 2816; }
      else if (n0 < 4352) { base = (u16*)(ws + OFF_IQ); ld = 1024; c0 = n0 - 3328; }
      else { base = (u16*)(ws + OFF_IK); ld = 128; c0 = n0 - 4352; }
      const bool qn = (n0 >= 2048 && n0 < 2560), kn = (n0 == 2560);
      float w0 = 1.f, w1 = 1.f;
      if (qn) { w0 = P.b_q_norm_w[l31] * 0.125f; w1 = P.b_q_norm_w[32 + l31] * 0.125f; }
      if (kn) { w0 = P.b_k_norm_w[l31]; w1 = P.b_k_norm_w[32 + l31]; }
      const int rowbase = mt * 256 + wm * 128;
      char* p0; int rs, ts, c1;
      if (n0 == 4352) {
        const int ca = wn * 64 + l31;
        p0 = (char*)base + (size_t)(rowbase >> 5) * 8192 + hh * 64 + ((ca >> 4) * 512 + ((ca >> 3) & 1) * 256 + (ca & 7)) * 2;
        rs = 16; ts = 8192; c1 = 2048;
      } else {
        p0 = (char*)base + ((size_t)(rowbase + 4 * hh) * ld + c0 + wn * 64 + l31) * 2;
        rs = ld * 2; ts = 64 * ld; c1 = 64;
      }
#pragma unroll
      for (int i = 0; i < 4; ++i) {
        char* pr = p0 + (size_t)i * ts;
#pragma unroll
        for (int r = 0; r < 16; ++r) {
          float v0 = acc[i][0][r], v1 = acc[i][1][r];
          if (qn || kn) {
            float ss = v0 * v0 + v1 * v1;
            ss += dpp_xor1(ss); ss += dpp_xor2(ss); ss += __shfl_xor(ss, 4); ss += dpp_xor8(ss); ss += __shfl_xor(ss, 16);
            const float rsq = rsqrtf(ss * (1.f / 64.f) + EPS);
            v0 *= rsq * w0; v1 *= rsq * w1;
          }
          *(u16*)pr = f2bf(v0);
          *(u16*)(pr + c1) = f2bf(v1);
          pr += ((r & 3) == 3) ? 5 * rs : rs;
          asm volatile("" : "+v"(pr));
        }
      }
    } else {
      if (wn == 0 && l31 < 16) {
        float* sp = (float*)(ws + OFF_SMALL) + (size_t)(mt * 256 + wm * 128 + 4 * hh) * 16 + l31;
#pragma unroll
        for (int i = 0; i < 4; ++i)
#pragma unroll
          for (int r = 0; r < 16; ++r) {
            *sp = acc[i][0][r];
            sp += ((r & 3) == 3) ? 5 * 16 : 16;
            asm volatile("" : "+v"(sp));
          }
      }
    }
  }
}

DI void knorm_all(const Params& P) {
  const int lane = otid() & 63, wave = otid() >> 6;
  u32* BKV = (u32*)(P.ws + OFF_BKV);
  const int gw = blockIdx.x * 4 + wave, nw = gridDim.x * 4;
  const float w0 = P.b_k_norm_w[(2 * lane) & 63], w1 = P.b_k_norm_w[(2 * lane + 1) & 63];
  for (int tok = gw; tok < T_; tok += nw) {
    u32 v = BKV[(size_t)tok * 128 + lane];
    float a = bflo(v), b = bfhi(v);
    float ss = a * a + b * b;
#pragma unroll
    for (int d = 1; d < 32; d <<= 1) ss += __shfl_xor(ss, d);
    float r = rsqrtf(ss * (1.f / 64.f) + EPS);
    BKV[(size_t)tok * 128 + lane] = pack2(a * r * w0, b * r * w1);
  }
}

DI int perm16(int x) { return (x & 3) | ((x & 8) >> 1) | ((x & 4) << 1); }

DI void ka1_item(const Params& P, int ch, char* lds) {
  const int tid = otid(), lane = tid & 63, wave = tid >> 6, hh = lane >> 5, l31 = lane & 31;
  const int b = ch >> 8, h = (ch >> 6) & 3, n = ch & 63;
  const int tok0 = b * 4096 + n * 64;
  char* ws = P.ws;
  u16* QV = (u16*)lds;
  u16* Ks = (u16*)(lds + 18432);
  u16* KBT = (u16*)(lds + 18432 + 17408);
  float* Am = (float*)(lds + 18432 + 17408 + 18432);
  u16* Tm = Ks;
  float* sm = (float*)(lds + 18432 + 17408 + 18432 + 16384);
  const u16* QKV = (const u16*)(ws + OFF_QKV);
  const float* SMALL = (const float*)(ws + OFF_SMALL);
  u16* QD = (u16*)(ws + OFF_QD) + (size_t)ch * 8192;
  u16* ATT = (u16*)(ws + OFF_ATT) + (size_t)ch * 4096;
  u16* KDT = (u16*)(ws + OFF_KDT) + (size_t)ch * 8192;
  u16* WNEG = (u16*)(ws + OFF_WNEG) + (size_t)ch * 8192;
  u16* UT = (u16*)(ws + OFF_UT) + (size_t)ch * 8192;
  __syncthreads();
  if (wave == 0) {
    float ab = SMALL[(size_t)(tok0 + lane) * 16 + h];
    float aa = SMALL[(size_t)(tok0 + lane) * 16 + 4 + h];
    float beta = sigmoidf_(ab);
    float xs = aa + P.dt_bias[h];
    float sp = fmaxf(xs, 0.f) + log1pf(__expf(-fabsf(xs)));
    float g = -__expf(P.a_log[h]) * sp;
#pragma unroll
    for (int d = 1; d < 64; d <<= 1) { float t = __shfl_up(g, d); if (lane >= d) g += t; }
    float glast = __shfl(g, 63);
    sm[lane] = g; sm[64 + lane] = beta; sm[128 + lane] = __expf(g); sm[192 + lane] = __expf(glast - g);
  }
  __syncthreads();
  const float* cw = P.conv_w;
  {
    const int cq = h * 128 + 2 * lane, ck = 512 + cq;
    float wq[4][2], wk[4][2];
#pragma unroll
    for (int j = 0; j < 4; ++j) {
      wq[j][0] = cw[j * 1536 + cq]; wq[j][1] = cw[j * 1536 + cq + 1];
      wk[j][0] = cw[j * 1536 + ck]; wk[j][1] = cw[j * 1536 + ck + 1];
    }
    const int i0 = wave * 16;
    float xq[3][2], xk[3][2];
#pragma unroll
    for (int j = 0; j < 3; ++j) {
      int pos = n * 64 + i0 - 3 + j;
      u32 vq = 0, vk = 0;
      if (pos >= 0) {
        const u16* rp = QKV + (size_t)(tok0 + i0 - 3 + j) * 1536;
        vq = *(const u32*)(rp + cq); vk = *(const u32*)(rp + ck);
      }
      xq[j][0] = bflo(vq); xq[j][1] = bfhi(vq); xk[j][0] = bflo(vk); xk[j][1] = bfhi(vk);
    }
    u32 rq_[16], rk_[16];
#pragma unroll
    for (int ii = 0; ii < 16; ++ii) {
      const u16* rp = QKV + (size_t)(tok0 + i0 + ii) * 1536;
      rq_[ii] = *(const u32*)(rp + cq); rk_[ii] = *(const u32*)(rp + ck);
    }
#pragma unroll
    for (int ii = 0; ii < 16; ++ii) {
      const int i = i0 + ii;
      const u32 vq = rq_[ii], vk = rk_[ii];
      float cq0 = bflo(vq), cq1 = bfhi(vq), ck0 = bflo(vk), ck1 = bfhi(vk);
      float yq0 = wq[0][0] * xq[0][0] + wq[1][0] * xq[1][0] + wq[2][0] * xq[2][0] + wq[3][0] * cq0;
      float yq1 = wq[0][1] * xq[0][1] + wq[1][1] * xq[1][1] + wq[2][1] * xq[2][1] + wq[3][1] * cq1;
      float yk0 = wk[0][0] * xk[0][0] + wk[1][0] * xk[1][0] + wk[2][0] * xk[2][0] + wk[3][0] * ck0;
      float yk1 = wk[0][1] * xk[0][1] + wk[1][1] * xk[1][1] + wk[2][1] * xk[2][1] + wk[3][1] * ck1;
      xq[0][0] = xq[1][0]; xq[0][1] = xq[1][1]; xq[1][0] = xq[2][0]; xq[1][1] = xq[2][1]; xq[2][0] = cq0; xq[2][1] = cq1;
      xk[0][0] = xk[1][0]; xk[0][1] = xk[1][1]; xk[1][0] = xk[2][0]; xk[1][1] = xk[2][1]; xk[2][0] = ck0; xk[2][1] = ck1;
      yq0 = siluf_(yq0); yq1 = siluf_(yq1); yk0 = siluf_(yk0); yk1 = siluf_(yk1);
      float sq = yq0 * yq0 + yq1 * yq1, sk = yk0 * yk0 + yk1 * yk1;
#pragma unroll
      for (int d = 1; d < 64; d <<= 1) { sq += __shfl_xor(sq, d); sk += __shfl_xor(sk, d); }
      const float rq = rsqrtf(sq + EPS) * 0.08838834764831845f, rk = rsqrtf(sk + EPS);
      yq0 *= rq; yq1 *= rq; yk0 *= rk; yk1 *= rk;
      *(u32*)(QV + i * 136 + 2 * lane) = pack2(yq0, yq1);
      *(u32*)(Ks + i * 136 + 2 * lane) = pack2(yk0, yk1);
      KBT[(2 * lane) * 72 + i] = f2bf(yk0);
      KBT[(2 * lane + 1) * 72 + i] = f2bf(yk1);
      const float eg = sm[128 + i];
      *(u32*)(QD + i * 128 + 2 * lane) = pack2(yq0 * eg, yq1 * eg);
    }
  }
  __syncthreads();
  {
    const int mt = wave & 1, nt = wave >> 1;
    f32x16 akk = zero16(), aqk = zero16();
#pragma unroll
    for (int s = 0; s < 8; ++s) {
      const int kof = 16 * s + 8 * hh;
      bf16x8 aq = *(const bf16x8*)(QV + (32 * mt + l31) * 136 + kof);
      bf16x8 ak = *(const bf16x8*)(Ks + (32 * mt + l31) * 136 + kof);
      bf16x8 bk = *(const bf16x8*)(Ks + (32 * nt + l31) * 136 + kof);
      akk = MFMA32(ak, bk, akk);
      aqk = MFMA32(aq, bk, aqk);
    }
    const int j = 32 * nt + l31;
    const float gj = sm[j];
#pragma unroll
    for (int r = 0; r < 16; ++r) {
      const int i = 32 * mt + (r & 3) + 8 * (r >> 2) + 4 * hh;
      const float gi = sm[i], bi = sm[64 + i];
      const float dec = (j <= i) ? __expf(gi - gj) : 0.f;
      Am[i * 64 + j] = (j < i) ? bi * akk[r] * dec : 0.f;
      ATT[i * 64 + j] = f2bf(aqk[r] * dec);
    }
  }
  {
    const int dk = tid >> 1, th = tid & 1;
    u16* kr = KBT + dk * 72 + th * 32;
#pragma unroll
    for (int g2 = 0; g2 < 2; ++g2) {
      u16 ov[16];
#pragma unroll
      for (int x = 0; x < 16; ++x) {
        const int tok = th * 32 + g2 * 16 + x;
        const float kv = bf2f(kr[g2 * 16 + x]);
        ov[perm16(x)] = f2bf(kv * sm[192 + tok]);
        kr[g2 * 16 + x] = f2bf(kv * sm[64 + tok] * sm[128 + tok]);
      }
      uint4 o0, o1;
      o0.x = ov[0] | ((u32)ov[1] << 16); o0.y = ov[2] | ((u32)ov[3] << 16); o0.z = ov[4] | ((u32)ov[5] << 16); o0.w = ov[6] | ((u32)ov[7] << 16);
      o1.x = ov[8] | ((u32)ov[9] << 16); o1.y = ov[10] | ((u32)ov[11] << 16); o1.z = ov[12] | ((u32)ov[13] << 16); o1.w = ov[14] | ((u32)ov[15] << 16);
      *(uint4*)(KDT + dk * 64 + th * 32 + g2 * 16) = o0;
      *(uint4*)(KDT + dk * 64 + th * 32 + g2 * 16 + 8) = o1;
    }
  }
  __syncthreads();
  {
    u16* VBT = QV;
    const int cv = 1024 + h * 128 + 2 * lane;
    float wv[4][2];
#pragma unroll
    for (int j = 0; j < 4; ++j) { wv[j][0] = cw[j * 1536 + cv]; wv[j][1] = cw[j * 1536 + cv + 1]; }
    const int i0 = wave * 16;
    float xv[3][2];
#pragma unroll
    for (int j = 0; j < 3; ++j) {
      int pos = n * 64 + i0 - 3 + j;
      u32 vv = 0;
      if (pos >= 0) vv = *(const u32*)(QKV + (size_t)(tok0 + i0 - 3 + j) * 1536 + cv);
      xv[j][0] = bflo(vv); xv[j][1] = bfhi(vv);
    }
    u32 rv_[16];
#pragma unroll
    for (int ii = 0; ii < 16; ++ii) rv_[ii] = *(const u32*)(QKV + (size_t)(tok0 + i0 + ii) * 1536 + cv);
#pragma unroll
    for (int ii = 0; ii < 16; ++ii) {
      const int i = i0 + ii;
      const u32 vv = rv_[ii];
      float c0 = bflo(vv), c1 = bfhi(vv);
      float y0 = wv[0][0] * xv[0][0] + wv[1][0] * xv[1][0] + wv[2][0] * xv[2][0] + wv[3][0] * c0;
      float y1 = wv[0][1] * xv[0][1] + wv[1][1] * xv[1][1] + wv[2][1] * xv[2][1] + wv[3][1] * c1;
      xv[0][0] = xv[1][0]; xv[0][1] = xv[1][1]; xv[1][0] = xv[2][0]; xv[1][1] = xv[2][1]; xv[2][0] = c0; xv[2][1] = c1;
      const float bi = sm[64 + i];
      VBT[(2 * lane) * 72 + i] = f2bf(siluf_(y0) * bi);
      VBT[(2 * lane + 1) * 72 + i] = f2bf(siluf_(y1) * bi);
    }
  }
  if (wave == 0) {
    float Tc[63];
#pragma unroll
    for (int i = 0; i < 64; ++i) {
      float a = (i == lane) ? 1.f : 0.f;
#pragma unroll
      for (int j = 0; j < i; ++j) a -= Am[i * 64 + j] * Tc[j];
      if (i < 63) Tc[i] = a;
      Tm[i * 72 + lane] = f2bf(a);
      if ((i & 3) == 3) __builtin_amdgcn_sched_barrier(0);
    }
  }
  __syncthreads();
  {
    const u16* VBT = QV;
    f32x16 c0 = zero16(), c1 = zero16(), d0 = zero16(), d1 = zero16();
#pragma unroll
    for (int s = 0; s < 4; ++s) {
      const int kof = 16 * s + 8 * hh;
      bf16x8 t0 = *(const bf16x8*)(Tm + l31 * 72 + kof);
      bf16x8 t1 = *(const bf16x8*)(Tm + (32 + l31) * 72 + kof);
      bf16x8 a = *(const bf16x8*)(KBT + (32 * wave + l31) * 72 + kof);
      bf16x8 bv = *(const bf16x8*)(VBT + (32 * wave + l31) * 72 + kof);
      c0 = MFMA32(a, t0, c0);
      c1 = MFMA32(a, t1, c1);
      d0 = MFMA32(t0, bv, d0);
      d1 = MFMA32(t1, bv, d1);
    }
#pragma unroll
    for (int rg = 0; rg < 4; ++rg) {
      const int dkpos = 16 * (2 * wave + (rg >> 1)) + 8 * hh + 4 * (rg & 1);
      uint2 o;
      o.x = pack2(-c0[4 * rg], -c0[4 * rg + 1]); o.y = pack2(-c0[4 * rg + 2], -c0[4 * rg + 3]);
      *(uint2*)(WNEG + (l31) * 128 + dkpos) = o;
      o.x = pack2(-c1[4 * rg], -c1[4 * rg + 1]); o.y = pack2(-c1[4 * rg + 2], -c1[4 * rg + 3]);
      *(uint2*)(WNEG + (32 + l31) * 128 + dkpos) = o;
      const int dv = 32 * wave + l31;
      o.x = pack2(d0[4 * rg], d0[4 * rg + 1]); o.y = pack2(d0[4 * rg + 2], d0[4 * rg + 3]);
      *(uint2*)(UT + rg * 1024 + dv * 8 + 4 * hh) = o;
      o.x = pack2(d1[4 * rg], d1[4 * rg + 1]); o.y = pack2(d1[4 * rg + 2], d1[4 * rg + 3]);
      *(uint2*)(UT + (4 + rg) * 1024 + dv * 8 + 4 * hh) = o;
    }
    if (tid == 0) ((float*)(ws + OFF_GL))[ch] = sm[128 + 63];
  }
}

#define ATT_UNROLL 4
typedef __bf16 bf2_t __attribute__((ext_vector_type(2)));
DI float fdot2(u32 a, u32 b, float c) { return __builtin_amdgcn_fdot2_f32_bf16(__builtin_bit_cast(bf2_t, a), __builtin_bit_cast(bf2_t, b), c, false); }
DI float dot8(const uint4& k, const u32* q, float acc) {
  acc = fdot2(k.x, q[0], acc);
  acc = fdot2(k.y, q[1], acc);
  acc = fdot2(k.z, q[2], acc);
  acc = fdot2(k.w, q[3], acc);
  return acc;
}

DI void kb2_query(const Params& P, int t, float* Sw, const u16* idxp) {
  const int lane = otid() & 63;
  char* ws = P.ws;
  const int b = t >> 12, pos = t & 4095;
  const int nvalid = pos + 1 < 256 ? pos + 1 : 256;
  const bool uselist = pos >= 255;
  const u16* BKVb = (const u16*)(ws + OFF_BKV) + (size_t)b * 4096 * 256;
  float inv;
  {
    const int l15 = lane & 15, g4 = lane >> 4;
    bf16x8 qf[4];
    {
      const u16* qrow = (const u16*)(ws + OFF_BQ) + (size_t)t * 512;
#pragma unroll
      for (int s = 0; s < 4; ++s) {
        bf16x8 z = {0, 0, 0, 0, 0, 0, 0, 0};
        if (l15 < 8 && (l15 >> 2) == (s >> 1)) z = *(const bf16x8*)(qrow + l15 * 64 + 32 * (s & 1) + 8 * g4);
        qf[s] = z;
      }
    }
    float sum = 0.f;
#pragma unroll 4
    for (int tau = 0; tau < 16; ++tau) {
      const int slotA = 16 * tau + l15;
      int kidx = uselist ? (int)idxp[slotA] : slotA;
      if (slotA >= nvalid) kidx = 0;
      const u16* row = BKVb + (size_t)kidx * 256 + 8 * g4;
      bf16x8 ka[4];
#pragma unroll
      for (int s = 0; s < 4; ++s) ka[s] = *(const bf16x8*)(row + 32 * s);
      f32x4 c = zero4();
#pragma unroll
      for (int s = 0; s < 4; ++s) c = MFMA16(ka[s], qf[s], c);
#pragma unroll
      for (int r = 0; r < 4; ++r) {
        const int slot = 16 * tau + 4 * g4 + r;
        const float pe = (slot < nvalid) ? __expf(c[r]) : 0.f;
        sum += pe;
        if (l15 < 8) Sw[slot * 8 + l15] = pe;
      }
    }
    sum += __shfl_xor(sum, 16); sum += __shfl_xor(sum, 32);
    inv = 1.f / sum;
  }
  const int dc = (lane & 3) | (((lane >> 3) & 1) << 2);
  const int ks = ((lane >> 2) & 1) | ((lane >> 4) << 1);
  float o[8][8];
#pragma unroll
  for (int hd = 0; hd < 8; ++hd)
#pragma unroll
    for (int d = 0; d < 8; ++d) o[hd][d] = 0.f;
#pragma unroll ATT_UNROLL
  for (int it = 0; it < 32; ++it) {
    const int slot = it * 8 + ks;
    int kidx = uselist ? (int)idxp[slot] : slot;
    if (slot >= nvalid) kidx = 0;
    const u16* row = BKVb + (size_t)kidx * 256;
    const uint4 v0 = *(const uint4*)(row + 128 + dc * 8);
    const uint4 v1 = *(const uint4*)(row + 192 + dc * 8);
    const f32x4 pa = *(const f32x4*)(Sw + slot * 8);
    const f32x4 pb = *(const f32x4*)(Sw + slot * 8 + 4);
    float f0[8] = {bflo(v0.x), bfhi(v0.x), bflo(v0.y), bfhi(v0.y), bflo(v0.z), bfhi(v0.z), bflo(v0.w), bfhi(v0.w)};
    float f1[8] = {bflo(v1.x), bfhi(v1.x), bflo(v1.y), bfhi(v1.y), bflo(v1.z), bfhi(v1.z), bflo(v1.w), bfhi(v1.w)};
#pragma unroll
    for (int r = 0; r < 4; ++r) {
#pragma unroll
      for (int d = 0; d < 8; ++d) { o[r][d] += pa[r] * f0[d]; o[4 + r][d] += pb[r] * f1[d]; }
    }
  }
  float o4[4][8];
  {
    const bool up = ks & 4;
#pragma unroll
    for (int i = 0; i < 4; ++i)
#pragma unroll
      for (int d = 0; d < 8; ++d) { float keep = up ? o[4 + i][d] : o[i][d]; float send = up ? o[i][d] : o[4 + i][d]; o4[i][d] = keep + __shfl_xor(send, 32); }
  }
  float o2[2][8];
  {
    const bool up = ks & 2;
#pragma unroll
    for (int i = 0; i < 2; ++i)
#pragma unroll
      for (int d = 0; d < 8; ++d) { float keep = up ? o4[2 + i][d] : o4[i][d]; float send = up ? o4[i][d] : o4[2 + i][d]; o2[i][d] = keep + __shfl_xor(send, 16); }
  }
  float o1[8];
  {
    const bool up = ks & 1;
#pragma unroll
    for (int d = 0; d < 8; ++d) { float keep = up ? o2[1][d] : o2[0][d]; float send = up ? o2[0][d] : o2[1][d]; o1[d] = keep + __shfl_xor(send, 4); }
  }
  const float invh = __shfl(inv, ks);
  const u16* bz = (const u16*)(ws + OFF_BZ) + (size_t)t * 512 + ks * 64 + dc * 8;
  uint4 zz = *(const uint4*)bz;
  float zf[8] = {bflo(zz.x), bfhi(zz.x), bflo(zz.y), bfhi(zz.y), bflo(zz.z), bfhi(zz.z), bflo(zz.w), bfhi(zz.w)};
  uint4 ov;
  ov.x = pack2(o1[0] * invh * siluf_(zf[0]), o1[1] * invh * siluf_(zf[1]));
  ov.y = pack2(o1[2] * invh * siluf_(zf[2]), o1[3] * invh * siluf_(zf[3]));
  ov.z = pack2(o1[4] * invh * siluf_(zf[4]), o1[5] * invh * siluf_(zf[5]));
  ov.w = pack2(o1[6] * invh * siluf_(zf[6]), o1[7] * invh * siluf_(zf[7]));
  *(uint4*)((u16*)(ws + OFF_MIXB) + (size_t)t * 512 + ks * 64 + dc * 8) = ov;
}

DI void kb_item(const Params& P, int item, char* lds) {
  const int tid = otid();
  const int lane = tid & 63, wave = __builtin_amdgcn_readfirstlane(tid >> 6), hh = lane >> 5, l31 = lane & 31;
  const int b = item & 3, qt = 1023 - (item >> 2), t0 = qt * 4;
  char* ws = P.ws;
  float* Sl = (float*)lds;
  u16* myidx = (u16*)(lds + wave * 16384);
  float* mySw = (float*)(lds + wave * 16384 + 1024);
  if (t0 + 3 < 255) {
    __syncthreads();
    kb2_query(P, b * 4096 + t0 + wave, mySw, myidx);
    return;
  }
  const u16* IQ = (const u16*)(ws + OFF_IQ);
  const u16* IK = (const u16*)(ws + OFF_IK);
  const float* SMALL = (const float*)(ws + OFF_SMALL);
  const int T0 = b * 4096 + t0;
  __syncthreads();
  {
    bf16x8 af[8];
    const u16* src = IQ + (size_t)(T0 + ((l31 >> 2) & 1) + 2 * ((l31 >> 4) & 1)) * 1024 + ((l31 & 3) + 4 * ((l31 >> 3) & 1)) * 128 + 8 * hh;
#pragma unroll
    for (int s = 0; s < 8; ++s) af[s] = *(const bf16x8*)(src + 16 * s);
    float wv[16];
#pragma unroll
    for (int r = 0; r < 16; ++r) wv[r] = SMALL[(size_t)(T0 + hh + 2 * (r >> 3)) * 16 + 8 + (r & 3) + 4 * ((r >> 2) & 1)] * 0.03125f;
    const int ntile = (t0 + 4 + 31) >> 5;
    const u16* kbase = IK + (size_t)b * 128 * 4096 + lane * 8;
    const int nmine = ntile > wave ? (ntile - wave + 3) >> 2 : 0;
    bf16x8 c0[8], c1[8];
    {
      const int k0 = wave, k1 = nmine > 1 ? wave + 4 : wave;
      if (nmine > 0) {
#pragma unroll
        for (int s = 0; s < 8; ++s) { c0[s] = *(const bf16x8*)(kbase + (size_t)k0 * 4096 + 512 * s); c1[s] = *(const bf16x8*)(kbase + (size_t)k1 * 4096 + 512 * s); }
      }
    }
    for (int j = 0; j < nmine; j += 2) {
      const int kt0 = wave + 4 * j, kt1 = kt0 + 4;
      const bool has1 = j + 1 < nmine;
      bf16x8 n0[8], n1[8];
      {
        const int ka = j + 2 < nmine ? kt0 + 8 : kt0, kb2 = j + 3 < nmine ? kt0 + 12 : kt0;
#pragma unroll
        for (int s = 0; s < 8; ++s) { n0[s] = *(const bf16x8*)(kbase + (size_t)ka * 4096 + 512 * s); n1[s] = *(const bf16x8*)(kbase + (size_t)kb2 * 4096 + 512 * s); }
      }
      f32x16 acc0 = zero16(), acc1 = zero16();
#pragma unroll
      for (int s = 0; s < 8; ++s) { acc0 = MFMA32(af[s], c0[s], acc0); acc1 = MFMA32(af[s], c1[s], acc1); }
#pragma unroll
      for (int s = 0; s < 8; ++s) { c0[s] = n0[s]; c1[s] = n1[s]; }
      float sa0 = 0.f, sa1 = 0.f, sb0 = 0.f, sb1 = 0.f;
#pragma unroll
      for (int i = 0; i < 8; ++i) {
        sa0 += wv[i] * fmaxf(acc0[i], 0.f); sa1 += wv[8 + i] * fmaxf(acc0[8 + i], 0.f);
        sb0 += wv[i] * fmaxf(acc1[i], 0.f); sb1 += wv[8 + i] * fmaxf(acc1[8 + i], 0.f);
      }
      Sl[hh * 4096 + kt0 * 32 + l31] = sa0;
      Sl[(hh + 2) * 4096 + kt0 * 32 + l31] = sa1;
      if (has1) {
        Sl[hh * 4096 + kt1 * 32 + l31] = sb0;
        Sl[(hh + 2) * 4096 + kt1 * 32 + l31] = sb1;
      }
    }
  }
  __syncthreads();
  const int pos = t0 + wave;
  if (pos >= 255) {
    const int nchunk = (pos >> 10) + 1;
    u32 key[64];
#pragma unroll
    for (int c4 = 0; c4 < 4; ++c4) {
      if (c4 < nchunk) {
#pragma unroll
        for (int ii = 0; ii < 16; ++ii) {
          const int i = c4 * 16 + ii;
          const int idx = lane + 64 * i;
          float v = Sl[wave * 4096 + idx] + 0.0f;
          u32 u = __float_as_uint(v);
          u = (u & 0x80000000u) ? ~u : (u | 0x80000000u);
          key[i] = (idx <= pos) ? u : 0u;
        }
      } else {
#pragma unroll
        for (int ii = 0; ii < 16; ++ii) key[c4 * 16 + ii] = 0u;
      }
    }
    u32 g0 = key[0], g1 = key[1], g2 = key[2], g3 = key[3];
#pragma unroll
    for (int i = 4; i < 64; i += 4) { g0 = max(g0, key[i]); g1 = max(g1, key[i + 1]); g2 = max(g2, key[i + 2]); g3 = max(g3, key[i + 3]); }
    u32 lo = min(min(g0, g1), min(g2, g3)), hi = max(max(g0, g1), max(g2, g3));
#pragma unroll
    for (int d = 1; d < 64; d <<= 1) { lo = min(lo, (u32)__shfl_xor((int)lo, d)); hi = max(hi, (u32)__shfl_xor((int)hi, d)); }
    lo = __builtin_amdgcn_readfirstlane(lo); hi = __builtin_amdgcn_readfirstlane(hi);
    const u32 diff = lo ^ hi;
    const int topbit = diff ? 31 - __builtin_clz(diff) : -1;
    u32 Pv = topbit >= 31 ? 0u : (topbit < 0 ? lo : (lo & ~((2u << topbit) - 1u)));
    bool exact = false;
    for (int bit = topbit; bit >= 0; --bit) {
      const u32 cand = Pv | (1u << bit);
      int c = 0;
#pragma unroll
      for (int c4 = 0; c4 < 4; ++c4) {
        if (c4 < nchunk) {
#pragma unroll
          for (int ii = 0; ii < 16; ++ii) {
            c += __popcll(__ballot(key[c4 * 16 + ii] >= cand));
            if ((ii & 7) == 7) __builtin_amdgcn_sched_barrier(0);
          }
        }
      }
      if (c >= 256) {
        Pv = cand;
        if (c == 256) { exact = true; break; }
      }
    }
    int need = 1 << 30;
    if (!exact) {
      int cgt = 0;
#pragma unroll
      for (int c4 = 0; c4 < 4; ++c4) {
        if (c4 < nchunk) {
#pragma unroll
          for (int ii = 0; ii < 16; ++ii) {
            cgt += __popcll(__ballot(key[c4 * 16 + ii] > Pv));
            if ((ii & 7) == 7) __builtin_amdgcn_sched_barrier(0);
          }
        }
      }
      need = 256 - cgt;
    }
    u16* out = myidx;
    if (exact) {
      u32 mlo = 0u, mhi = 0u;
#pragma unroll
      for (int c4 = 0; c4 < 4; ++c4) {
        if (c4 < nchunk) {
#pragma unroll
          for (int ii = 0; ii < 16; ++ii) {
            const int i = c4 * 16 + ii;
            const u32 bit = (key[i] >= Pv) ? (1u << (i & 31)) : 0u;
            if (i < 32) mlo |= bit; else mhi |= bit;
          }
        }
      }
      const int cnt = __popc(mlo) + __popc(mhi);
      int incl = cnt;
#pragma unroll
      for (int d = 1; d < 64; d <<= 1) { const int tv = __shfl_up(incl, d); if (lane >= d) incl += tv; }
      int off = incl - cnt;
      while (mlo) { const int i = __ffs((int)mlo) - 1; out[off++] = (u16)(lane + 64 * i); mlo &= mlo - 1u; }
      while (mhi) { const int i = __ffs((int)mhi) - 1; out[off++] = (u16)(lane + 64 * (32 + i)); mhi &= mhi - 1u; }
    } else {
    int off = 0, eqseen = 0;
    const u64 ltmask = (1ull << lane) - 1ull;
#pragma unroll
    for (int c4 = 0; c4 < 4; ++c4) {
      if (c4 < nchunk) {
#pragma unroll
        for (int ii = 0; ii < 16; ++ii) {
          const int i = c4 * 16 + ii;
          const bool gt = key[i] > Pv, eq = key[i] == Pv;
          const u64 meq = __ballot(eq);
          const int rank = eqseen + __popcll(meq & ltmask);
          const bool sel = gt || (eq && rank < need);
          const u64 ms = __ballot(sel);
          if (sel) out[off + __popcll(ms & ltmask)] = (u16)(lane + 64 * i);
          off += __popcll(ms);
          eqseen += __popcll(meq);
          if ((ii & 3) == 3) __builtin_amdgcn_sched_barrier(0);
        }
      }
    }
    }
  }
  kb2_query(P, T0 + wave, mySw, myidx);
}

constexpr int KB_SPLIT = 1536;
DI int pull_item(unsigned* ctr, char* lds) {
  volatile LAS unsigned* slot = (volatile LAS unsigned*)(lds + LDS_BYTES - 8);
  __syncthreads();
  if (threadIdx.x == 0) *slot = __hip_atomic_fetch_add(ctr, 1u, __ATOMIC_RELAXED, __HIP_MEMORY_SCOPE_AGENT);
  __syncthreads();
  return (int)*slot;
}
DI void phase2(const Params& P, char* lds) {
  for (int it = blockIdx.x; it < 1024; it += gridDim.x) ka1_item(P, it, lds);
  if ((gridDim.x & 3) == 0) {
    const int bb = blockIdx.x & 3;
    unsigned* ctr = (unsigned*)(P.ws + OFF_BAR) + 16 * bb;
    for (;;) {
      const int k = pull_item(ctr, lds);
      if (k >= KB_SPLIT / 4) break;
      kb_item(P, 4 * k + bb, lds);
    }
  } else {
    for (int it = blockIdx.x; it < KB_SPLIT; it += gridDim.x) kb_item(P, it, lds);
  }
}

DI void ka2_scan(const Params& P, int bh, char* lds) {
  const int tid = otid(), lane = tid & 63, wave = tid >> 6, hh = lane >> 5, l31 = lane & 31;
  char* ws = P.ws;
  const int dv = 32 * wave + l31;
  const u16* WNEG = (const u16*)(ws + OFF_WNEG) + (size_t)bh * 64 * 8192;
  const u16* KDT = (const u16*)(ws + OFF_KDT) + (size_t)bh * 64 * 8192;
  const u16* UT = (const u16*)(ws + OFF_UT) + (size_t)bh * 64 * 8192 + dv * 8 + 4 * hh;
  const float* GL = (const float*)(ws + OFF_GL) + bh * 64;
  u16* HST = (u16*)((char*)P.out + OOFF_HST) + (size_t)bh * 64 * 16384 + dv * 8 + 4 * hh;
  u16* VNT = (u16*)((char*)P.out + OOFF_VNT) + (size_t)bh * 64 * 8192 + dv * 8 + 4 * hh;
  const int wbase = (tid >> 4) * 272 + ((tid & 15) << 4);
  const int kbase = 17408 + (tid >> 3) * 144 + ((tid & 7) << 4);
  u32x4 sw[4], sk[4];
  uint2 un[8];
  float gln;
  __syncthreads();
#pragma unroll
  for (int i = 0; i < 4; ++i) {
    sw[i] = *(const u32x4*)(WNEG + (size_t)(tid + 256 * i) * 8);
    sk[i] = *(const u32x4*)(KDT + (size_t)(tid + 256 * i) * 8);
  }
#pragma unroll
  for (int i = 0; i < 8; ++i) un[i] = *(const uint2*)(UT + i * 1024);
  gln = GL[0];
#pragma unroll
  for (int i = 0; i < 4; ++i) { *(u32x4*)(lds + wbase + i * 4352) = sw[i]; *(u32x4*)(lds + kbase + i * 4608) = sk[i]; }
  __syncthreads();
  f32x16 S[4];
#pragma unroll
  for (int m = 0; m < 4; ++m) S[m] = zero16();
  for (int n = 0; n < 64; ++n) {
    const char* buf = lds + (n & 1) * 35840;
    char* nbuf = lds + ((n + 1) & 1) * 35840;
    f32x16 vn[2];
#pragma unroll
    for (int tt = 0; tt < 2; ++tt) {
#pragma unroll
      for (int rg = 0; rg < 4; ++rg) {
        const uint2 u = un[4 * tt + rg];
        vn[tt][4 * rg] = bflo(u.x); vn[tt][4 * rg + 1] = bfhi(u.x); vn[tt][4 * rg + 2] = bflo(u.y); vn[tt][4 * rg + 3] = bfhi(u.y);
      }
    }
    const float gl = gln;
    if (n + 1 < 64) {
      const size_t o = (size_t)(n + 1) * 8192;
#pragma unroll
      for (int i = 0; i < 4; ++i) {
        sw[i] = *(const u32x4*)(WNEG + o + (size_t)(tid + 256 * i) * 8);
        sk[i] = *(const u32x4*)(KDT + o + (size_t)(tid + 256 * i) * 8);
      }
#pragma unroll
      for (int i = 0; i < 8; ++i) un[i] = *(const uint2*)(UT + o + i * 1024);
      gln = GL[n + 1];
    }
    u16* hst = HST + (size_t)n * 16384;
    u16* vnt = VNT + (size_t)n * 8192;
#pragma unroll
    for (int m = 0; m < 4; ++m) {
      u32 pk[8];
#pragma unroll
      for (int r = 0; r < 8; ++r) pk[r] = pack2(S[m][2 * r], S[m][2 * r + 1]);
#pragma unroll
      for (int rg = 0; rg < 4; ++rg) *(uint2*)(hst + (4 * m + rg) * 1024) = make_uint2(pk[2 * rg], pk[2 * rg + 1]);
      u32x4 f0 = {pk[0], pk[1], pk[2], pk[3]}, f1 = {pk[4], pk[5], pk[6], pk[7]};
      const bf16x8 sf0 = __builtin_bit_cast(bf16x8, f0), sf1 = __builtin_bit_cast(bf16x8, f1);
#pragma unroll
      for (int tt = 0; tt < 2; ++tt) {
        bf16x8 a0 = *(const bf16x8*)(buf + (l31 * 272 + 16 * hh) + (tt * 8704 + 32 * (2 * m)));
        bf16x8 a1 = *(const bf16x8*)(buf + (l31 * 272 + 16 * hh) + (tt * 8704 + 32 * (2 * m + 1)));
        vn[tt] = MFMA32(a0, sf0, vn[tt]);
        vn[tt] = MFMA32(a1, sf1, vn[tt]);
      }
      __builtin_amdgcn_sched_barrier(0);
    }
    bf16x8 vf[4];
#pragma unroll
    for (int tt = 0; tt < 2; ++tt) {
      u32 pk[8];
#pragma unroll
      for (int r = 0; r < 8; ++r) pk[r] = pack2(vn[tt][2 * r], vn[tt][2 * r + 1]);
#pragma unroll
      for (int rg = 0; rg < 4; ++rg) *(uint2*)(vnt + (4 * tt + rg) * 1024) = make_uint2(pk[2 * rg], pk[2 * rg + 1]);
      u32x4 f0 = {pk[0], pk[1], pk[2], pk[3]}, f1 = {pk[4], pk[5], pk[6], pk[7]};
      vf[2 * tt] = __builtin_bit_cast(bf16x8, f0);
      vf[2 * tt + 1] = __builtin_bit_cast(bf16x8, f1);
    }
#pragma unroll
    for (int m = 0; m < 4; ++m) {
#pragma unroll
      for (int r = 0; r < 16; ++r) S[m][r] *= gl;
    }
#pragma unroll
    for (int ks = 0; ks < 4; ++ks) {
#pragma unroll
      for (int m = 0; m < 4; ++m) {
        bf16x8 a = *(const bf16x8*)(buf + 17408 + (l31 * 144 + 16 * hh) + (m * 4608 + 32 * ks));
        S[m] = MFMA32(a, vf[ks], S[m]);
      }
      __builtin_amdgcn_sched_barrier(0);
    }
    if (n + 1 < 64) {
#pragma unroll
      for (int i = 0; i < 4; ++i) { *(u32x4*)(nbuf + wbase + i * 4352) = sw[i]; *(u32x4*)(nbuf + kbase + i * 4608) = sk[i]; }
    }
    __syncthreads();
  }
}

DI void phase3(const Params& P, char* lds) {
  const int G = gridDim.x;
  const int nscan = G > 32 ? 16 : 0;
  int first = KB_SPLIT + (int)blockIdx.x - nscan, stride = G - nscan;
  if ((int)blockIdx.x < 16 || nscan == 0) {
    for (int bh = blockIdx.x; bh < 16; bh += G) ka2_scan(P, bh, lds);
    if (nscan) first = 4096;
  }
  if (nscan && (G & 3) == 0) {
    if ((int)blockIdx.x >= 16) {
      const int bb = blockIdx.x & 3;
      unsigned* ctr = (unsigned*)(P.ws + OFF_BAR) + 64 + 16 * bb;
      for (;;) {
        const int k = KB_SPLIT / 4 + pull_item(ctr, lds);
        if (k >= 1024) break;
        kb_item(P, 4 * k + bb, lds);
      }
    }
  } else {
    for (int it = first; it < 4096; it += stride) kb_item(P, it, lds);
  }
}

DI void phase4(const Params& P, char* lds) {
  const int tid4 = otid(), lane = tid4 & 63, wave = tid4 >> 6, l15 = lane & 15, g4 = lane >> 4;
  char* ws = P.ws;
  float nw[8];
#pragma unroll
  for (int nt = 0; nt < 8; ++nt) nw[nt] = P.a_out_norm_w[16 * nt + l15];
  const bool aff = gridDim.x == 512;
  for (int it4 = aff ? 0 : (int)blockIdx.x; it4 < (aff ? 2 : 1024); it4 += (aff ? 1 : (int)gridDim.x)) {
    const int ch = aff ? (((int)blockIdx.x & 7) + 8 * it4) * 64 + ((int)blockIdx.x >> 3) : it4;
    const int b = ch >> 8, h = (ch >> 6) & 3, n = ch & 63;
    const int tok0 = b * 4096 + n * 64;
    const u16* QD = (const u16*)(ws + OFF_QD) + (size_t)ch * 8192;
    const u16* ATT = (const u16*)(ws + OFF_ATT) + (size_t)ch * 4096;
    const u16* HST = (const u16*)((const char*)P.out + OOFF_HST) + (size_t)ch * 16384;
    const u16* VNT = (const u16*)((const char*)P.out + OOFF_VNT) + (size_t)ch * 8192;
    __syncthreads();
    {
      u32x4 st[12];
#pragma unroll
      for (int i = 0; i < 8; ++i) st[i] = *(const u32x4*)(HST + (size_t)(tid4 + 256 * i) * 8);
#pragma unroll
      for (int i = 0; i < 4; ++i) st[8 + i] = *(const u32x4*)(VNT + (size_t)(tid4 + 256 * i) * 8);
#pragma unroll
      for (int i = 0; i < 8; ++i) *(u32x4*)(lds + (tid4 + 256 * i) * 16) = st[i];
#pragma unroll
      for (int i = 0; i < 4; ++i) *(u32x4*)(lds + 32768 + (tid4 + 256 * i) * 16) = st[8 + i];
    }
    __syncthreads();
    const u16* HSl = (const u16*)lds;
    const u16* VNl = (const u16*)(lds + 32768);
    f32x4 acc[8];
#pragma unroll
    for (int nt = 0; nt < 8; ++nt) acc[nt] = zero4();
#pragma unroll
    for (int ks = 0; ks < 4; ++ks) {
      bf16x8 a = *(const bf16x8*)(QD + (16 * wave + l15) * 128 + 32 * ks + 8 * g4);
#pragma unroll
      for (int nt = 0; nt < 8; ++nt) {
        bf16x8 bb = *(const bf16x8*)(HSl + (4 * ks + g4) * 1024 + (16 * nt + l15) * 8);
        acc[nt] = MFMA16(a, bb, acc[nt]);
      }
    }
#pragma unroll
    for (int ks = 0; ks < 2; ++ks) {
      bf16x8 a = *(const bf16x8*)(ATT + (16 * wave + l15) * 64 + 32 * ks + 8 * g4);
#pragma unroll
      for (int nt = 0; nt < 8; ++nt) {
        bf16x8 bb = *(const bf16x8*)(VNl + (4 * ks + g4) * 1024 + (16 * nt + l15) * 8);
        acc[nt] = MFMA16(a, bb, acc[nt]);
      }
    }
    float zg[4][8];
#pragma unroll
    for (int r = 0; r < 4; ++r) {
      const u16* az = (const u16*)(ws + OFF_AZ) + (size_t)(tok0 + 16 * wave + 4 * g4 + r) * 512 + h * 128;
#pragma unroll
      for (int nt = 0; nt < 8; ++nt) zg[r][nt] = bf2f(az[16 * nt + l15]);
    }
#pragma unroll
    for (int r = 0; r < 4; ++r) {
      float ss = 0.f;
#pragma unroll
      for (int nt = 0; nt < 8; ++nt) ss += acc[nt][r] * acc[nt][r];
      ss += __shfl_xor(ss, 1); ss += __shfl_xor(ss, 2); ss += __shfl_xor(ss, 4); ss += __shfl_xor(ss, 8);
      const float rs = rsqrtf(ss * (1.f / 128.f) + EPS);
      const int t = tok0 + 16 * wave + 4 * g4 + r;
      u16* mix = (u16*)(ws + OFF_MIXA) + (size_t)t * 512 + h * 128;
#pragma unroll
      for (int nt = 0; nt < 8; ++nt) {
        const int dv = 16 * nt + l15;
        mix[dv] = f2bf(acc[nt][r] * rs * nw[nt] * siluf_(zg[r][nt]));
      }
    }
  }
}

DI void phase5(const Params& P, char* lds) {
  char* ws = P.ws;
  const u16* MIXA = (const u16*)(ws + OFF_MIXA);
  const u16* MIXB = (const u16*)(ws + OFF_MIXB);
  const u16* WT = (const u16*)(ws + OFF_WT_OUT);
  float* X1 = (float*)(ws + OFF_X1);
  u16* X1B = (u16*)(ws + OFF_X1B);
  float* SS = (float*)(ws + OFF_SUMSQ);
  const int lane = otid() & 63, wave = otid() >> 6;
  const int wm = wave & 1, wn = wave >> 1, l31 = lane & 31, hh = lane >> 5;
  const bool xswz = (gridDim.x & 7) == 0;
  const int xq = blockIdx.x >> 3, xn = gridDim.x >> 3, xx = blockIdx.x & 7;
  for (int tile = xswz ? xq : (int)blockIdx.x; tile < (xswz ? 64 : 512); tile += (xswz ? xn : (int)gridDim.x)) {
    const int mt = xswz ? 8 * xx + (tile & 7) : (tile >> 3), nt = xswz ? (tile >> 3) : (tile & 7);
    f32x16 acc[4][2];
#pragma unroll
    for (int i = 0; i < 4; ++i)
#pragma unroll
      for (int j = 0; j < 2; ++j) acc[i][j] = zero16();
    gemm_mainloop<4>(MIXA, 512, WT, 1024, 512, mt * 256, nt * 128, lds, acc);
    gemm_mainloop<4>(MIXB, 512, WT + 512, 1024, 512, mt * 256, nt * 128, lds, acc);
    {
      const size_t e0 = (size_t)(mt * 256 + wm * 128 + 4 * hh) * 1024 + nt * 128 + wn * 64 + l31;
      float* ssp0 = SS + (mt * 256 + wm * 128 + 4 * hh);
#pragma unroll
      for (int i = 0; i < 4; ++i) {
        float xa[16], xb[16];
        {
          const float* xp = P.x + e0 + (size_t)i * 32 * 1024;
#pragma unroll
          for (int r = 0; r < 16; ++r) {
            xa[r] = xp[0]; xb[r] = xp[32];
            xp += (((r & 3) == 3) ? 5 : 1) * 1024;
            asm volatile("" : "+v"(xp));
          }
        }
        float* x1p = X1 + e0 + (size_t)i * 32 * 1024;
        u16* x1bp = X1B + e0 + (size_t)i * 32 * 1024;
        float* ssp = ssp0 + i * 32;
#pragma unroll
        for (int r = 0; r < 16; ++r) {
          const float va = xa[r] + acc[i][0][r], vb = xb[r] + acc[i][1][r];
          x1p[0] = va; x1p[32] = vb;
          x1bp[0] = f2bf(va); x1bp[32] = f2bf(vb);
          float ss = va * va + vb * vb;
          ss += dpp_xor1(ss); ss += dpp_xor2(ss); ss += __shfl_xor(ss, 4); ss += dpp_xor8(ss); ss += __shfl_xor(ss, 16);
          if (l31 == 0) atomicAdd(ssp, ss);
          const int step = ((r & 3) == 3) ? 5 : 1;
          x1p += step * 1024; x1bp += step * 1024; ssp += step;
          asm volatile("" : "+v"(x1p), "+v"(x1bp), "+v"(ssp));
        }
      }
    }
  }
}

DI void phase6(const Params& P, char* lds) {
  char* ws = P.ws;
  const u16* X1B = (const u16*)(ws + OFF_X1B);
  const float* X1 = (const float*)(ws + OFF_X1);
  const u16* WG = (const u16*)(ws + OFF_WT_GATE);
  const u16* WP = (const u16*)(ws + OFF_WT_PLE);
  const u16* PB = (const u16*)(ws + OFF_PB);
  const float* SS = (const float*)(ws + OFF_SUMSQ);
  const int lane = otid() & 63, wave = otid() >> 6;
  const int wm = wave & 1, wn = wave >> 1, l31 = lane & 31, hh = lane >> 5;
  const bool xswz = (gridDim.x & 7) == 0;
  const int xq = blockIdx.x >> 3, xn = gridDim.x >> 3, xx = blockIdx.x & 7;
  for (int tile = xswz ? xq : (int)blockIdx.x; tile < (xswz ? 128 : 1024); tile += (xswz ? xn : (int)gridDim.x)) {
    const int mt = xswz ? 16 * xx + (tile & 15) : (tile >> 3), nt = xswz ? (tile >> 4) : (tile & 7);
    f32x16 ag[2][2], ap[2][2];
#pragma unroll
    for (int i = 0; i < 2; ++i)
#pragma unroll
      for (int j = 0; j < 2; ++j) { ag[i][j] = zero16(); ap[i][j] = zero16(); }
    gemm_mainloop<2>(X1B, 1024, WG, 1024, 1024, mt * 128, nt * 128, lds, ag);
    gemm_mainloop<2>(PB, 256, WP, 256, 256, mt * 128, nt * 128, lds, ap);
    const size_t e0 = (size_t)(mt * 128 + wm * 64 + 4 * hh) * 1024 + nt * 128 + wn * 64 + l31;
    const float b0 = P.b_ple_gate[nt * 128 + wn * 64 + l31], b1 = P.b_ple_gate[nt * 128 + wn * 64 + 32 + l31];
    const float* ssp0 = SS + (mt * 128 + wm * 64 + 4 * hh);
#pragma unroll
    for (int i = 0; i < 2; ++i) {
      float rsv[16], xa[16], xb[16];
#pragma unroll
      for (int r = 0; r < 16; ++r) rsv[r] = ssp0[i * 32 + (r & 3) + 8 * (r >> 2)];
      {
        const float* x1p = X1 + e0 + (size_t)i * 32 * 1024;
#pragma unroll
        for (int r = 0; r < 16; ++r) {
          xa[r] = x1p[0]; xb[r] = x1p[32];
          x1p += (((r & 3) == 3) ? 5 : 1) * 1024;
          asm volatile("" : "+v"(x1p));
        }
      }
      float* op = P.out + e0 + (size_t)i * 32 * 1024;
#pragma unroll
      for (int r = 0; r < 16; ++r) {
        const float rs = rsqrtf(rsv[r] * (1.f / 1024.f) + EPS);
        op[0] = xa[r] + ap[i][0][r] * sigmoidf_(rs * ag[i][0][r] + b0);
        op[32] = xb[r] + ap[i][1][r] * sigmoidf_(rs * ag[i][1][r] + b1);
        op += (((r & 3) == 3) ? 5 : 1) * 1024;
        asm volatile("" : "+v"(op));
      }
    }
  }
}

template <int PH>
DI void run_phase(const Params& P, char* lds) {
  if (PH == 0) phase0(P);
  else if (PH == 1) phase1(P, lds);
  else if (PH == 2) phase2(P, lds);
  else if (PH == 3) phase3(P, lds);
  else if (PH == 4) phase4(P, lds);
  else if (PH == 5) phase5(P, lds);
  else phase6(P, lds);
}

template <int PH>
__global__ void __launch_bounds__(256, 2) phase_kernel(Params P) {
  __shared__ __attribute__((aligned(16))) char lds[LDS_BYTES];
  run_phase<PH>(P, lds);
}

__global__ void __launch_bounds__(256, 2) mega(Params P) {
  __shared__ __attribute__((aligned(16))) char lds[LDS_BYTES];
  volatile LAS unsigned* st = (volatile LAS unsigned*)(lds + LDS_BYTES - 16);
  if (threadIdx.x == 0) { st[0] = 0u; st[1] = 0u; }
  __syncthreads();
  if (P.ws == nullptr) cg::this_grid().sync();
  XcdBarrier xb = xcd_barrier_post((unsigned*)(P.ws + OFF_BAR), st);
  run_phase<0>(P, lds); xcd_barrier(xb);
  run_phase<1>(P, lds); xcd_barrier(xb);
  run_phase<2>(P, lds); xcd_barrier(xb);
  run_phase<3>(P, lds); xcd_barrier(xb);
  run_phase<4>(P, lds); xcd_barrier(xb);
  run_phase<5>(P, lds); xcd_barrier(xb);
  run_phase<6>(P, lds);
}

extern "C" void kernel_launch(void* const* d_in, const int* in_sizes, int n_in, void* d_out, int out_size, void* d_ws,
                              size_t ws_size, hipStream_t stream) {
  Params P{};
  P.x = (const float*)d_in[0]; P.p = (const float*)d_in[1]; P.attn_norm_w = (const float*)d_in[2];
  P.w_in = (const float*)d_in[3]; P.conv_w = (const float*)d_in[4]; P.a_log = (const float*)d_in[5];
  P.dt_bias = (const float*)d_in[6]; P.a_out_norm_w = (const float*)d_in[7]; P.b_q_norm_w = (const float*)d_in[8];
  P.b_k_norm_w = (const float*)d_in[9]; P.w_out = (const float*)d_in[10]; P.w_ple = (const float*)d_in[11];
  P.ple_gate_norm_w = (const float*)d_in[12]; P.w_ple_gate = (const float*)d_in[13]; P.b_ple_gate = (const float*)d_in[14];
  P.out = (float*)d_out; P.ws = (char*)d_ws;
  static int grid_blocks = 0;
  if (!grid_blocks) {
    int dev = 0, cus = 0, per_cu = 0;
    (void)hipGetDevice(&dev);
    (void)hipDeviceGetAttribute(&cus, hipDeviceAttributeMultiprocessorCount, dev);
    (void)hipOccupancyMaxActiveBlocksPerMultiprocessor(&per_cu, mega, 256, 0);
    if (per_cu > 2) per_cu = 2;
    if (per_cu < 1) per_cu = 1;
    grid_blocks = cus * per_cu;
  }
#ifdef MULTI_LAUNCH
  hipLaunchKernelGGL(phase_kernel<0>, dim3(grid_blocks), dim3(256), 0, stream, P);
  hipLaunchKernelGGL(phase_kernel<1>, dim3(grid_blocks), dim3(256), 0, stream, P);
  hipLaunchKernelGGL(phase_kernel<2>, dim3(grid_blocks), dim3(256), 0, stream, P);
  hipLaunchKernelGGL(phase_kernel<3>, dim3(grid_blocks), dim3(256), 0, stream, P);
  hipLaunchKernelGGL(phase_kernel<4>, dim3(grid_blocks), dim3(256), 0, stream, P);
  hipLaunchKernelGGL(phase_kernel<5>, dim3(grid_blocks), dim3(256), 0, stream, P);
  hipLaunchKernelGGL(phase_kernel<6>, dim3(grid_blocks), dim3(256), 0, stream, P);
#else
  (void)hipMemsetAsync((char*)d_ws + OFF_BAR, 0, XCD_BAR_WORDS * 4, stream);
  void* args[] = {&P};
  hipError_t e = hipLaunchCooperativeKernel((void*)mega, dim3(grid_blocks), dim3(256), args, 0, stream);
  if (e != hipSuccess) fprintf(stderr, "cooperative launch failed: %s (grid %d)\n", hipGetErrorString(e), grid_blocks);
#endif
}
```

```cpp
#include <hip/hip_runtime.h>
#include <hip/hip_cooperative_groups.h>
#include <cstdio>
namespace cg = cooperative_groups;

typedef unsigned short u16;
typedef unsigned int u32;
typedef unsigned long long u64;
using bf16x8 = __attribute__((ext_vector_type(8))) short;
using f32x16 = __attribute__((ext_vector_type(16))) float;
using f32x4 = __attribute__((ext_vector_type(4))) float;
using u32x4 = __attribute__((ext_vector_type(4))) unsigned;
#define DI __device__ __forceinline__
#define MFMA32(a, b, c) __builtin_amdgcn_mfma_f32_32x32x16_bf16((a), (b), (c), 0, 0, 0)
#define MFMA16(a, b, c) __builtin_amdgcn_mfma_f32_16x16x32_bf16((a), (b), (c), 0, 0, 0)

constexpr int T_ = 16384;
constexpr float EPS = 1e-6f;

constexpr size_t OFF_WT_IN = 0;
constexpr size_t OFF_WT_OUT = OFF_WT_IN + (size_t)4608 * 1024 * 2;
constexpr size_t OFF_WT_GATE = OFF_WT_OUT + (size_t)1024 * 1024 * 2;
constexpr size_t OFF_WT_PLE = OFF_WT_GATE + (size_t)1024 * 1024 * 2;
constexpr size_t OFF_PB = OFF_WT_PLE + (size_t)1024 * 256 * 2;
constexpr size_t OFF_SUMSQ = OFF_PB + (size_t)T_ * 256 * 2;
constexpr size_t OFF_QKV = OFF_SUMSQ + (size_t)T_ * 4;
constexpr size_t OFF_MIXA = OFF_QKV;
constexpr size_t OFF_AZ = OFF_QKV + (size_t)T_ * 1536 * 2;
constexpr size_t OFF_BQ = OFF_AZ + (size_t)T_ * 512 * 2;
constexpr size_t OFF_BKV = OFF_BQ + (size_t)T_ * 512 * 2;
constexpr size_t OFF_BZ = OFF_BKV + (size_t)T_ * 256 * 2;
constexpr size_t OFF_IQ = OFF_BZ + (size_t)T_ * 512 * 2;
constexpr size_t OFF_IK = OFF_IQ + (size_t)T_ * 1024 * 2;
constexpr size_t OFF_SMALL = OFF_IK + (size_t)T_ * 128 * 2;
constexpr size_t OFF_H = OFF_SMALL + (size_t)T_ * 16 * 4;
constexpr size_t OFF_WNEG = OFF_H;
constexpr size_t OFF_KDT = OFF_WNEG + (size_t)1024 * 8192 * 2;
constexpr size_t OFF_UT = OFF_H + (size_t)T_ * 1024 * 2;
constexpr size_t OFF_QD = OFF_UT + (size_t)1024 * 8192 * 2;
constexpr size_t OFF_ATT = OFF_QD + (size_t)1024 * 8192 * 2;
constexpr size_t OFF_GL = OFF_ATT + (size_t)1024 * 4096 * 2;
constexpr size_t OFF_BAR = OFF_GL + 4096;
constexpr size_t OFF_MIXB = OFF_BAR + 16384;
constexpr size_t WS_END = OFF_MIXB + (size_t)T_ * 512 * 2;
constexpr size_t OFF_X1 = OFF_AZ;
constexpr size_t OFF_X1B = OFF_X1 + (size_t)T_ * 1024 * 4;
static_assert(OFF_X1B + (size_t)T_ * 1024 * 2 <= OFF_UT, "x1 alias overlaps live data");
static_assert(WS_END <= (size_t)256 * 1024 * 1024, "ws too small");
constexpr size_t OOFF_HST = 0;
constexpr size_t OOFF_VNT = OOFF_HST + (size_t)1024 * 16384 * 2;
constexpr size_t OOFF_IDX = OOFF_VNT + (size_t)1024 * 8192 * 2;
static_assert(OOFF_IDX + (size_t)T_ * 256 * 2 <= (size_t)T_ * 1024 * 4, "d_out scratch");

constexpr int LDS_BYTES = 72 * 1024;

struct Params {
  const float *x, *p, *attn_norm_w, *w_in, *conv_w, *a_log, *dt_bias, *a_out_norm_w, *b_q_norm_w, *b_k_norm_w,
      *w_out, *w_ple, *ple_gate_norm_w, *w_ple_gate, *b_ple_gate;
  float* out;
  char* ws;
};

DI int otid() { int t = threadIdx.x; asm volatile("" : "+v"(t)); return t; }
DI float dpp_xor1(float v) { return __int_as_float(__builtin_amdgcn_update_dpp(0, __float_as_int(v), 0xB1, 0xF, 0xF, true)); }
DI float dpp_xor2(float v) { return __int_as_float(__builtin_amdgcn_update_dpp(0, __float_as_int(v), 0x4E, 0xF, 0xF, true)); }
DI float dpp_xor8(float v) { return __int_as_float(__builtin_amdgcn_update_dpp(0, __float_as_int(v), 0x128, 0xF, 0xF, true)); }
DI u16 f2bf(float x) { u32 u = __float_as_uint(x); u += 0x7fffu + ((u >> 16) & 1u); return (u16)(u >> 16); }
DI float bf2f(u16 v) { return __uint_as_float(((u32)v) << 16); }
DI u32 pack2(float a, float b) { return (u32)f2bf(a) | ((u32)f2bf(b) << 16); }
DI float bflo(u32 v) { return __uint_as_float(v << 16); }
DI float bfhi(u32 v) { return __uint_as_float(v & 0xffff0000u); }
DI float sigmoidf_(float x) { return 1.f / (1.f + __expf(-x)); }
DI float siluf_(float x) { return x / (1.f + __expf(-x)); }
DI f32x16 zero16() { f32x16 z; for (int i = 0; i < 16; ++i) z[i] = 0.f; return z; }
DI f32x4 zero4() { f32x4 z; for (int i = 0; i < 4; ++i) z[i] = 0.f; return z; }


#define XB_TMO      128
#define XB_XCNT(j)  (256  + 64 * (j))
#define XB_XSUB(j)  (1280 + 64 * (j))
#define XB_XGEN(j)  (2304 + 64 * (j))
#define XB_TOP      3328
#define XB_TOPGEN   3392
#define XCD_BAR_WORDS 3456
#define XB_SPIN_CAP (1u << 22)
#define LAS __attribute__((address_space(3)))
DI unsigned xb_ld(unsigned* p) { return __hip_atomic_load(p, __ATOMIC_RELAXED, __HIP_MEMORY_SCOPE_AGENT); }
DI unsigned xb_add(unsigned* p, unsigned v) { return __hip_atomic_fetch_add(p, v, __ATOMIC_RELAXED, __HIP_MEMORY_SCOPE_AGENT); }
DI unsigned xb_xcc_id() { return (unsigned)__builtin_amdgcn_s_getreg((3 << 11) | 20) & 0xFu; }
#define XB_SPIN(cond, bar) do { unsigned _sp = 0; while (cond) { __builtin_amdgcn_s_sleep(1); \
    if ((++_sp & 255u) == 0u) { if (xb_ld(&(bar)[XB_TMO])) break; if (_sp > XB_SPIN_CAP) { atomicAdd(&(bar)[XB_TMO], 1u); break; } } } } while (0)
struct XcdBarrier { unsigned* bar; unsigned x; volatile LAS unsigned* st; };
DI XcdBarrier xcd_barrier_post(unsigned* bar, volatile LAS unsigned* st) {
  XcdBarrier b; b.bar = bar; b.x = xb_xcc_id(); b.st = st;
  if (threadIdx.x == 0) (void)xb_add(&bar[XB_XCNT(b.x)], 1u);
  return b;
}
DI void xcd_barrier_complete(unsigned* bar, unsigned x, unsigned& nloc, unsigned& nx) {
  const unsigned G = gridDim.x * gridDim.y * gridDim.z;
  unsigned sum, cnt, mine, sp = 0u;
  for (;;) {
    sum = 0u; cnt = 0u; mine = 0u;
#pragma unroll
    for (unsigned j = 0; j < 16; ++j) { const unsigned c = xb_ld(&bar[XB_XCNT(j)]); sum += c; cnt += (c > 0u) ? 1u : 0u; mine = (j == x) ? c : mine; }
    if (sum == G) break;
    __builtin_amdgcn_s_sleep(1);
    if ((++sp & 255u) == 0u) { if (xb_ld(&bar[XB_TMO])) break; if (sp > XB_SPIN_CAP) { atomicAdd(&bar[XB_TMO], 1u); break; } }
  }
  nloc = mine > 0u ? mine : 1u; nx = cnt > 0u ? cnt : 1u;
}
DI void xcd_barrier(const XcdBarrier& b) {
  asm volatile("s_waitcnt vmcnt(0)" ::: "memory");
  __syncthreads();
  if (threadIdx.x == 0) {
    unsigned* bar = b.bar;
    __builtin_amdgcn_s_waitcnt(0);
    unsigned nloc = b.st[0], nx = b.st[1];
    if (nloc == 0u) { xcd_barrier_complete(bar, b.x, nloc, nx); b.st[0] = nloc; b.st[1] = nx; }
    const unsigned old = xb_add(&bar[XB_XSUB(b.x)], 1u);
    const unsigned gen = old / nloc;
    if (old + 1u == (gen + 1u) * nloc) {
      __builtin_amdgcn_fence(__ATOMIC_RELEASE, "agent");
      asm volatile("s_waitcnt vmcnt(0)" ::: "memory");
      const unsigned og = xb_add(&bar[XB_TOP], 1u);
      const unsigned tg = og / nx;
      if (og + 1u == (tg + 1u) * nx) xb_add(&bar[XB_TOPGEN], 1u);
      else XB_SPIN(xb_ld(&bar[XB_TOPGEN]) == tg, bar);
      __builtin_amdgcn_fence(__ATOMIC_ACQUIRE, "agent");
      xb_add(&bar[XB_XGEN(b.x)], 1u);
      asm volatile("s_waitcnt vmcnt(0)" ::: "memory");
    } else {
      XB_SPIN(xb_ld(&bar[XB_XGEN(b.x)]) == gen, bar);
      __builtin_amdgcn_fence(__ATOMIC_ACQUIRE, "agent");
      asm volatile("s_waitcnt vmcnt(0)" ::: "memory");
    }
  }
  __syncthreads();
}

template <bool SCALE>
DI void transpose_w(const float* __restrict__ W, int ldw, int K, int NP, int NV, u16* __restrict__ wt,
                    const float* __restrict__ scale, bool remap, size_t gtid, size_t gsz) {
  const int kchunks = K / 8;
  for (size_t it = gtid; it < (size_t)NP * kchunks; it += gsz) {
    int j = (int)(it % NP), kc = (int)(it / NP);
    uint4 o = make_uint4(0, 0, 0, 0);
    if (j < NV) {
      int src = j;
      if (remap) src = j < 2048 ? j : (j < 4480 ? j + 8 : (j < 4488 ? 2048 + (j - 4480) : j));
      float v[8];
#pragma unroll
      for (int i = 0; i < 8; ++i) {
        v[i] = W[(size_t)(kc * 8 + i) * ldw + src];
        if (SCALE) v[i] *= scale[kc * 8 + i];
      }
      o.x = pack2(v[0], v[1]); o.y = pack2(v[2], v[3]); o.z = pack2(v[4], v[5]); o.w = pack2(v[6], v[7]);
    }
    *(uint4*)(wt + (size_t)j * K + kc * 8) = o;
  }
}

DI void phase0(const Params& P) {
  const int tid = otid(), lane = tid & 63, wave = tid >> 6;
  const size_t gtid = (size_t)blockIdx.x * 256 + tid, gsz = (size_t)gridDim.x * 256;
  char* ws = P.ws;
  transpose_w<false>(P.w_in, 4496, 1024, 4608, 4496, (u16*)(ws + OFF_WT_IN), nullptr, true, gtid, gsz);
  transpose_w<false>(P.w_out, 1024, 1024, 1024, 1024, (u16*)(ws + OFF_WT_OUT), nullptr, false, gtid, gsz);
  transpose_w<true>(P.w_ple_gate, 1024, 1024, 1024, 1024, (u16*)(ws + OFF_WT_GATE), P.ple_gate_norm_w, false, gtid, gsz);
  transpose_w<false>(P.w_ple, 1024, 256, 1024, 1024, (u16*)(ws + OFF_WT_PLE), nullptr, false, gtid, gsz);
  {
    u16* pb = (u16*)(ws + OFF_PB);
    for (size_t it = gtid; it < (size_t)T_ * 256 / 8; it += gsz) {
      float4 a = *(const float4*)(P.p + it * 8), b = *(const float4*)(P.p + it * 8 + 4);
      uint4 o; o.x = pack2(a.x, a.y); o.y = pack2(a.z, a.w); o.z = pack2(b.x, b.y); o.w = pack2(b.z, b.w);
      *(uint4*)(pb + it * 8) = o;
    }
  }
  {
    float* ss = (float*)(ws + OFF_SUMSQ);
    for (size_t it = gtid; it < (size_t)T_; it += gsz) ss[it] = 0.f;
  }
  {
    u16* H = (u16*)(ws + OFF_H);
    const int gw = blockIdx.x * 4 + wave, nw = gridDim.x * 4;
    for (int row0 = gw * 4; row0 < T_; row0 += nw * 4) {
      float4 v[4][4];
#pragma unroll
      for (int rr = 0; rr < 4; ++rr)
#pragma unroll
        for (int i = 0; i < 4; ++i) v[rr][i] = *(const float4*)(P.x + (size_t)(row0 + rr) * 1024 + lane * 4 + 256 * i);
      float4 g[4];
#pragma unroll
      for (int i = 0; i < 4; ++i) g[i] = *(const float4*)(P.attn_norm_w + lane * 4 + 256 * i);
#pragma unroll
      for (int rr = 0; rr < 4; ++rr) {
        float ss = 0.f;
#pragma unroll
        for (int i = 0; i < 4; ++i) ss += v[rr][i].x * v[rr][i].x + v[rr][i].y * v[rr][i].y + v[rr][i].z * v[rr][i].z + v[rr][i].w * v[rr][i].w;
#pragma unroll
        for (int d = 1; d < 64; d <<= 1) ss += __shfl_xor(ss, d);
        const float r = rsqrtf(ss * (1.f / 1024.f) + EPS);
#pragma unroll
        for (int i = 0; i < 4; ++i) {
          uint2 o; o.x = pack2(v[rr][i].x * r * g[i].x, v[rr][i].y * r * g[i].y); o.y = pack2(v[rr][i].z * r * g[i].z, v[rr][i].w * r * g[i].w);
          *(uint2*)(H + (size_t)(row0 + rr) * 1024 + lane * 4 + 256 * i) = o;
        }
      }
    }
  }
}

template <int MT>
DI void gemm_mainloop(const u16* __restrict__ A, int lda, const u16* __restrict__ Bt, int ldb, int K, int m0, int n0,
                      char* lds, f32x16 (&acc)[MT][2]) {
  const int tid = otid(), lane = tid & 63, wave = tid >> 6;
  const int wm = wave & 1, wn = wave >> 1, l31 = lane & 31, hh = lane >> 5;
  constexpr int BM = 64 * MT;
  char* ldsA = lds;
  char* ldsB = lds + BM * 128;
  const int lrow = tid >> 3, kc = tid & 7;
  const u16* ga = A + (size_t)(m0 + lrow) * lda + kc * 8;
  const u16* gb = Bt + (size_t)(n0 + lrow) * ldb + kc * 8;
  u32x4 ra[2 * MT], rb[4];
#pragma unroll
  for (int i = 0; i < 2 * MT; ++i) ra[i] = *(const u32x4*)(ga + (size_t)(32 * i) * lda);
#pragma unroll
  for (int i = 0; i < 4; ++i) rb[i] = *(const u32x4*)(gb + (size_t)(32 * i) * ldb);
  const int woff = lrow * 128 + ((kc ^ ((lrow >> 1) & 7)) << 4);
  const int nk = K >> 6;
  for (int kt = 0; kt < nk; ++kt) {
    __syncthreads();
#pragma unroll
    for (int i = 0; i < 2 * MT; ++i) *(u32x4*)(ldsA + woff + i * 4096) = ra[i];
#pragma unroll
    for (int i = 0; i < 4; ++i) *(u32x4*)(ldsB + woff + i * 4096) = rb[i];
    __syncthreads();
    if (kt + 1 < nk) {
#pragma unroll
      for (int i = 0; i < 2 * MT; ++i) ra[i] = *(const u32x4*)(ga + (size_t)(32 * i) * lda + (kt + 1) * 64);
#pragma unroll
      for (int i = 0; i < 4; ++i) rb[i] = *(const u32x4*)(gb + (size_t)(32 * i) * ldb + (kt + 1) * 64);
    }
#pragma unroll
    for (int s = 0; s < 4; ++s) {
      bf16x8 af[MT], bfr[2];
      const int c = 2 * s + hh;
#pragma unroll
      for (int i = 0; i < MT; ++i) {
        int row = wm * (32 * MT) + i * 32 + l31;
        af[i] = *(const bf16x8*)(ldsA + row * 128 + ((c ^ ((row >> 1) & 7)) << 4));
      }
#pragma unroll
      for (int j = 0; j < 2; ++j) {
        int rowb = wn * 64 + j * 32 + l31;
        bfr[j] = *(const bf16x8*)(ldsB + rowb * 128 + ((c ^ ((rowb >> 1) & 7)) << 4));
      }
#pragma unroll
      for (int i = 0; i < MT; ++i)
#pragma unroll
        for (int j = 0; j < 2; ++j) acc[i][j] = MFMA32(af[i], bfr[j], acc[i][j]);
    }
  }
}

DI void phase1(const Params& P, char* lds) {
  char* ws = P.ws;
  const u16* H = (const u16*)(ws + OFF_H);
  const u16* WT = (const u16*)(ws + OFF_WT_IN);
  const int lane = otid() & 63, wave = otid() >> 6;
  const int wm = wave & 1, wn = wave >> 1, l31 = lane & 31, hh = lane >> 5;
  const bool xswz = (gridDim.x & 7) == 0;
  const int xq = blockIdx.x >> 3, xn = gridDim.x >> 3, xx = blockIdx.x & 7;
  for (int tile = xswz ? xq : (int)blockIdx.x; tile < (xswz ? 8 * 36 : 64 * 36); tile += (xswz ? xn : (int)gridDim.x)) {
    const int mt = xswz ? 8 * xx + (tile & 7) : tile / 36, nt = xswz ? (tile >> 3) : tile % 36;
    f32x16 acc[4][2];
#pragma unroll
    for (int i = 0; i < 4; ++i)
#pragma unroll
      for (int j = 0; j < 2; ++j) acc[i][j] = zero16();
    gemm_mainloop<4>(H, 1024, WT, 1024, 1024, mt * 256, nt * 128, lds, acc);
    const int n0 = nt * 128;
    if (n0 < 4480) {
      u16* base; int ld, c0;
      if (n0 < 1536) { base = (u16*)(ws + OFF_QKV); ld = 1536; c0 = n0; }
      else if (n0 < 2048) { base = (u16*)(ws + OFF_AZ); ld = 512; c0 = n0 - 1536; }
      else if (n0 < 2560) { base = (u16*)(ws + OFF_BQ); ld = 512; c0 = n0 - 2048; }
      else if (n0 < 2816) { base = (u16*)(ws + OFF_BKV); ld = 256; c0 = n0 - 2560; }
      else if (n0 < 3328) { base = (u16*)(ws + OFF_BZ); ld = 512; c0 = n0 - 2816; }
      else if (n0 < 4352) { base = (u16*)(ws + OFF_IQ); ld = 1024; c0 = n0 - 3328; }
      else { base = (u16*)(ws + OFF_IK); ld = 128; c0 = n0 - 4352; }
      const bool qn = (n0 >= 2048 && n0 < 2560), kn = (n0 == 2560);
      float w0 = 1.f, w1 = 1.f;
      if (qn) { w0 = P.b_q_norm_w[l31] * 0.125f; w1 = P.b_q_norm_w[32 + l31] * 0.125f; }
      if (kn) { w0 = P.b_k_norm_w[l31]; w1 = P.b_k_norm_w[32 + l31]; }
      const int rowbase = mt * 256 + wm * 128;
      char* p0; int rs, ts, c1;
      if (n0 == 4352) {
        const int ca = wn * 64 + l31;
        p0 = (char*)base + (size_t)(rowbase >> 5) * 8192 + hh * 64 + ((ca >> 4) * 512 + ((ca >> 3) & 1) * 256 + (ca & 7)) * 2;
        rs = 16; ts = 8192; c1 = 2048;
      } else {
        p0 = (char*)base + ((size_t)(rowbase + 4 * hh) * ld + c0 + wn * 64 + l31) * 2;
        rs = ld * 2; ts = 64 * ld; c1 = 64;
      }
#pragma unroll
      for (int i = 0; i < 4; ++i) {
        char* pr = p0 + (size_t)i * ts;
#pragma unroll
        for (int r = 0; r < 16; ++r) {
          float v0 = acc[i][0][r], v1 = acc[i][1][r];
          if (qn || kn) {
            float ss = v0 * v0 + v1 * v1;
            ss += dpp_xor1(ss); ss += dpp_xor2(ss); ss += __shfl_xor(ss, 4); ss += dpp_xor8(ss); ss += __shfl_xor(ss, 16);
            const float rsq = rsqrtf(ss * (1.f / 64.f) + EPS);
            v0 *= rsq * w0; v1 *= rsq * w1;
          }
          *(u16*)pr = f2bf(v0);
          *(u16*)(pr + c1) = f2bf(v1);
          pr += ((r & 3) == 3) ? 5 * rs : rs;
          asm volatile("" : "+v"(pr));
        }
      }
    } else {
      if (wn == 0 && l31 < 16) {
        float* sp = (float*)(ws + OFF_SMALL) + (size_t)(mt * 256 + wm * 128 + 4 * hh) * 16 + l31;
#pragma unroll
        for (int i = 0; i < 4; ++i)
#pragma unroll
          for (int r = 0; r < 16; ++r) {
            *sp = acc[i][0][r];
            sp += ((r & 3) == 3) ? 5 * 16 : 16;
            asm volatile("" : "+v"(sp));
          }
      }
    }
  }
}

DI void knorm_all(const Params& P) {
  const int lane = otid() & 63, wave = otid() >> 6;
  u32* BKV = (u32*)(P.ws + OFF_BKV);
  const int gw = blockIdx.x * 4 + wave, nw = gridDim.x * 4;
  const float w0 = P.b_k_norm_w[(2 * lane) & 63], w1 = P.b_k_norm_w[(2 * lane + 1) & 63];
  for (int tok = gw; tok < T_; tok += nw) {
    u32 v = BKV[(size_t)tok * 128 + lane];
    float a = bflo(v), b = bfhi(v);
    float ss = a * a + b * b;
#pragma unroll
    for (int d = 1; d < 32; d <<= 1) ss += __shfl_xor(ss, d);
    float r = rsqrtf(ss * (1.f / 64.f) + EPS);
    BKV[(size_t)tok * 128 + lane] = pack2(a * r * w0, b * r * w1);
  }
}

DI int perm16(int x) { return (x & 3) | ((x & 8) >> 1) | ((x & 4) << 1); }

DI void ka1_item(const Params& P, int ch, char* lds) {
  const int tid = otid(), lane = tid & 63, wave = tid >> 6, hh = lane >> 5, l31 = lane & 31;
  const int b = ch >> 8, h = (ch >> 6) & 3, n = ch & 63;
  const int tok0 = b * 4096 + n * 64;
  char* ws = P.ws;
  u16* QV = (u16*)lds;
  u16* Ks = (u16*)(lds + 18432);
  u16* KBT = (u16*)(lds + 18432 + 17408);
  float* Am = (float*)(lds + 18432 + 17408 + 18432);
  u16* Tm = Ks;
  float* sm = (float*)(lds + 18432 + 17408 + 18432 + 16384);
  const u16* QKV = (const u16*)(ws + OFF_QKV);
  const float* SMALL = (const float*)(ws + OFF_SMALL);
  u16* QD = (u16*)(ws + OFF_QD) + (size_t)ch * 8192;
  u16* ATT = (u16*)(ws + OFF_ATT) + (size_t)ch * 4096;
  u16* KDT = (u16*)(ws + OFF_KDT) + (size_t)ch * 8192;
  u16* WNEG = (u16*)(ws + OFF_WNEG) + (size_t)ch * 8192;
  u16* UT = (u16*)(ws + OFF_UT) + (size_t)ch * 8192;
  __syncthreads();
  if (wave == 0) {
    float ab = SMALL[(size_t)(tok0 + lane) * 16 + h];
    float aa = SMALL[(size_t)(tok0 + lane) * 16 + 4 + h];
    float beta = sigmoidf_(ab);
    float xs = aa + P.dt_bias[h];
    float sp = fmaxf(xs, 0.f) + log1pf(__expf(-fabsf(xs)));
    float g = -__expf(P.a_log[h]) * sp;
#pragma unroll
    for (int d = 1; d < 64; d <<= 1) { float t = __shfl_up(g, d); if (lane >= d) g += t; }
    float glast = __shfl(g, 63);
    sm[lane] = g; sm[64 + lane] = beta; sm[128 + lane] = __expf(g); sm[192 + lane] = __expf(glast - g);
  }
  __syncthreads();
  const float* cw = P.conv_w;
  {
    const int cq = h * 128 + 2 * lane, ck = 512 + cq;
    float wq[4][2], wk[4][2];
#pragma unroll
    for (int j = 0; j < 4; ++j) {
      wq[j][0] = cw[j * 1536 + cq]; wq[j][1] = cw[j * 1536 + cq + 1];
      wk[j][0] = cw[j * 1536 + ck]; wk[j][1] = cw[j * 1536 + ck + 1];
    }
    const int i0 = wave * 16;
    float xq[3][2], xk[3][2];
#pragma unroll
    for (int j = 0; j < 3; ++j) {
      int pos = n * 64 + i0 - 3 + j;
      u32 vq = 0, vk = 0;
      if (pos >= 0) {
        const u16* rp = QKV + (size_t)(tok0 + i0 - 3 + j) * 1536;
        vq = *(const u32*)(rp + cq); vk = *(const u32*)(rp + ck);
      }
      xq[j][0] = bflo(vq); xq[j][1] = bfhi(vq); xk[j][0] = bflo(vk); xk[j][1] = bfhi(vk);
    }
    u32 rq_[16], rk_[16];
#pragma unroll
    for (int ii = 0; ii < 16; ++ii) {
      const u16* rp = QKV + (size_t)(tok0 + i0 + ii) * 1536;
      rq_[ii] = *(const u32*)(rp + cq); rk_[ii] = *(const u32*)(rp + ck);
    }
#pragma unroll
    for (int ii = 0; ii < 16; ++ii) {
      const int i = i0 + ii;
      const u32 vq = rq_[ii], vk = rk_[ii];
      float cq0 = bflo(vq), cq1 = bfhi(vq), ck0 = bflo(vk), ck1 = bfhi(vk);
      float yq0 = wq[0][0] * xq[0][0] + wq[1][0] * xq[1][0] + wq[2][0] * xq[2][0] + wq[3][0] * cq0;
      float yq1 = wq[0][1] * xq[0][1] + wq[1][1] * xq[1][1] + wq[2][1] * xq[2][1] + wq[3][1] * cq1;
      float yk0 = wk[0][0] * xk[0][0] + wk[1][0] * xk[1][0] + wk[2][0] * xk[2][0] + wk[3][0] * ck0;
      float yk1 = wk[0][1] * xk[0][1] + wk[1][1] * xk[1][1] + wk[2][1] * xk[2][1] + wk[3][1] * ck1;
      xq[0][0] = xq[1][0]; xq[0][1] = xq[1][1]; xq[1][0] = xq[2][0]; xq[1][1] = xq[2][1]; xq[2][0] = cq0; xq[2][1] = cq1;
      xk[0][0] = xk[1][0]; xk[0][1] = xk[1][1]; xk[1][0] = xk[2][0]; xk[1][1] = xk[2][1]; xk[2][0] = ck0; xk[2][1] = ck1;
      yq0 = siluf_(yq0); yq1 = siluf_(yq1); yk0 = siluf_(yk0); yk1 = siluf_(yk1);
      float sq = yq0 * yq0 + yq1 * yq1, sk = yk0 * yk0 + yk1 * yk1;
#pragma unroll
      for (int d = 1; d < 64; d <<= 1) { sq += __shfl_xor(sq, d); sk += __shfl_xor(sk, d); }
      const float rq = rsqrtf(sq + EPS) * 0.08838834764831845f, rk = rsqrtf(sk + EPS);
      yq0 *= rq; yq1 *= rq; yk0 *= rk; yk1 *= rk;
      *(u32*)(QV + i * 136 + 2 * lane) = pack2(yq0, yq1);
      *(u32*)(Ks + i * 136 + 2 * lane) = pack2(yk0, yk1);
      KBT[(2 * lane) * 72 + i] = f2bf(yk0);
      KBT[(2 * lane + 1) * 72 + i] = f2bf(yk1);
      const float eg = sm[128 + i];
      *(u32*)(QD + i * 128 + 2 * lane) = pack2(yq0 * eg, yq1 * eg);
    }
  }
  __syncthreads();
  {
    const int mt = wave & 1, nt = wave >> 1;
    f32x16 akk = zero16(), aqk = zero16();
#pragma unroll
    for (int s = 0; s < 8; ++s) {
      const int kof = 16 * s + 8 * hh;
      bf16x8 aq = *(const bf16x8*)(QV + (32 * mt + l31) * 136 + kof);
      bf16x8 ak = *(const bf16x8*)(Ks + (32 * mt + l31) * 136 + kof);
      bf16x8 bk = *(const bf16x8*)(Ks + (32 * nt + l31) * 136 + kof);
      akk = MFMA32(ak, bk, akk);
      aqk = MFMA32(aq, bk, aqk);
    }
    const int j = 32 * nt + l31;
    const float gj = sm[j];
#pragma unroll
    for (int r = 0; r < 16; ++r) {
      const int i = 32 * mt + (r & 3) + 8 * (r >> 2) + 4 * hh;
      const float gi = sm[i], bi = sm[64 + i];
      const float dec = (j <= i) ? __expf(gi - gj) : 0.f;
      Am[i * 64 + j] = (j < i) ? bi * akk[r] * dec : 0.f;
      ATT[i * 64 + j] = f2bf(aqk[r] * dec);
    }
  }
  {
    const int dk = tid >> 1, th = tid & 1;
    u16* kr = KBT + dk * 72 + th * 32;
#pragma unroll
    for (int g2 = 0; g2 < 2; ++g2) {
      u16 ov[16];
#pragma unroll
      for (int x = 0; x < 16; ++x) {
        const int tok = th * 32 + g2 * 16 + x;
        const float kv = bf2f(kr[g2 * 16 + x]);
        ov[perm16(x)] = f2bf(kv * sm[192 + tok]);
        kr[g2 * 16 + x] = f2bf(kv * sm[64 + tok] * sm[128 + tok]);
      }
      uint4 o0, o1;
      o0.x = ov[0] | ((u32)ov[1] << 16); o0.y = ov[2] | ((u32)ov[3] << 16); o0.z = ov[4] | ((u32)ov[5] << 16); o0.w = ov[6] | ((u32)ov[7] << 16);
      o1.x = ov[8] | ((u32)ov[9] << 16); o1.y = ov[10] | ((u32)ov[11] << 16); o1.z = ov[12] | ((u32)ov[13] << 16); o1.w = ov[14] | ((u32)ov[15] << 16);
      *(uint4*)(KDT + dk * 64 + th * 32 + g2 * 16) = o0;
      *(uint4*)(KDT + dk * 64 + th * 32 + g2 * 16 + 8) = o1;
    }
  }
  __syncthreads();
  {
    u16* VBT = QV;
    const int cv = 1024 + h * 128 + 2 * lane;
    float wv[4][2];
#pragma unroll
    for (int j = 0; j < 4; ++j) { wv[j][0] = cw[j * 1536 + cv]; wv[j][1] = cw[j * 1536 + cv + 1]; }
    const int i0 = wave * 16;
    float xv[3][2];
#pragma unroll
    for (int j = 0; j < 3; ++j) {
      int pos = n * 64 + i0 - 3 + j;
      u32 vv = 0;
      if (pos >= 0) vv = *(const u32*)(QKV + (size_t)(tok0 + i0 - 3 + j) * 1536 + cv);
      xv[j][0] = bflo(vv); xv[j][1] = bfhi(vv);
    }
    u32 rv_[16];
#pragma unroll
    for (int ii = 0; ii < 16; ++ii) rv_[ii] = *(const u32*)(QKV + (size_t)(tok0 + i0 + ii) * 1536 + cv);
#pragma unroll
    for (int ii = 0; ii < 16; ++ii) {
      const int i = i0 + ii;
      const u32 vv = rv_[ii];
      float c0 = bflo(vv), c1 = bfhi(vv);
      float y0 = wv[0][0] * xv[0][0] + wv[1][0] * xv[1][0] + wv[2][0] * xv[2][0] + wv[3][0] * c0;
      float y1 = wv[0][1] * xv[0][1] + wv[1][1] * xv[1][1] + wv[2][1] * xv[2][1] + wv[3][1] * c1;
      xv[0][0] = xv[1][0]; xv[0][1] = xv[1][1]; xv[1][0] = xv[2][0]; xv[1][1] = xv[2][1]; xv[2][0] = c0; xv[2][1] = c1;
      const float bi = sm[64 + i];
      VBT[(2 * lane) * 72 + i] = f2bf(siluf_(y0) * bi);
      VBT[(2 * lane + 1) * 72 + i] = f2bf(siluf_(y1) * bi);
    }
  }
  if (wave == 0) {
    float Tc[63];
#pragma unroll
    for (int i = 0; i < 64; ++i) {
      float a = (i == lane) ? 1.f : 0.f;
#pragma unroll
      for (int j = 0; j < i; ++j) a -= Am[i * 64 + j] * Tc[j];
      if (i < 63) Tc[i] = a;
      Tm[i * 72 + lane] = f2bf(a);
      if ((i & 3) == 3) __builtin_amdgcn_sched_barrier(0);
    }
  }
  __syncthreads();
  {
    const u16* VBT = QV;
    f32x16 c0 = zero16(), c1 = zero16(), d0 = zero16(), d1 = zero16();
#pragma unroll
    for (int s = 0; s < 4; ++s) {
      const int kof = 16 * s + 8 * hh;
      bf16x8 t0 = *(const bf16x8*)(Tm + l31 * 72 + kof);
      bf16x8 t1 = *(const bf16x8*)(Tm + (32 + l31) * 72 + kof);
      bf16x8 a = *(const bf16x8*)(KBT + (32 * wave + l31) * 72 + kof);
      bf16x8 bv = *(const bf16x8*)(VBT + (32 * wave + l31) * 72 + kof);
      c0 = MFMA32(a, t0, c0);
      c1 = MFMA32(a, t1, c1);
      d0 = MFMA32(t0, bv, d0);
      d1 = MFMA32(t1, bv, d1);
    }
#pragma unroll
    for (int rg = 0; rg < 4; ++rg) {
      const int dkpos = 16 * (2 * wave + (rg >> 1)) + 8 * hh + 4 * (rg & 1);
      uint2 o;
      o.x = pack2(-c0[4 * rg], -c0[4 * rg + 1]); o.y = pack2(-c0[4 * rg + 2], -c0[4 * rg + 3]);
      *(uint2*)(WNEG + (l31) * 128 + dkpos) = o;
      o.x = pack2(-c1[4 * rg], -c1[4 * rg + 1]); o.y = pack2(-c1[4 * rg + 2], -c1[4 * rg + 3]);
      *(uint2*)(WNEG + (32 + l31) * 128 + dkpos) = o;
      const int dv = 32 * wave + l31;
      o.x = pack2(d0[4 * rg], d0[4 * rg + 1]); o.y = pack2(d0[4 * rg + 2], d0[4 * rg + 3]);
      *(uint2*)(UT + rg * 1024 + dv * 8 + 4 * hh) = o;
      o.x = pack2(d1[4 * rg], d1[4 * rg + 1]); o.y = pack2(d1[4 * rg + 2], d1[4 * rg + 3]);
      *(uint2*)(UT + (4 + rg) * 1024 + dv * 8 + 4 * hh) = o;
    }
    if (tid == 0) ((float*)(ws + OFF_GL))[ch] = sm[128 + 63];
  }
}

#define ATT_UNROLL 4
typedef __bf16 bf2_t __attribute__((ext_vector_type(2)));
DI float fdot2(u32 a, u32 b, float c) { return __builtin_amdgcn_fdot2_f32_bf16(__builtin_bit_cast(bf2_t, a), __builtin_bit_cast(bf2_t, b), c, false); }
DI float dot8(const uint4& k, const u32* q, float acc) {
  acc = fdot2(k.x, q[0], acc);
  acc = fdot2(k.y, q[1], acc);
  acc = fdot2(k.z, q[2], acc);
  acc = fdot2(k.w, q[3], acc);
  return acc;
}

DI void kb2_query(const Params& P, int t, float* Sw, const u16* idxp) {
  const int lane = otid() & 63;
  char* ws = P.ws;
  const int b = t >> 12, pos = t & 4095;
  const int nvalid = pos + 1 < 256 ? pos + 1 : 256;
  const bool uselist = pos >= 255;
  const u16* BKVb = (const u16*)(ws + OFF_BKV) + (size_t)b * 4096 * 256;
  float inv;
  {
    const int l15 = lane & 15, g4 = lane >> 4;
    bf16x8 qf[4];
    {
      const u16* qrow = (const u16*)(ws + OFF_BQ) + (size_t)t * 512;
#pragma unroll
      for (int s = 0; s < 4; ++s) {
        bf16x8 z = {0, 0, 0, 0, 0, 0, 0, 0};
        if (l15 < 8 && (l15 >> 2) == (s >> 1)) z = *(const bf16x8*)(qrow + l15 * 64 + 32 * (s & 1) + 8 * g4);
        qf[s] = z;
      }
    }
    float sum = 0.f;
#pragma unroll 4
    for (int tau = 0; tau < 16; ++tau) {
      const int slotA = 16 * tau + l15;
      int kidx = uselist ? (int)idxp[slotA] : slotA;
      if (slotA >= nvalid) kidx = 0;
      const u16* row = BKVb + (size_t)kidx * 256 + 8 * g4;
      bf16x8 ka[4];
#pragma unroll
      for (int s = 0; s < 4; ++s) ka[s] = *(const bf16x8*)(row + 32 * s);
      f32x4 c = zero4();
      __builtin_amdgcn_s_setprio(1);
#pragma unroll
      for (int s = 0; s < 4; ++s) c = MFMA16(ka[s], qf[s], c);
      __builtin_amdgcn_s_setprio(0);
#pragma unroll
      for (int r = 0; r < 4; ++r) {
        const int slot = 16 * tau + 4 * g4 + r;
        const float pe = (slot < nvalid) ? __expf(c[r]) : 0.f;
        sum += pe;
        if (l15 < 8) Sw[slot * 8 + l15] = pe;
      }
    }
    sum += __shfl_xor(sum, 16); sum += __shfl_xor(sum, 32);
    inv = 1.f / sum;
  }
  const int dc = (lane & 3) | (((lane >> 3) & 1) << 2);
  const int ks = ((lane >> 2) & 1) | ((lane >> 4) << 1);
  float o[8][8];
#pragma unroll
  for (int hd = 0; hd < 8; ++hd)
#pragma unroll
    for (int d = 0; d < 8; ++d) o[hd][d] = 0.f;
#pragma unroll ATT_UNROLL
  for (int it = 0; it < 32; ++it) {
    const int slot = it * 8 + ks;
    int kidx = uselist ? (int)idxp[slot] : slot;
    if (slot >= nvalid) kidx = 0;
    const u16* row = BKVb + (size_t)kidx * 256;
    const uint4 v0 = *(const uint4*)(row + 128 + dc * 8);
    const uint4 v1 = *(const uint4*)(row + 192 + dc * 8);
    const f32x4 pa = *(const f32x4*)(Sw + slot * 8);
    const f32x4 pb = *(const f32x4*)(Sw + slot * 8 + 4);
    float f0[8] = {bflo(v0.x), bfhi(v0.x), bflo(v0.y), bfhi(v0.y), bflo(v0.z), bfhi(v0.z), bflo(v0.w), bfhi(v0.w)};
    float f1[8] = {bflo(v1.x), bfhi(v1.x), bflo(v1.y), bfhi(v1.y), bflo(v1.z), bfhi(v1.z), bflo(v1.w), bfhi(v1.w)};
#pragma unroll
    for (int r = 0; r < 4; ++r) {
#pragma unroll
      for (int d = 0; d < 8; ++d) { o[r][d] += pa[r] * f0[d]; o[4 + r][d] += pb[r] * f1[d]; }
    }
  }
  float o4[4][8];
  {
    const bool up = ks & 4;
#pragma unroll
    for (int i = 0; i < 4; ++i)
#pragma unroll
      for (int d = 0; d < 8; ++d) { float keep = up ? o[4 + i][d] : o[i][d]; float send = up ? o[i][d] : o[4 + i][d]; o4[i][d] = keep + __shfl_xor(send, 32); }
  }
  float o2[2][8];
  {
    const bool up = ks & 2;
#pragma unroll
    for (int i = 0; i < 2; ++i)
#pragma unroll
      for (int d = 0; d < 8; ++d) { float keep = up ? o4[2 + i][d] : o4[i][d]; float send = up ? o4[i][d] : o4[2 + i][d]; o2[i][d] = keep + __shfl_xor(send, 16); }
  }
  float o1[8];
  {
    const bool up = ks & 1;
#pragma unroll
    for (int d = 0; d < 8; ++d) { float keep = up ? o2[1][d] : o2[0][d]; float send = up ? o2[0][d] : o2[1][d]; o1[d] = keep + __shfl_xor(send, 4); }
  }
  const float invh = __shfl(inv, ks);
  const u16* bz = (const u16*)(ws + OFF_BZ) + (size_t)t * 512 + ks * 64 + dc * 8;
  uint4 zz = *(const uint4*)bz;
  float zf[8] = {bflo(zz.x), bfhi(zz.x), bflo(zz.y), bfhi(zz.y), bflo(zz.z), bfhi(zz.z), bflo(zz.w), bfhi(zz.w)};
  uint4 ov;
  ov.x = pack2(o1[0] * invh * siluf_(zf[0]), o1[1] * invh * siluf_(zf[1]));
  ov.y = pack2(o1[2] * invh * siluf_(zf[2]), o1[3] * invh * siluf_(zf[3]));
  ov.z = pack2(o1[4] * invh * siluf_(zf[4]), o1[5] * invh * siluf_(zf[5]));
  ov.w = pack2(o1[6] * invh * siluf_(zf[6]), o1[7] * invh * siluf_(zf[7]));
  *(uint4*)((u16*)(ws + OFF_MIXB) + (size_t)t * 512 + ks * 64 + dc * 8) = ov;
}

DI void kb_item(const Params& P, int item, char* lds) {
  const int tid = otid();
  const int lane = tid & 63, wave = __builtin_amdgcn_readfirstlane(tid >> 6), hh = lane >> 5, l31 = lane & 31;
  const int b = item & 3, qt = 1023 - (item >> 2), t0 = qt * 4;
  char* ws = P.ws;
  float* Sl = (float*)lds;
  u16* myidx = (u16*)(lds + wave * 16384);
  float* mySw = (float*)(lds + wave * 16384 + 1024);
  if (t0 + 3 < 255) {
    __syncthreads();
    kb2_query(P, b * 4096 + t0 + wave, mySw, myidx);
    return;
  }
  const u16* IQ = (const u16*)(ws + OFF_IQ);
  const u16* IK = (const u16*)(ws + OFF_IK);
  const float* SMALL = (const float*)(ws + OFF_SMALL);
  const int T0 = b * 4096 + t0;
  __syncthreads();
  {
    bf16x8 af[8];
    const u16* src = IQ + (size_t)(T0 + ((l31 >> 2) & 1) + 2 * ((l31 >> 4) & 1)) * 1024 + ((l31 & 3) + 4 * ((l31 >> 3) & 1)) * 128 + 8 * hh;
#pragma unroll
    for (int s = 0; s < 8; ++s) af[s] = *(const bf16x8*)(src + 16 * s);
    float wv[16];
#pragma unroll
    for (int r = 0; r < 16; ++r) wv[r] = SMALL[(size_t)(T0 + hh + 2 * (r >> 3)) * 16 + 8 + (r & 3) + 4 * ((r >> 2) & 1)] * 0.03125f;
    const int ntile = (t0 + 4 + 31) >> 5;
    const u16* kbase = IK + (size_t)b * 128 * 4096 + lane * 8;
    const int nmine = ntile > wave ? (ntile - wave + 3) >> 2 : 0;
    bf16x8 c0[8], c1[8];
    {
      const int k0 = wave, k1 = nmine > 1 ? wave + 4 : wave;
      if (nmine > 0) {
#pragma unroll
        for (int s = 0; s < 8; ++s) { c0[s] = *(const bf16x8*)(kbase + (size_t)k0 * 4096 + 512 * s); c1[s] = *(const bf16x8*)(kbase + (size_t)k1 * 4096 + 512 * s); }
      }
    }
    for (int j = 0; j < nmine; j += 2) {
      const int kt0 = wave + 4 * j, kt1 = kt0 + 4;
      const bool has1 = j + 1 < nmine;
      bf16x8 n0[8], n1[8];
      {
        const int ka = j + 2 < nmine ? kt0 + 8 : kt0, kb2 = j + 3 < nmine ? kt0 + 12 : kt0;
#pragma unroll
        for (int s = 0; s < 8; ++s) { n0[s] = *(const bf16x8*)(kbase + (size_t)ka * 4096 + 512 * s); n1[s] = *(const bf16x8*)(kbase + (size_t)kb2 * 4096 + 512 * s); }
      }
      f32x16 acc0 = zero16(), acc1 = zero16();
      __builtin_amdgcn_s_setprio(1);
#pragma unroll
      for (int s = 0; s < 8; ++s) { acc0 = MFMA32(af[s], c0[s], acc0); acc1 = MFMA32(af[s], c1[s], acc1); }
      __builtin_amdgcn_s_setprio(0);
#pragma unroll
      for (int s = 0; s < 8; ++s) { c0[s] = n0[s]; c1[s] = n1[s]; }
      float sa0 = 0.f, sa1 = 0.f, sb0 = 0.f, sb1 = 0.f;
#pragma unroll
      for (int i = 0; i < 8; ++i) {
        sa0 += wv[i] * fmaxf(acc0[i], 0.f); sa1 += wv[8 + i] * fmaxf(acc0[8 + i], 0.f);
        sb0 += wv[i] * fmaxf(acc1[i], 0.f); sb1 += wv[8 + i] * fmaxf(acc1[8 + i], 0.f);
      }
      Sl[hh * 4096 + kt0 * 32 + l31] = sa0;
      Sl[(hh + 2) * 4096 + kt0 * 32 + l31] = sa1;
      if (has1) {
        Sl[hh * 4096 + kt1 * 32 + l31] = sb0;
        Sl[(hh + 2) * 4096 + kt1 * 32 + l31] = sb1;
      }
    }
  }
  __syncthreads();
  const int pos = t0 + wave;
  if (pos >= 255) {
    const int nchunk = (pos >> 10) + 1;
    u32 key[64];
#pragma unroll
    for (int c4 = 0; c4 < 4; ++c4) {
      if (c4 < nchunk) {
#pragma unroll
        for (int ii = 0; ii < 16; ++ii) {
          const int i = c4 * 16 + ii;
          const int idx = lane + 64 * i;
          float v = Sl[wave * 4096 + idx] + 0.0f;
          u32 u = __float_as_uint(v);
          u = (u & 0x80000000u) ? ~u : (u | 0x80000000u);
          key[i] = (idx <= pos) ? u : 0u;
        }
      } else {
#pragma unroll
        for (int ii = 0; ii < 16; ++ii) key[c4 * 16 + ii] = 0u;
      }
    }
    u32 g0 = key[0], g1 = key[1], g2 = key[2], g3 = key[3];
#pragma unroll
    for (int i = 4; i < 64; i += 4) { g0 = max(g0, key[i]); g1 = max(g1, key[i + 1]); g2 = max(g2, key[i + 2]); g3 = max(g3, key[i + 3]); }
    u32 lo = min(min(g0, g1), min(g2, g3)), hi = max(max(g0, g1), max(g2, g3));
#pragma unroll
    for (int d = 1; d < 64; d <<= 1) { lo = min(lo, (u32)__shfl_xor((int)lo, d)); hi = max(hi, (u32)__shfl_xor((int)hi, d)); }
    lo = __builtin_amdgcn_readfirstlane(lo); hi = __builtin_amdgcn_readfirstlane(hi);
    const u32 diff = lo ^ hi;
    const int topbit = diff ? 31 - __builtin_clz(diff) : -1;
    u32 Pv = topbit >= 31 ? 0u : (topbit < 0 ? lo : (lo & ~((2u << topbit) - 1u)));
    bool exact = false;
    for (int bit = topbit; bit >= 0; --bit) {
      const u32 cand = Pv | (1u << bit);
      int c = 0;
#pragma unroll
      for (int c4 = 0; c4 < 4; ++c4) {
        if (c4 < nchunk) {
#pragma unroll
          for (int ii = 0; ii < 16; ++ii) {
            c += __popcll(__ballot(key[c4 * 16 + ii] >= cand));
            if ((ii & 7) == 7) __builtin_amdgcn_sched_barrier(0);
          }
        }
      }
      if (c >= 256) {
        Pv = cand;
        if (c == 256) { exact = true; break; }
      }
    }
    int need = 1 << 30;
    if (!exact) {
      int cgt = 0;
#pragma unroll
      for (int c4 = 0; c4 < 4; ++c4) {
        if (c4 < nchunk) {
#pragma unroll
          for (int ii = 0; ii < 16; ++ii) {
            cgt += __popcll(__ballot(key[c4 * 16 + ii] > Pv));
            if ((ii & 7) == 7) __builtin_amdgcn_sched_barrier(0);
          }
        }
      }
      need = 256 - cgt;
    }
    u16* out = myidx;
    if (exact) {
      u32 mlo = 0u, mhi = 0u;
#pragma unroll
      for (int c4 = 0; c4 < 4; ++c4) {
        if (c4 < nchunk) {
#pragma unroll
          for (int ii = 0; ii < 16; ++ii) {
            const int i = c4 * 16 + ii;
            const u32 bit = (key[i] >= Pv) ? (1u << (i & 31)) : 0u;
            if (i < 32) mlo |= bit; else mhi |= bit;
          }
        }
      }
      const int cnt = __popc(mlo) + __popc(mhi);
      int incl = cnt;
#pragma unroll
      for (int d = 1; d < 64; d <<= 1) { const int tv = __shfl_up(incl, d); if (lane >= d) incl += tv; }
      int off = incl - cnt;
      while (mlo) { const int i = __ffs((int)mlo) - 1; out[off++] = (u16)(lane + 64 * i); mlo &= mlo - 1u; }
      while (mhi) { const int i = __ffs((int)mhi) - 1; out[off++] = (u16)(lane + 64 * (32 + i)); mhi &= mhi - 1u; }
    } else {
    int off = 0, eqseen = 0;
    const u64 ltmask = (1ull << lane) - 1ull;
#pragma unroll
    for (int c4 = 0; c4 < 4; ++c4) {
      if (c4 < nchunk) {
#pragma unroll
        for (int ii = 0; ii < 16; ++ii) {
          const int i = c4 * 16 + ii;
          const bool gt = key[i] > Pv, eq = key[i] == Pv;
          const u64 meq = __ballot(eq);
          const int rank = eqseen + __popcll(meq & ltmask);
          const bool sel = gt || (eq && rank < need);
          const u64 ms = __ballot(sel);
          if (sel) out[off + __popcll(ms & ltmask)] = (u16)(lane + 64 * i);
          off += __popcll(ms);
          eqseen += __popcll(meq);
          if ((ii & 3) == 3) __builtin_amdgcn_sched_barrier(0);
        }
      }
    }
    }
  }
  kb2_query(P, T0 + wave, mySw, myidx);
}

constexpr int KB_SPLIT = 1536;
DI int pull_item(unsigned* ctr, char* lds) {
  volatile LAS unsigned* slot = (volatile LAS unsigned*)(lds + LDS_BYTES - 8);
  __syncthreads();
  if (threadIdx.x == 0) *slot = __hip_atomic_fetch_add(ctr, 1u, __ATOMIC_RELAXED, __HIP_MEMORY_SCOPE_AGENT);
  __syncthreads();
  return (int)*slot;
}
DI void phase2(const Params& P, char* lds) {
  for (int it = blockIdx.x; it < 1024; it += gridDim.x) ka1_item(P, it, lds);
  if ((gridDim.x & 3) == 0) {
    const int bb = blockIdx.x & 3;
    unsigned* ctr = (unsigned*)(P.ws + OFF_BAR) + 16 * bb;
    for (;;) {
      const int k = pull_item(ctr, lds);
      if (k >= KB_SPLIT / 4) break;
      kb_item(P, 4 * k + bb, lds);
    }
  } else {
    for (int it = blockIdx.x; it < KB_SPLIT; it += gridDim.x) kb_item(P, it, lds);
  }
}

DI void ka2_scan(const Params& P, int bh, char* lds) {
  const int tid = otid(), lane = tid & 63, wave = tid >> 6, hh = lane >> 5, l31 = lane & 31;
  char* ws = P.ws;
  const int dv = 32 * wave + l31;
  const u16* WNEG = (const u16*)(ws + OFF_WNEG) + (size_t)bh * 64 * 8192;
  const u16* KDT = (const u16*)(ws + OFF_KDT) + (size_t)bh * 64 * 8192;
  const u16* UT = (const u16*)(ws + OFF_UT) + (size_t)bh * 64 * 8192 + dv * 8 + 4 * hh;
  const float* GL = (const float*)(ws + OFF_GL) + bh * 64;
  u16* HST = (u16*)((char*)P.out + OOFF_HST) + (size_t)bh * 64 * 16384 + dv * 8 + 4 * hh;
  u16* VNT = (u16*)((char*)P.out + OOFF_VNT) + (size_t)bh * 64 * 8192 + dv * 8 + 4 * hh;
  const int wbase = (tid >> 4) * 272 + ((tid & 15) << 4);
  const int kbase = 17408 + (tid >> 3) * 144 + ((tid & 7) << 4);
  u32x4 sw[4], sk[4];
  uint2 un[8];
  float gln;
  __syncthreads();
#pragma unroll
  for (int i = 0; i < 4; ++i) {
    sw[i] = *(const u32x4*)(WNEG + (size_t)(tid + 256 * i) * 8);
    sk[i] = *(const u32x4*)(KDT + (size_t)(tid + 256 * i) * 8);
  }
#pragma unroll
  for (int i = 0; i < 8; ++i) un[i] = *(const uint2*)(UT + i * 1024);
  gln = GL[0];
#pragma unroll
  for (int i = 0; i < 4; ++i) { *(u32x4*)(lds + wbase + i * 4352) = sw[i]; *(u32x4*)(lds + kbase + i * 4608) = sk[i]; }
  __syncthreads();
  f32x16 S[4];
#pragma unroll
  for (int m = 0; m < 4; ++m) S[m] = zero16();
  for (int n = 0; n < 64; ++n) {
    const char* buf = lds + (n & 1) * 35840;
    char* nbuf = lds + ((n + 1) & 1) * 35840;
    f32x16 vn[2];
#pragma unroll
    for (int tt = 0; tt < 2; ++tt) {
#pragma unroll
      for (int rg = 0; rg < 4; ++rg) {
        const uint2 u = un[4 * tt + rg];
        vn[tt][4 * rg] = bflo(u.x); vn[tt][4 * rg + 1] = bfhi(u.x); vn[tt][4 * rg + 2] = bflo(u.y); vn[tt][4 * rg + 3] = bfhi(u.y);
      }
    }
    const float gl = gln;
    if (n + 1 < 64) {
      const size_t o = (size_t)(n + 1) * 8192;
#pragma unroll
      for (int i = 0; i < 4; ++i) {
        sw[i] = *(const u32x4*)(WNEG + o + (size_t)(tid + 256 * i) * 8);
        sk[i] = *(const u32x4*)(KDT + o + (size_t)(tid + 256 * i) * 8);
      }
#pragma unroll
      for (int i = 0; i < 8; ++i) un[i] = *(const uint2*)(UT + o + i * 1024);
      gln = GL[n + 1];
    }
    u16* hst = HST + (size_t)n * 16384;
    u16* vnt = VNT + (size_t)n * 8192;
#pragma unroll
    for (int m = 0; m < 4; ++m) {
      u32 pk[8];
#pragma unroll
      for (int r = 0; r < 8; ++r) pk[r] = pack2(S[m][2 * r], S[m][2 * r + 1]);
#pragma unroll
      for (int rg = 0; rg < 4; ++rg) *(uint2*)(hst + (4 * m + rg) * 1024) = make_uint2(pk[2 * rg], pk[2 * rg + 1]);
      u32x4 f0 = {pk[0], pk[1], pk[2], pk[3]}, f1 = {pk[4], pk[5], pk[6], pk[7]};
      const bf16x8 sf0 = __builtin_bit_cast(bf16x8, f0), sf1 = __builtin_bit_cast(bf16x8, f1);
#pragma unroll
      for (int tt = 0; tt < 2; ++tt) {
        bf16x8 a0 = *(const bf16x8*)(buf + (l31 * 272 + 16 * hh) + (tt * 8704 + 32 * (2 * m)));
        bf16x8 a1 = *(const bf16x8*)(buf + (l31 * 272 + 16 * hh) + (tt * 8704 + 32 * (2 * m + 1)));
        vn[tt] = MFMA32(a0, sf0, vn[tt]);
        vn[tt] = MFMA32(a1, sf1, vn[tt]);
      }
      __builtin_amdgcn_sched_barrier(0);
    }
    bf16x8 vf[4];
#pragma unroll
    for (int tt = 0; tt < 2; ++tt) {
      u32 pk[8];
#pragma unroll
      for (int r = 0; r < 8; ++r) pk[r] = pack2(vn[tt][2 * r], vn[tt][2 * r + 1]);
#pragma unroll
      for (int rg = 0; rg < 4; ++rg) *(uint2*)(vnt + (4 * tt + rg) * 1024) = make_uint2(pk[2 * rg], pk[2 * rg + 1]);
      u32x4 f0 = {pk[0], pk[1], pk[2], pk[3]}, f1 = {pk[4], pk[5], pk[6], pk[7]};
      vf[2 * tt] = __builtin_bit_cast(bf16x8, f0);
      vf[2 * tt + 1] = __builtin_bit_cast(bf16x8, f1);
    }
#pragma unroll
    for (int m = 0; m < 4; ++m) {
#pragma unroll
      for (int r = 0; r < 16; ++r) S[m][r] *= gl;
    }
#pragma unroll
    for (int ks = 0; ks < 4; ++ks) {
#pragma unroll
      for (int m = 0; m < 4; ++m) {
        bf16x8 a = *(const bf16x8*)(buf + 17408 + (l31 * 144 + 16 * hh) + (m * 4608 + 32 * ks));
        S[m] = MFMA32(a, vf[ks], S[m]);
      }
      __builtin_amdgcn_sched_barrier(0);
    }
    if (n + 1 < 64) {
#pragma unroll
      for (int i = 0; i < 4; ++i) { *(u32x4*)(nbuf + wbase + i * 4352) = sw[i]; *(u32x4*)(nbuf + kbase + i * 4608) = sk[i]; }
    }
    __syncthreads();
  }
}

DI void phase3(const Params& P, char* lds) {
  const int G = gridDim.x;
  const int nscan = G > 32 ? 16 : 0;
  int first = KB_SPLIT + (int)blockIdx.x - nscan, stride = G - nscan;
  if ((int)blockIdx.x < 16 || nscan == 0) {
    for (int bh = blockIdx.x; bh < 16; bh += G) ka2_scan(P, bh, lds);
    if (nscan) first = 4096;
  }
  if (nscan && (G & 3) == 0) {
    if ((int)blockIdx.x >= 16) {
      const int bb = blockIdx.x & 3;
      unsigned* ctr = (unsigned*)(P.ws + OFF_BAR) + 64 + 16 * bb;
      for (;;) {
        const int k = KB_SPLIT / 4 + pull_item(ctr, lds);
        if (k >= 1024) break;
        kb_item(P, 4 * k + bb, lds);
      }
    }
  } else {
    for (int it = first; it < 4096; it += stride) kb_item(P, it, lds);
  }
}

DI void phase4(const Params& P, char* lds) {
  const int tid4 = otid(), lane = tid4 & 63, wave = tid4 >> 6, l15 = lane & 15, g4 = lane >> 4;
  char* ws = P.ws;
  float nw[8];
#pragma unroll
  for (int nt = 0; nt < 8; ++nt) nw[nt] = P.a_out_norm_w[16 * nt + l15];
  for (int ch = blockIdx.x; ch < 1024; ch += gridDim.x) {
    const int b = ch >> 8, h = (ch >> 6) & 3, n = ch & 63;
    const int tok0 = b * 4096 + n * 64;
    const u16* QD = (const u16*)(ws + OFF_QD) + (size_t)ch * 8192;
    const u16* ATT = (const u16*)(ws + OFF_ATT) + (size_t)ch * 4096;
    const u16* HST = (const u16*)((const char*)P.out + OOFF_HST) + (size_t)ch * 16384;
    const u16* VNT = (const u16*)((const char*)P.out + OOFF_VNT) + (size_t)ch * 8192;
    __syncthreads();
    {
      u32x4 st[12];
#pragma unroll
      for (int i = 0; i < 8; ++i) st[i] = *(const u32x4*)(HST + (size_t)(tid4 + 256 * i) * 8);
#pragma unroll
      for (int i = 0; i < 4; ++i) st[8 + i] = *(const u32x4*)(VNT + (size_t)(tid4 + 256 * i) * 8);
#pragma unroll
      for (int i = 0; i < 8; ++i) *(u32x4*)(lds + (tid4 + 256 * i) * 16) = st[i];
#pragma unroll
      for (int i = 0; i < 4; ++i) *(u32x4*)(lds + 32768 + (tid4 + 256 * i) * 16) = st[8 + i];
    }
    __syncthreads();
    const u16* HSl = (const u16*)lds;
    const u16* VNl = (const u16*)(lds + 32768);
    f32x4 acc[8];
#pragma unroll
    for (int nt = 0; nt < 8; ++nt) acc[nt] = zero4();
#pragma unroll
    for (int ks = 0; ks < 4; ++ks) {
      bf16x8 a = *(const bf16x8*)(QD + (16 * wave + l15) * 128 + 32 * ks + 8 * g4);
#pragma unroll
      for (int nt = 0; nt < 8; ++nt) {
        bf16x8 bb = *(const bf16x8*)(HSl + (4 * ks + g4) * 1024 + (16 * nt + l15) * 8);
        acc[nt] = MFMA16(a, bb, acc[nt]);
      }
    }
#pragma unroll
    for (int ks = 0; ks < 2; ++ks) {
      bf16x8 a = *(const bf16x8*)(ATT + (16 * wave + l15) * 64 + 32 * ks + 8 * g4);
#pragma unroll
      for (int nt = 0; nt < 8; ++nt) {
        bf16x8 bb = *(const bf16x8*)(VNl + (4 * ks + g4) * 1024 + (16 * nt + l15) * 8);
        acc[nt] = MFMA16(a, bb, acc[nt]);
      }
    }
    float zg[4][8];
#pragma unroll
    for (int r = 0; r < 4; ++r) {
      const u16* az = (const u16*)(ws + OFF_AZ) + (size_t)(tok0 + 16 * wave + 4 * g4 + r) * 512 + h * 128;
#pragma unroll
      for (int nt = 0; nt < 8; ++nt) zg[r][nt] = bf2f(az[16 * nt + l15]);
    }
#pragma unroll
    for (int r = 0; r < 4; ++r) {
      float ss = 0.f;
#pragma unroll
      for (int nt = 0; nt < 8; ++nt) ss += acc[nt][r] * acc[nt][r];
      ss += __shfl_xor(ss, 1); ss += __shfl_xor(ss, 2); ss += __shfl_xor(ss, 4); ss += __shfl_xor(ss, 8);
      const float rs = rsqrtf(ss * (1.f / 128.f) + EPS);
      const int t = tok0 + 16 * wave + 4 * g4 + r;
      u16* mix = (u16*)(ws + OFF_MIXA) + (size_t)t * 512 + h * 128;
#pragma unroll
      for (int nt = 0; nt < 8; ++nt) {
        const int dv = 16 * nt + l15;
        mix[dv] = f2bf(acc[nt][r] * rs * nw[nt] * siluf_(zg[r][nt]));
      }
    }
  }
}

DI void phase5(const Params& P, char* lds) {
  char* ws = P.ws;
  const u16* MIXA = (const u16*)(ws + OFF_MIXA);
  const u16* MIXB = (const u16*)(ws + OFF_MIXB);
  const u16* WT = (const u16*)(ws + OFF_WT_OUT);
  float* X1 = (float*)(ws + OFF_X1);
  u16* X1B = (u16*)(ws + OFF_X1B);
  float* SS = (float*)(ws + OFF_SUMSQ);
  const int lane = otid() & 63, wave = otid() >> 6;
  const int wm = wave & 1, wn = wave >> 1, l31 = lane & 31, hh = lane >> 5;
  const bool xswz = (gridDim.x & 7) == 0;
  const int xq = blockIdx.x >> 3, xn = gridDim.x >> 3, xx = blockIdx.x & 7;
  for (int tile = xswz ? xq : (int)blockIdx.x; tile < (xswz ? 64 : 512); tile += (xswz ? xn : (int)gridDim.x)) {
    const int mt = xswz ? 8 * xx + (tile & 7) : (tile >> 3), nt = xswz ? (tile >> 3) : (tile & 7);
    f32x16 acc[4][2];
#pragma unroll
    for (int i = 0; i < 4; ++i)
#pragma unroll
      for (int j = 0; j < 2; ++j) acc[i][j] = zero16();
    gemm_mainloop<4>(MIXA, 512, WT, 1024, 512, mt * 256, nt * 128, lds, acc);
    gemm_mainloop<4>(MIXB, 512, WT + 512, 1024, 512, mt * 256, nt * 128, lds, acc);
    {
      const size_t e0 = (size_t)(mt * 256 + wm * 128 + 4 * hh) * 1024 + nt * 128 + wn * 64 + l31;
      float* ssp0 = SS + (mt * 256 + wm * 128 + 4 * hh);
#pragma unroll
      for (int i = 0; i < 4; ++i) {
        float xa[16], xb[16];
        {
          const float* xp = P.x + e0 + (size_t)i * 32 * 1024;
#pragma unroll
          for (int r = 0; r < 16; ++r) {
            xa[r] = xp[0]; xb[r] = xp[32];
            xp += (((r & 3) == 3) ? 5 : 1) * 1024;
            asm volatile("" : "+v"(xp));
          }
        }
        float* x1p = X1 + e0 + (size_t)i * 32 * 1024;
        u16* x1bp = X1B + e0 + (size_t)i * 32 * 1024;
        float* ssp = ssp0 + i * 32;
#pragma unroll
        for (int r = 0; r < 16; ++r) {
          const float va = xa[r] + acc[i][0][r], vb = xb[r] + acc[i][1][r];
          x1p[0] = va; x1p[32] = vb;
          x1bp[0] = f2bf(va); x1bp[32] = f2bf(vb);
          float ss = va * va + vb * vb;
          ss += dpp_xor1(ss); ss += dpp_xor2(ss); ss += __shfl_xor(ss, 4); ss += dpp_xor8(ss); ss += __shfl_xor(ss, 16);
          if (l31 == 0) atomicAdd(ssp, ss);
          const int step = ((r & 3) == 3) ? 5 : 1;
          x1p += step * 1024; x1bp += step * 1024; ssp += step;
          asm volatile("" : "+v"(x1p), "+v"(x1bp), "+v"(ssp));
        }
      }
    }
  }
}

DI void phase6(const Params& P, char* lds) {
  char* ws = P.ws;
  const u16* X1B = (const u16*)(ws + OFF_X1B);
  const float* X1 = (const float*)(ws + OFF_X1);
  const u16* WG = (const u16*)(ws + OFF_WT_GATE);
  const u16* WP = (const u16*)(ws + OFF_WT_PLE);
  const u16* PB = (const u16*)(ws + OFF_PB);
  const float* SS = (const float*)(ws + OFF_SUMSQ);
  const int lane = otid() & 63, wave = otid() >> 6;
  const int wm = wave & 1, wn = wave >> 1, l31 = lane & 31, hh = lane >> 5;
  const bool xswz = (gridDim.x & 7) == 0;
  const int xq = blockIdx.x >> 3, xn = gridDim.x >> 3, xx = blockIdx.x & 7;
  for (int tile = xswz ? xq : (int)blockIdx.x; tile < (xswz ? 128 : 1024); tile += (xswz ? xn : (int)gridDim.x)) {
    const int mt = xswz ? 16 * xx + (tile & 15) : (tile >> 3), nt = xswz ? (tile >> 4) : (tile & 7);
    f32x16 ag[2][2], ap[2][2];
#pragma unroll
    for (int i = 0; i < 2; ++i)
#pragma unroll
      for (int j = 0; j < 2; ++j) { ag[i][j] = zero16(); ap[i][j] = zero16(); }
    gemm_mainloop<2>(X1B, 1024, WG, 1024, 1024, mt * 128, nt * 128, lds, ag);
    gemm_mainloop<2>(PB, 256, WP, 256, 256, mt * 128, nt * 128, lds, ap);
    const size_t e0 = (size_t)(mt * 128 + wm * 64 + 4 * hh) * 1024 + nt * 128 + wn * 64 + l31;
    const float b0 = P.b_ple_gate[nt * 128 + wn * 64 + l31], b1 = P.b_ple_gate[nt * 128 + wn * 64 + 32 + l31];
    const float* ssp0 = SS + (mt * 128 + wm * 64 + 4 * hh);
#pragma unroll
    for (int i = 0; i < 2; ++i) {
      float rsv[16], xa[16], xb[16];
#pragma unroll
      for (int r = 0; r < 16; ++r) rsv[r] = ssp0[i * 32 + (r & 3) + 8 * (r >> 2)];
      {
        const float* x1p = X1 + e0 + (size_t)i * 32 * 1024;
#pragma unroll
        for (int r = 0; r < 16; ++r) {
          xa[r] = x1p[0]; xb[r] = x1p[32];
          x1p += (((r & 3) == 3) ? 5 : 1) * 1024;
          asm volatile("" : "+v"(x1p));
        }
      }
      float* op = P.out + e0 + (size_t)i * 32 * 1024;
#pragma unroll
      for (int r = 0; r < 16; ++r) {
        const float rs = rsqrtf(rsv[r] * (1.f / 1024.f) + EPS);
        op[0] = xa[r] + ap[i][0][r] * sigmoidf_(rs * ag[i][0][r] + b0);
        op[32] = xb[r] + ap[i][1][r] * sigmoidf_(rs * ag[i][1][r] + b1);
        op += (((r & 3) == 3) ? 5 : 1) * 1024;
        asm volatile("" : "+v"(op));
      }
    }
  }
}

template <int PH>
DI void run_phase(const Params& P, char* lds) {
  if (PH == 0) phase0(P);
  else if (PH == 1) phase1(P, lds);
  else if (PH == 2) phase2(P, lds);
  else if (PH == 3) phase3(P, lds);
  else if (PH == 4) phase4(P, lds);
  else if (PH == 5) phase5(P, lds);
  else phase6(P, lds);
}

template <int PH>
__global__ void __launch_bounds__(256, 2) phase_kernel(Params P) {
  __shared__ __attribute__((aligned(16))) char lds[LDS_BYTES];
  run_phase<PH>(P, lds);
}

__global__ void __launch_bounds__(256, 2) mega(Params P) {
  __shared__ __attribute__((aligned(16))) char lds[LDS_BYTES];
  volatile LAS unsigned* st = (volatile LAS unsigned*)(lds + LDS_BYTES - 16);
  if (threadIdx.x == 0) { st[0] = 0u; st[1] = 0u; }
  __syncthreads();
  if (P.ws == nullptr) cg::this_grid().sync();
  XcdBarrier xb = xcd_barrier_post((unsigned*)(P.ws + OFF_BAR), st);
  run_phase<0>(P, lds); xcd_barrier(xb);
  run_phase<1>(P, lds); xcd_barrier(xb);
  run_phase<2>(P, lds); xcd_barrier(xb);
  run_phase<3>(P, lds); xcd_barrier(xb);
  run_phase<4>(P, lds); xcd_barrier(xb);
  run_phase<5>(P, lds); xcd_barrier(xb);
  run_phase<6>(P, lds);
}

extern "C" void kernel_launch(void* const* d_in, const int* in_sizes, int n_in, void* d_out, int out_size, void* d_ws,
                              size_t ws_size, hipStream_t stream) {
  Params P{};
  P.x = (const float*)d_in[0]; P.p = (const float*)d_in[1]; P.attn_norm_w = (const float*)d_in[2];
  P.w_in = (const float*)d_in[3]; P.conv_w = (const float*)d_in[4]; P.a_log = (const float*)d_in[5];
  P.dt_bias = (const float*)d_in[6]; P.a_out_norm_w = (const float*)d_in[7]; P.b_q_norm_w = (const float*)d_in[8];
  P.b_k_norm_w = (const float*)d_in[9]; P.w_out = (const float*)d_in[10]; P.w_ple = (const float*)d_in[11];
  P.ple_gate_norm_w = (const float*)d_in[12]; P.w_ple_gate = (const float*)d_in[13]; P.b_ple_gate = (const float*)d_in[14];
  P.out = (float*)d_out; P.ws = (char*)d_ws;
  static int grid_blocks = 0;
  if (!grid_blocks) {
    int dev = 0, cus = 0, per_cu = 0;
    (void)hipGetDevice(&dev);
    (void)hipDeviceGetAttribute(&cus, hipDeviceAttributeMultiprocessorCount, dev);
    (void)hipOccupancyMaxActiveBlocksPerMultiprocessor(&per_cu, mega, 256, 0);
    if (per_cu > 2) per_cu = 2;
    if (per_cu < 1) per_cu = 1;
    grid_blocks = cus * per_cu;
  }
#ifdef MULTI_LAUNCH
  hipLaunchKernelGGL(phase_kernel<0>, dim3(grid_blocks), dim3(256), 0, stream, P);
  hipLaunchKernelGGL(phase_kernel<1>, dim3(grid_blocks), dim3(256), 0, stream, P);
  hipLaunchKernelGGL(phase_kernel<2>, dim3(grid_blocks), dim3(256), 0, stream, P);
  hipLaunchKernelGGL(phase_kernel<3>, dim3(grid_blocks), dim3(256), 0, stream, P);
  hipLaunchKernelGGL(phase_kernel<4>, dim3(grid_blocks), dim3(256), 0, stream, P);
  hipLaunchKernelGGL(phase_kernel<5>, dim3(grid_blocks), dim3(256), 0, stream, P);
  hipLaunchKernelGGL(phase_kernel<6>, dim3(grid_blocks), dim3(256), 0, stream, P);
#else
  (void)hipMemsetAsync((char*)d_ws + OFF_BAR, 0, XCD_BAR_WORDS * 4, stream);
  void* args[] = {&P};
  hipError_t e = hipLaunchCooperativeKernel((void*)mega, dim3(grid_blocks), dim3(256), args, 0, stream);
  if (e != hipSuccess) fprintf(stderr, "cooperative launch failed: %s (grid %d)\n", hipGetErrorString(e), grid_blocks);
#endif
}
```

```cpp
#include <hip/hip_runtime.h>
#include <hip/hip_cooperative_groups.h>
#include <cstdio>
namespace cg = cooperative_groups;

typedef unsigned short u16;
typedef unsigned int u32;
typedef unsigned long long u64;
using bf16x8 = __attribute__((ext_vector_type(8))) short;
using f32x16 = __attribute__((ext_vector_type(16))) float;
using f32x4 = __attribute__((ext_vector_type(4))) float;
using u32x4 = __attribute__((ext_vector_type(4))) unsigned;
#define DI __device__ __forceinline__
#define MFMA32(a, b, c) __builtin_amdgcn_mfma_f32_32x32x16_bf16((a), (b), (c), 0, 0, 0)
#define MFMA16(a, b, c) __builtin_amdgcn_mfma_f32_16x16x32_bf16((a), (b), (c), 0, 0, 0)

constexpr int T_ = 16384;
constexpr float EPS = 1e-6f;

constexpr size_t OFF_WT_IN = 0;
constexpr size_t OFF_WT_OUT = OFF_WT_IN + (size_t)4608 * 1024 * 2;
constexpr size_t OFF_WT_GATE = OFF_WT_OUT + (size_t)1024 * 1024 * 2;
constexpr size_t OFF_WT_PLE = OFF_WT_GATE + (size_t)1024 * 1024 * 2;
constexpr size_t OFF_PB = OFF_WT_PLE + (size_t)1024 * 256 * 2;
constexpr size_t OFF_SUMSQ = OFF_PB + (size_t)T_ * 256 * 2;
constexpr size_t OFF_QKV = OFF_SUMSQ + (size_t)T_ * 4;
constexpr size_t OFF_MIXA = OFF_QKV;
constexpr size_t OFF_AZ = OFF_QKV + (size_t)T_ * 1536 * 2;
constexpr size_t OFF_BQ = OFF_AZ + (size_t)T_ * 512 * 2;
constexpr size_t OFF_BKV = OFF_BQ + (size_t)T_ * 512 * 2;
constexpr size_t OFF_BZ = OFF_BKV + (size_t)T_ * 256 * 2;
constexpr size_t OFF_IQ = OFF_BZ + (size_t)T_ * 512 * 2;
constexpr size_t OFF_IK = OFF_IQ + (size_t)T_ * 1024 * 2;
constexpr size_t OFF_SMALL = OFF_IK + (size_t)T_ * 128 * 2;
constexpr size_t OFF_H = OFF_SMALL + (size_t)T_ * 16 * 4;
constexpr size_t OFF_WNEG = OFF_H;
constexpr size_t OFF_KDT = OFF_WNEG + (size_t)1024 * 8192 * 2;
constexpr size_t OFF_UT = OFF_H + (size_t)T_ * 1024 * 2;
constexpr size_t OFF_QD = OFF_UT + (size_t)1024 * 8192 * 2;
constexpr size_t OFF_ATT = OFF_QD + (size_t)1024 * 8192 * 2;
constexpr size_t OFF_GL = OFF_ATT + (size_t)1024 * 4096 * 2;
constexpr size_t OFF_BAR = OFF_GL + 4096;
constexpr size_t OFF_MIXB = OFF_BAR + 16384;
constexpr size_t WS_END = OFF_MIXB + (size_t)T_ * 512 * 2;
constexpr size_t OFF_X1 = OFF_AZ;
constexpr size_t OFF_X1B = OFF_X1 + (size_t)T_ * 1024 * 4;
static_assert(OFF_X1B + (size_t)T_ * 1024 * 2 <= OFF_UT, "x1 alias overlaps live data");
static_assert(WS_END <= (size_t)256 * 1024 * 1024, "ws too small");
constexpr size_t OOFF_HST = 0;
constexpr size_t OOFF_VNT = OOFF_HST + (size_t)1024 * 16384 * 2;
constexpr size_t OOFF_IDX = OOFF_VNT + (size_t)1024 * 8192 * 2;
static_assert(OOFF_IDX + (size_t)T_ * 256 * 2 <= (size_t)T_ * 1024 * 4, "d_out scratch");

constexpr int LDS_BYTES = 72 * 1024;

struct Params {
  const float *x, *p, *attn_norm_w, *w_in, *conv_w, *a_log, *dt_bias, *a_out_norm_w, *b_q_norm_w, *b_k_norm_w,
      *w_out, *w_ple, *ple_gate_norm_w, *w_ple_gate, *b_ple_gate;
  float* out;
  char* ws;
};

DI int otid() { int t = threadIdx.x; asm volatile("" : "+v"(t)); return t; }
DI float dpp_xor1(float v) { return __int_as_float(__builtin_amdgcn_update_dpp(0, __float_as_int(v), 0xB1, 0xF, 0xF, true)); }
DI float dpp_xor2(float v) { return __int_as_float(__builtin_amdgcn_update_dpp(0, __float_as_int(v), 0x4E, 0xF, 0xF, true)); }
DI float dpp_xor8(float v) { return __int_as_float(__builtin_amdgcn_update_dpp(0, __float_as_int(v), 0x128, 0xF, 0xF, true)); }
DI u16 f2bf(float x) { u32 u = __float_as_uint(x); u += 0x7fffu + ((u >> 16) & 1u); return (u16)(u >> 16); }
DI float bf2f(u16 v) { return __uint_as_float(((u32)v) << 16); }
DI u32 pack2(float a, float b) { return (u32)f2bf(a) | ((u32)f2bf(b) << 16); }
DI float bflo(u32 v) { return __uint_as_float(v << 16); }
DI float bfhi(u32 v) { return __uint_as_float(v & 0xffff0000u); }
DI float sigmoidf_(float x) { return 1.f / (1.f + __expf(-x)); }
DI float siluf_(float x) { return x / (1.f + __expf(-x)); }
DI f32x16 zero16() { f32x16 z; for (int i = 0; i < 16; ++i) z[i] = 0.f; return z; }
DI f32x4 zero4() { f32x4 z; for (int i = 0; i < 4; ++i) z[i] = 0.f; return z; }


#define XB_TMO      128
#define XB_XCNT(j)  (256  + 64 * (j))
#define XB_XSUB(j)  (1280 + 64 * (j))
#define XB_XGEN(j)  (2304 + 64 * (j))
#define XB_TOP      3328
#define XB_TOPGEN   3392
#define XCD_BAR_WORDS 3456
#define XB_SPIN_CAP (1u << 22)
#define LAS __attribute__((address_space(3)))
DI unsigned xb_ld(unsigned* p) { return __hip_atomic_load(p, __ATOMIC_RELAXED, __HIP_MEMORY_SCOPE_AGENT); }
DI unsigned xb_add(unsigned* p, unsigned v) { return __hip_atomic_fetch_add(p, v, __ATOMIC_RELAXED, __HIP_MEMORY_SCOPE_AGENT); }
DI unsigned xb_xcc_id() { return (unsigned)__builtin_amdgcn_s_getreg((3 << 11) | 20) & 0xFu; }
#define XB_SPIN(cond, bar) do { unsigned _sp = 0; while (cond) { __builtin_amdgcn_s_sleep(1); \
    if ((++_sp & 255u) == 0u) { if (xb_ld(&(bar)[XB_TMO])) break; if (_sp > XB_SPIN_CAP) { atomicAdd(&(bar)[XB_TMO], 1u); break; } } } } while (0)
struct XcdBarrier { unsigned* bar; unsigned x; volatile LAS unsigned* st; };
DI XcdBarrier xcd_barrier_post(unsigned* bar, volatile LAS unsigned* st) {
  XcdBarrier b; b.bar = bar; b.x = xb_xcc_id(); b.st = st;
  if (threadIdx.x == 0) (void)xb_add(&bar[XB_XCNT(b.x)], 1u);
  return b;
}
DI void xcd_barrier_complete(unsigned* bar, unsigned x, unsigned& nloc, unsigned& nx) {
  const unsigned G = gridDim.x * gridDim.y * gridDim.z;
  unsigned sum, cnt, mine, sp = 0u;
  for (;;) {
    sum = 0u; cnt = 0u; mine = 0u;
#pragma unroll
    for (unsigned j = 0; j < 16; ++j) { const unsigned c = xb_ld(&bar[XB_XCNT(j)]); sum += c; cnt += (c > 0u) ? 1u : 0u; mine = (j == x) ? c : mine; }
    if (sum == G) break;
    __builtin_amdgcn_s_sleep(1);
    if ((++sp & 255u) == 0u) { if (xb_ld(&bar[XB_TMO])) break; if (sp > XB_SPIN_CAP) { atomicAdd(&bar[XB_TMO], 1u); break; } }
  }
  nloc = mine > 0u ? mine : 1u; nx = cnt > 0u ? cnt : 1u;
}
DI void xcd_barrier(const XcdBarrier& b) {
  asm volatile("s_waitcnt vmcnt(0)" ::: "memory");
  __syncthreads();
  if (threadIdx.x == 0) {
    unsigned* bar = b.bar;
    __builtin_amdgcn_s_waitcnt(0);
    unsigned nloc = b.st[0], nx = b.st[1];
    if (nloc == 0u) { xcd_barrier_complete(bar, b.x, nloc, nx); b.st[0] = nloc; b.st[1] = nx; }
    const unsigned old = xb_add(&bar[XB_XSUB(b.x)], 1u);
    const unsigned gen = old / nloc;
    if (old + 1u == (gen + 1u) * nloc) {
      __builtin_amdgcn_fence(__ATOMIC_RELEASE, "agent");
      asm volatile("s_waitcnt vmcnt(0)" ::: "memory");
      const unsigned og = xb_add(&bar[XB_TOP], 1u);
      const unsigned tg = og / nx;
      if (og + 1u == (tg + 1u) * nx) xb_add(&bar[XB_TOPGEN], 1u);
      else XB_SPIN(xb_ld(&bar[XB_TOPGEN]) == tg, bar);
      __builtin_amdgcn_fence(__ATOMIC_ACQUIRE, "agent");
      xb_add(&bar[XB_XGEN(b.x)], 1u);
      asm volatile("s_waitcnt vmcnt(0)" ::: "memory");
    } else {
      XB_SPIN(xb_ld(&bar[XB_XGEN(b.x)]) == gen, bar);
      __builtin_amdgcn_fence(__ATOMIC_ACQUIRE, "agent");
      asm volatile("s_waitcnt vmcnt(0)" ::: "memory");
    }
  }
  __syncthreads();
}

template <bool SCALE>
DI void transpose_w(const float* __restrict__ W, int ldw, int K, int NP, int NV, u16* __restrict__ wt,
                    const float* __restrict__ scale, bool remap, size_t gtid, size_t gsz) {
  const int kchunks = K / 8;
  for (size_t it = gtid; it < (size_t)NP * kchunks; it += gsz) {
    int j = (int)(it % NP), kc = (int)(it / NP);
    uint4 o = make_uint4(0, 0, 0, 0);
    if (j < NV) {
      int src = j;
      if (remap) src = j < 2048 ? j : (j < 4480 ? j + 8 : (j < 4488 ? 2048 + (j - 4480) : j));
      float v[8];
#pragma unroll
      for (int i = 0; i < 8; ++i) {
        v[i] = W[(size_t)(kc * 8 + i) * ldw + src];
        if (SCALE) v[i] *= scale[kc * 8 + i];
      }
      o.x = pack2(v[0], v[1]); o.y = pack2(v[2], v[3]); o.z = pack2(v[4], v[5]); o.w = pack2(v[6], v[7]);
    }
    *(uint4*)(wt + (size_t)j * K + kc * 8) = o;
  }
}

DI void phase0(const Params& P) {
  const int tid = otid(), lane = tid & 63, wave = tid >> 6;
  const size_t gtid = (size_t)blockIdx.x * 256 + tid, gsz = (size_t)gridDim.x * 256;
  char* ws = P.ws;
  transpose_w<false>(P.w_in, 4496, 1024, 4608, 4496, (u16*)(ws + OFF_WT_IN), nullptr, true, gtid, gsz);
  transpose_w<false>(P.w_out, 1024, 1024, 1024, 1024, (u16*)(ws + OFF_WT_OUT), nullptr, false, gtid, gsz);
  transpose_w<true>(P.w_ple_gate, 1024, 1024, 1024, 1024, (u16*)(ws + OFF_WT_GATE), P.ple_gate_norm_w, false, gtid, gsz);
  transpose_w<false>(P.w_ple, 1024, 256, 1024, 1024, (u16*)(ws + OFF_WT_PLE), nullptr, false, gtid, gsz);
  {
    u16* pb = (u16*)(ws + OFF_PB);
    for (size_t it = gtid; it < (size_t)T_ * 256 / 8; it += gsz) {
      float4 a = *(const float4*)(P.p + it * 8), b = *(const float4*)(P.p + it * 8 + 4);
      uint4 o; o.x = pack2(a.x, a.y); o.y = pack2(a.z, a.w); o.z = pack2(b.x, b.y); o.w = pack2(b.z, b.w);
      *(uint4*)(pb + it * 8) = o;
    }
  }
  {
    float* ss = (float*)(ws + OFF_SUMSQ);
    for (size_t it = gtid; it < (size_t)T_; it += gsz) ss[it] = 0.f;
  }
  {
    u16* H = (u16*)(ws + OFF_H);
    const int gw = blockIdx.x * 4 + wave, nw = gridDim.x * 4;
    for (int row0 = gw * 4; row0 < T_; row0 += nw * 4) {
      float4 v[4][4];
#pragma unroll
      for (int rr = 0; rr < 4; ++rr)
#pragma unroll
        for (int i = 0; i < 4; ++i) v[rr][i] = *(const float4*)(P.x + (size_t)(row0 + rr) * 1024 + lane * 4 + 256 * i);
      float4 g[4];
#pragma unroll
      for (int i = 0; i < 4; ++i) g[i] = *(const float4*)(P.attn_norm_w + lane * 4 + 256 * i);
#pragma unroll
      for (int rr = 0; rr < 4; ++rr) {
        float ss = 0.f;
#pragma unroll
        for (int i = 0; i < 4; ++i) ss += v[rr][i].x * v[rr][i].x + v[rr][i].y * v[rr][i].y + v[rr][i].z * v[rr][i].z + v[rr][i].w * v[rr][i].w;
#pragma unroll
        for (int d = 1; d < 64; d <<= 1) ss += __shfl_xor(ss, d);
        const float r = rsqrtf(ss * (1.f / 1024.f) + EPS);
#pragma unroll
        for (int i = 0; i < 4; ++i) {
          uint2 o; o.x = pack2(v[rr][i].x * r * g[i].x, v[rr][i].y * r * g[i].y); o.y = pack2(v[rr][i].z * r * g[i].z, v[rr][i].w * r * g[i].w);
          *(uint2*)(H + (size_t)(row0 + rr) * 1024 + lane * 4 + 256 * i) = o;
        }
      }
    }
  }
}

template <int MT>
DI void gemm_mainloop(const u16* __restrict__ A, int lda, const u16* __restrict__ Bt, int ldb, int K, int m0, int n0,
                      char* lds, f32x16 (&acc)[MT][2]) {
  const int tid = otid(), lane = tid & 63, wave = tid >> 6;
  const int wm = wave & 1, wn = wave >> 1, l31 = lane & 31, hh = lane >> 5;
  constexpr int BM = 64 * MT;
  char* ldsA = lds;
  char* ldsB = lds + BM * 128;
  const int lrow = tid >> 3, kc = tid & 7;
  const u16* ga = A + (size_t)(m0 + lrow) * lda + kc * 8;
  const u16* gb = Bt + (size_t)(n0 + lrow) * ldb + kc * 8;
  u32x4 ra[2 * MT], rb[4];
#pragma unroll
  for (int i = 0; i < 2 * MT; ++i) ra[i] = *(const u32x4*)(ga + (size_t)(32 * i) * lda);
#pragma unroll
  for (int i = 0; i < 4; ++i) rb[i] = *(const u32x4*)(gb + (size_t)(32 * i) * ldb);
  const int woff = lrow * 128 + ((kc ^ ((lrow >> 1) & 7)) << 4);
  const int nk = K >> 6;
  for (int kt = 0; kt < nk; ++kt) {
    __syncthreads();
#pragma unroll
    for (int i = 0; i < 2 * MT; ++i) *(u32x4*)(ldsA + woff + i * 4096) = ra[i];
#pragma unroll
    for (int i = 0; i < 4; ++i) *(u32x4*)(ldsB + woff + i * 4096) = rb[i];
    __syncthreads();
    if (kt + 1 < nk) {
#pragma unroll
      for (int i = 0; i < 2 * MT; ++i) ra[i] = *(const u32x4*)(ga + (size_t)(32 * i) * lda + (kt + 1) * 64);
#pragma unroll
      for (int i = 0; i < 4; ++i) rb[i] = *(const u32x4*)(gb + (size_t)(32 * i) * ldb + (kt + 1) * 64);
    }
#pragma unroll
    for (int s = 0; s < 4; ++s) {
      bf16x8 af[MT], bfr[2];
      const int c = 2 * s + hh;
#pragma unroll
      for (int i = 0; i < MT; ++i) {
        int row = wm * (32 * MT) + i * 32 + l31;
        af[i] = *(const bf16x8*)(ldsA + row * 128 + ((c ^ ((row >> 1) & 7)) << 4));
      }
#pragma unroll
      for (int j = 0; j < 2; ++j) {
        int rowb = wn * 64 + j * 32 + l31;
        bfr[j] = *(const bf16x8*)(ldsB + rowb * 128 + ((c ^ ((rowb >> 1) & 7)) << 4));
      }
#pragma unroll
      for (int i = 0; i < MT; ++i)
#pragma unroll
        for (int j = 0; j < 2; ++j) acc[i][j] = MFMA32(af[i], bfr[j], acc[i][j]);
    }
  }
}

DI void phase1(const Params& P, char* lds) {
  char* ws = P.ws;
  const u16* H = (const u16*)(ws + OFF_H);
  const u16* WT = (const u16*)(ws + OFF_WT_IN);
  const int lane = otid() & 63, wave = otid() >> 6;
  const int wm = wave & 1, wn = wave >> 1, l31 = lane & 31, hh = lane >> 5;
  const bool xswz = (gridDim.x & 7) == 0;
  const int xq = blockIdx.x >> 3, xn = gridDim.x >> 3, xx = blockIdx.x & 7;
  for (int tile = xswz ? xq : (int)blockIdx.x; tile < (xswz ? 8 * 36 : 64 * 36); tile += (xswz ? xn : (int)gridDim.x)) {
    const int mt = xswz ? 8 * xx + (tile & 7) : tile / 36, nt = xswz ? (tile >> 3) : tile % 36;
    f32x16 acc[4][2];
#pragma unroll
    for (int i = 0; i < 4; ++i)
#pragma unroll
      for (int j = 0; j < 2; ++j) acc[i][j] = zero16();
    gemm_mainloop<4>(H, 1024, WT, 1024, 1024, mt * 256, nt * 128, lds, acc);
    const int n0 = nt * 128;
    if (n0 < 4480) {
      u16* base; int ld, c0;
      if (n0 < 1536) { base = (u16*)(ws + OFF_QKV); ld = 1536; c0 = n0; }
      else if (n0 < 2048) { base = (u16*)(ws + OFF_AZ); ld = 512; c0 = n0 - 1536; }
      else if (n0 < 2560) { base = (u16*)(ws + OFF_BQ); ld = 512; c0 = n0 - 2048; }
      else if (n0 < 2816) { base = (u16*)(ws + OFF_BKV); ld = 256; c0 = n0 - 2560; }
      else if (n0 < 3328) { base = (u16*)(ws + OFF_BZ); ld = 512; c0 = n0 - 2816; }
      else if (n0 < 4352) { base = (u16*)(ws + OFF_IQ); ld = 1024; c0 = n0 - 3328; }
      else { base = (u16*)(ws + OFF_IK); ld = 128; c0 = n0 - 4352; }
      const bool qn = (n0 >= 2048 && n0 < 2560), kn = (n0 == 2560);
      float w0 = 1.f, w1 = 1.f;
      if (qn) { w0 = P.b_q_norm_w[l31] * 0.125f; w1 = P.b_q_norm_w[32 + l31] * 0.125f; }
      if (kn) { w0 = P.b_k_norm_w[l31]; w1 = P.b_k_norm_w[32 + l31]; }
      const int rowbase = mt * 256 + wm * 128;
      char* p0; int rs, ts, c1;
      if (n0 == 4352) {
        const int ca = wn * 64 + l31;
        p0 = (char*)base + (size_t)(rowbase >> 5) * 8192 + hh * 64 + ((ca >> 4) * 512 + ((ca >> 3) & 1) * 256 + (ca & 7)) * 2;
        rs = 16; ts = 8192; c1 = 2048;
      } else {
        p0 = (char*)base + ((size_t)(rowbase + 4 * hh) * ld + c0 + wn * 64 + l31) * 2;
        rs = ld * 2; ts = 64 * ld; c1 = 64;
      }
#pragma unroll
      for (int i = 0; i < 4; ++i) {
        char* pr = p0 + (size_t)i * ts;
#pragma unroll
        for (int r = 0; r < 16; ++r) {
          float v0 = acc[i][0][r], v1 = acc[i][1][r];
          if (qn || kn) {
            float ss = v0 * v0 + v1 * v1;
            ss += dpp_xor1(ss); ss += dpp_xor2(ss); ss += __shfl_xor(ss, 4); ss += dpp_xor8(ss); ss += __shfl_xor(ss, 16);
            const float rsq = rsqrtf(ss * (1.f / 64.f) + EPS);
            v0 *= rsq * w0; v1 *= rsq * w1;
          }
          *(u16*)pr = f2bf(v0);
          *(u16*)(pr + c1) = f2bf(v1);
          pr += ((r & 3) == 3) ? 5 * rs : rs;
          asm volatile("" : "+v"(pr));
        }
      }
    } else {
      if (wn == 0 && l31 < 16) {
        float* sp = (float*)(ws + OFF_SMALL) + (size_t)(mt * 256 + wm * 128 + 4 * hh) * 16 + l31;
#pragma unroll
        for (int i = 0; i < 4; ++i)
#pragma unroll
          for (int r = 0; r < 16; ++r) {
            *sp = acc[i][0][r];
            sp += ((r & 3) == 3) ? 5 * 16 : 16;
            asm volatile("" : "+v"(sp));
          }
      }
    }
  }
}

DI void knorm_all(const Params& P) {
  const int lane = otid() & 63, wave = otid() >> 6;
  u32* BKV = (u32*)(P.ws + OFF_BKV);
  const int gw = blockIdx.x * 4 + wave, nw = gridDim.x * 4;
  const float w0 = P.b_k_norm_w[(2 * lane) & 63], w1 = P.b_k_norm_w[(2 * lane + 1) & 63];
  for (int tok = gw; tok < T_; tok += nw) {
    u32 v = BKV[(size_t)tok * 128 + lane];
    float a = bflo(v), b = bfhi(v);
    float ss = a * a + b * b;
#pragma unroll
    for (int d = 1; d < 32; d <<= 1) ss += __shfl_xor(ss, d);
    float r = rsqrtf(ss * (1.f / 64.f) + EPS);
    BKV[(size_t)tok * 128 + lane] = pack2(a * r * w0, b * r * w1);
  }
}

DI int perm16(int x) { return (x & 3) | ((x & 8) >> 1) | ((x & 4) << 1); }

DI void ka1_item(const Params& P, int ch, char* lds) {
  const int tid = otid(), lane = tid & 63, wave = tid >> 6, hh = lane >> 5, l31 = lane & 31;
  const int b = ch >> 8, h = (ch >> 6) & 3, n = ch & 63;
  const int tok0 = b * 4096 + n * 64;
  char* ws = P.ws;
  u16* QV = (u16*)lds;
  u16* Ks = (u16*)(lds + 18432);
  u16* KBT = (u16*)(lds + 18432 + 17408);
  float* Am = (float*)(lds + 18432 + 17408 + 18432);
  u16* Tm = Ks;
  float* sm = (float*)(lds + 18432 + 17408 + 18432 + 16384);
  const u16* QKV = (const u16*)(ws + OFF_QKV);
  const float* SMALL = (const float*)(ws + OFF_SMALL);
  u16* QD = (u16*)(ws + OFF_QD) + (size_t)ch * 8192;
  u16* ATT = (u16*)(ws + OFF_ATT) + (size_t)ch * 4096;
  u16* KDT = (u16*)(ws + OFF_KDT) + (size_t)ch * 8192;
  u16* WNEG = (u16*)(ws + OFF_WNEG) + (size_t)ch * 8192;
  u16* UT = (u16*)(ws + OFF_UT) + (size_t)ch * 8192;
  __syncthreads();
  if (wave == 0) {
    float ab = SMALL[(size_t)(tok0 + lane) * 16 + h];
    float aa = SMALL[(size_t)(tok0 + lane) * 16 + 4 + h];
    float beta = sigmoidf_(ab);
    float xs = aa + P.dt_bias[h];
    float sp = fmaxf(xs, 0.f) + log1pf(__expf(-fabsf(xs)));
    float g = -__expf(P.a_log[h]) * sp;
#pragma unroll
    for (int d = 1; d < 64; d <<= 1) { float t = __shfl_up(g, d); if (lane >= d) g += t; }
    float glast = __shfl(g, 63);
    sm[lane] = g; sm[64 + lane] = beta; sm[128 + lane] = __expf(g); sm[192 + lane] = __expf(glast - g);
  }
  __syncthreads();
  const float* cw = P.conv_w;
  {
    const int cq = h * 128 + 2 * lane, ck = 512 + cq;
    float wq[4][2], wk[4][2];
#pragma unroll
    for (int j = 0; j < 4; ++j) {
      wq[j][0] = cw[j * 1536 + cq]; wq[j][1] = cw[j * 1536 + cq + 1];
      wk[j][0] = cw[j * 1536 + ck]; wk[j][1] = cw[j * 1536 + ck + 1];
    }
    const int i0 = wave * 16;
    float xq[3][2], xk[3][2];
#pragma unroll
    for (int j = 0; j < 3; ++j) {
      int pos = n * 64 + i0 - 3 + j;
      u32 vq = 0, vk = 0;
      if (pos >= 0) {
        const u16* rp = QKV + (size_t)(tok0 + i0 - 3 + j) * 1536;
        vq = *(const u32*)(rp + cq); vk = *(const u32*)(rp + ck);
      }
      xq[j][0] = bflo(vq); xq[j][1] = bfhi(vq); xk[j][0] = bflo(vk); xk[j][1] = bfhi(vk);
    }
    u32 rq_[16], rk_[16];
#pragma unroll
    for (int ii = 0; ii < 16; ++ii) {
      const u16* rp = QKV + (size_t)(tok0 + i0 + ii) * 1536;
      rq_[ii] = *(const u32*)(rp + cq); rk_[ii] = *(const u32*)(rp + ck);
    }
#pragma unroll
    for (int ii = 0; ii < 16; ++ii) {
      const int i = i0 + ii;
      const u32 vq = rq_[ii], vk = rk_[ii];
      float cq0 = bflo(vq), cq1 = bfhi(vq), ck0 = bflo(vk), ck1 = bfhi(vk);
      float yq0 = wq[0][0] * xq[0][0] + wq[1][0] * xq[1][0] + wq[2][0] * xq[2][0] + wq[3][0] * cq0;
      float yq1 = wq[0][1] * xq[0][1] + wq[1][1] * xq[1][1] + wq[2][1] * xq[2][1] + wq[3][1] * cq1;
      float yk0 = wk[0][0] * xk[0][0] + wk[1][0] * xk[1][0] + wk[2][0] * xk[2][0] + wk[3][0] * ck0;
      float yk1 = wk[0][1] * xk[0][1] + wk[1][1] * xk[1][1] + wk[2][1] * xk[2][1] + wk[3][1] * ck1;
      xq[0][0] = xq[1][0]; xq[0][1] = xq[1][1]; xq[1][0] = xq[2][0]; xq[1][1] = xq[2][1]; xq[2][0] = cq0; xq[2][1] = cq1;
      xk[0][0] = xk[1][0]; xk[0][1] = xk[1][1]; xk[1][0] = xk[2][0]; xk[1][1] = xk[2][1]; xk[2][0] = ck0; xk[2][1] = ck1;
      yq0 = siluf_(yq0); yq1 = siluf_(yq1); yk0 = siluf_(yk0); yk1 = siluf_(yk1);
      float sq = yq0 * yq0 + yq1 * yq1, sk = yk0 * yk0 + yk1 * yk1;
#pragma unroll
      for (int d = 1; d < 64; d <<= 1) { sq += __shfl_xor(sq, d); sk += __shfl_xor(sk, d); }
      const float rq = rsqrtf(sq + EPS) * 0.08838834764831845f, rk = rsqrtf(sk + EPS);
      yq0 *= rq; yq1 *= rq; yk0 *= rk; yk1 *= rk;
      *(u32*)(QV + i * 136 + 2 * lane) = pack2(yq0, yq1);
      *(u32*)(Ks + i * 136 + 2 * lane) = pack2(yk0, yk1);
      KBT[(2 * lane) * 72 + i] = f2bf(yk0);
      KBT[(2 * lane + 1) * 72 + i] = f2bf(yk1);
      const float eg = sm[128 + i];
      *(u32*)(QD + i * 128 + 2 * lane) = pack2(yq0 * eg, yq1 * eg);
    }
  }
  __syncthreads();
  {
    const int mt = wave & 1, nt = wave >> 1;
    f32x16 akk = zero16(), aqk = zero16();
#pragma unroll
    for (int s = 0; s < 8; ++s) {
      const int kof = 16 * s + 8 * hh;
      bf16x8 aq = *(const bf16x8*)(QV + (32 * mt + l31) * 136 + kof);
      bf16x8 ak = *(const bf16x8*)(Ks + (32 * mt + l31) * 136 + kof);
      bf16x8 bk = *(const bf16x8*)(Ks + (32 * nt + l31) * 136 + kof);
      akk = MFMA32(ak, bk, akk);
      aqk = MFMA32(aq, bk, aqk);
    }
    const int j = 32 * nt + l31;
    const float gj = sm[j];
#pragma unroll
    for (int r = 0; r < 16; ++r) {
      const int i = 32 * mt + (r & 3) + 8 * (r >> 2) + 4 * hh;
      const float gi = sm[i], bi = sm[64 + i];
      const float dec = (j <= i) ? __expf(gi - gj) : 0.f;
      Am[i * 64 + j] = (j < i) ? bi * akk[r] * dec : 0.f;
      ATT[i * 64 + j] = f2bf(aqk[r] * dec);
    }
  }
  {
    const int dk = tid >> 1, th = tid & 1;
    u16* kr = KBT + dk * 72 + th * 32;
#pragma unroll
    for (int g2 = 0; g2 < 2; ++g2) {
      u16 ov[16];
#pragma unroll
      for (int x = 0; x < 16; ++x) {
        const int tok = th * 32 + g2 * 16 + x;
        const float kv = bf2f(kr[g2 * 16 + x]);
        ov[perm16(x)] = f2bf(kv * sm[192 + tok]);
        kr[g2 * 16 + x] = f2bf(kv * sm[64 + tok] * sm[128 + tok]);
      }
      uint4 o0, o1;
      o0.x = ov[0] | ((u32)ov[1] << 16); o0.y = ov[2] | ((u32)ov[3] << 16); o0.z = ov[4] | ((u32)ov[5] << 16); o0.w = ov[6] | ((u32)ov[7] << 16);
      o1.x = ov[8] | ((u32)ov[9] << 16); o1.y = ov[10] | ((u32)ov[11] << 16); o1.z = ov[12] | ((u32)ov[13] << 16); o1.w = ov[14] | ((u32)ov[15] << 16);
      *(uint4*)(KDT + dk * 64 + th * 32 + g2 * 16) = o0;
      *(uint4*)(KDT + dk * 64 + th * 32 + g2 * 16 + 8) = o1;
    }
  }
  __syncthreads();
  {
    u16* VBT = QV;
    const int cv = 1024 + h * 128 + 2 * lane;
    float wv[4][2];
#pragma unroll
    for (int j = 0; j < 4; ++j) { wv[j][0] = cw[j * 1536 + cv]; wv[j][1] = cw[j * 1536 + cv + 1]; }
    const int i0 = wave * 16;
    float xv[3][2];
#pragma unroll
    for (int j = 0; j < 3; ++j) {
      int pos = n * 64 + i0 - 3 + j;
      u32 vv = 0;
      if (pos >= 0) vv = *(const u32*)(QKV + (size_t)(tok0 + i0 - 3 + j) * 1536 + cv);
      xv[j][0] = bflo(vv); xv[j][1] = bfhi(vv);
    }
    u32 rv_[16];
#pragma unroll
    for (int ii = 0; ii < 16; ++ii) rv_[ii] = *(const u32*)(QKV + (size_t)(tok0 + i0 + ii) * 1536 + cv);
#pragma unroll
    for (int ii = 0; ii < 16; ++ii) {
      const int i = i0 + ii;
      const u32 vv = rv_[ii];
      float c0 = bflo(vv), c1 = bfhi(vv);
      float y0 = wv[0][0] * xv[0][0] + wv[1][0] * xv[1][0] + wv[2][0] * xv[2][0] + wv[3][0] * c0;
      float y1 = wv[0][1] * xv[0][1] + wv[1][1] * xv[1][1] + wv[2][1] * xv[2][1] + wv[3][1] * c1;
      xv[0][0] = xv[1][0]; xv[0][1] = xv[1][1]; xv[1][0] = xv[2][0]; xv[1][1] = xv[2][1]; xv[2][0] = c0; xv[2][1] = c1;
      const float bi = sm[64 + i];
      VBT[(2 * lane) * 72 + i] = f2bf(siluf_(y0) * bi);
      VBT[(2 * lane + 1) * 72 + i] = f2bf(siluf_(y1) * bi);
    }
  }
  if (wave == 0) {
    float Tc[63];
#pragma unroll
    for (int i = 0; i < 64; ++i) {
      float a = (i == lane) ? 1.f : 0.f;
#pragma unroll
      for (int j = 0; j < i; ++j) a -= Am[i * 64 + j] * Tc[j];
      if (i < 63) Tc[i] = a;
      Tm[i * 72 + lane] = f2bf(a);
      if ((i & 3) == 3) __builtin_amdgcn_sched_barrier(0);
    }
  }
  __syncthreads();
  {
    const u16* VBT = QV;
    f32x16 c0 = zero16(), c1 = zero16(), d0 = zero16(), d1 = zero16();
#pragma unroll
    for (int s = 0; s < 4; ++s) {
      const int kof = 16 * s + 8 * hh;
      bf16x8 t0 = *(const bf16x8*)(Tm + l31 * 72 + kof);
      bf16x8 t1 = *(const bf16x8*)(Tm + (32 + l31) * 72 + kof);
      bf16x8 a = *(const bf16x8*)(KBT + (32 * wave + l31) * 72 + kof);
      bf16x8 bv = *(const bf16x8*)(VBT + (32 * wave + l31) * 72 + kof);
      c0 = MFMA32(a, t0, c0);
      c1 = MFMA32(a, t1, c1);
      d0 = MFMA32(t0, bv, d0);
      d1 = MFMA32(t1, bv, d1);
    }
#pragma unroll
    for (int rg = 0; rg < 4; ++rg) {
      const int dkpos = 16 * (2 * wave + (rg >> 1)) + 8 * hh + 4 * (rg & 1);
      uint2 o;
      o.x = pack2(-c0[4 * rg], -c0[4 * rg + 1]); o.y = pack2(-c0[4 * rg + 2], -c0[4 * rg + 3]);
      *(uint2*)(WNEG + (l31) * 128 + dkpos) = o;
      o.x = pack2(-c1[4 * rg], -c1[4 * rg + 1]); o.y = pack2(-c1[4 * rg + 2], -c1[4 * rg + 3]);
      *(uint2*)(WNEG + (32 + l31) * 128 + dkpos) = o;
      const int dv = 32 * wave + l31;
      o.x = pack2(d0[4 * rg], d0[4 * rg + 1]); o.y = pack2(d0[4 * rg + 2], d0[4 * rg + 3]);
      *(uint2*)(UT + rg * 1024 + dv * 8 + 4 * hh) = o;
      o.x = pack2(d1[4 * rg], d1[4 * rg + 1]); o.y = pack2(d1[4 * rg + 2], d1[4 * rg + 3]);
      *(uint2*)(UT + (4 + rg) * 1024 + dv * 8 + 4 * hh) = o;
    }
    if (tid == 0) ((float*)(ws + OFF_GL))[ch] = sm[128 + 63];
  }
}

#define ATT_UNROLL 4
typedef __bf16 bf2_t __attribute__((ext_vector_type(2)));
DI float fdot2(u32 a, u32 b, float c) { return __builtin_amdgcn_fdot2_f32_bf16(__builtin_bit_cast(bf2_t, a), __builtin_bit_cast(bf2_t, b), c, false); }
DI float dot8(const uint4& k, const u32* q, float acc) {
  acc = fdot2(k.x, q[0], acc);
  acc = fdot2(k.y, q[1], acc);
  acc = fdot2(k.z, q[2], acc);
  acc = fdot2(k.w, q[3], acc);
  return acc;
}

DI void kb2_query(const Params& P, int t, float* Sw, const u16* idxp) {
  const int lane = otid() & 63;
  char* ws = P.ws;
  const int b = t >> 12, pos = t & 4095;
  const int nvalid = pos + 1 < 256 ? pos + 1 : 256;
  const bool uselist = pos >= 255;
  const u16* BKVb = (const u16*)(ws + OFF_BKV) + (size_t)b * 4096 * 256;
  float inv;
  {
    const int l15 = lane & 15, g4 = lane >> 4;
    bf16x8 qf[4];
    {
      const u16* qrow = (const u16*)(ws + OFF_BQ) + (size_t)t * 512;
#pragma unroll
      for (int s = 0; s < 4; ++s) {
        bf16x8 z = {0, 0, 0, 0, 0, 0, 0, 0};
        if (l15 < 8 && (l15 >> 2) == (s >> 1)) z = *(const bf16x8*)(qrow + l15 * 64 + 32 * (s & 1) + 8 * g4);
        qf[s] = z;
      }
    }
    float sum = 0.f;
#pragma unroll 4
    for (int tau = 0; tau < 16; ++tau) {
      const int slotA = 16 * tau + l15;
      int kidx = uselist ? (int)idxp[slotA] : slotA;
      if (slotA >= nvalid) kidx = 0;
      const u16* row = BKVb + (size_t)kidx * 256 + 8 * g4;
      bf16x8 ka[4];
#pragma unroll
      for (int s = 0; s < 4; ++s) ka[s] = *(const bf16x8*)(row + 32 * s);
      f32x4 c = zero4();
      __builtin_amdgcn_s_setprio(1);
#pragma unroll
      for (int s = 0; s < 4; ++s) c = MFMA16(ka[s], qf[s], c);
      __builtin_amdgcn_s_setprio(0);
#pragma unroll
      for (int r = 0; r < 4; ++r) {
        const int slot = 16 * tau + 4 * g4 + r;
        const float pe = (slot < nvalid) ? __expf(c[r]) : 0.f;
        sum += pe;
        if (l15 < 8) Sw[slot * 8 + l15] = pe;
      }
    }
    sum += __shfl_xor(sum, 16); sum += __shfl_xor(sum, 32);
    inv = 1.f / sum;
  }
  const int dc = (lane & 3) | (((lane >> 3) & 1) << 2);
  const int ks = ((lane >> 2) & 1) | ((lane >> 4) << 1);
  float o[8][8];
#pragma unroll
  for (int hd = 0; hd < 8; ++hd)
#pragma unroll
    for (int d = 0; d < 8; ++d) o[hd][d] = 0.f;
#pragma unroll ATT_UNROLL
  for (int it = 0; it < 32; ++it) {
    const int slot = it * 8 + ks;
    int kidx = uselist ? (int)idxp[slot] : slot;
    if (slot >= nvalid) kidx = 0;
    const u16* row = BKVb + (size_t)kidx * 256;
    const uint4 v0 = *(const uint4*)(row + 128 + dc * 8);
    const uint4 v1 = *(const uint4*)(row + 192 + dc * 8);
    const f32x4 pa = *(const f32x4*)(Sw + slot * 8);
    const f32x4 pb = *(const f32x4*)(Sw + slot * 8 + 4);
    float f0[8] = {bflo(v0.x), bfhi(v0.x), bflo(v0.y), bfhi(v0.y), bflo(v0.z), bfhi(v0.z), bflo(v0.w), bfhi(v0.w)};
    float f1[8] = {bflo(v1.x), bfhi(v1.x), bflo(v1.y), bfhi(v1.y), bflo(v1.z), bfhi(v1.z), bflo(v1.w), bfhi(v1.w)};
#pragma unroll
    for (int r = 0; r < 4; ++r) {
#pragma unroll
      for (int d = 0; d < 8; ++d) { o[r][d] += pa[r] * f0[d]; o[4 + r][d] += pb[r] * f1[d]; }
    }
  }
  float o4[4][8];
  {
    const bool up = ks & 4;
#pragma unroll
    for (int i = 0; i < 4; ++i)
#pragma unroll
      for (int d = 0; d < 8; ++d) { float keep = up ? o[4 + i][d] : o[i][d]; float send = up ? o[i][d] : o[4 + i][d]; o4[i][d] = keep + __shfl_xor(send, 32); }
  }
  float o2[2][8];
  {
    const bool up = ks & 2;
#pragma unroll
    for (int i = 0; i < 2; ++i)
#pragma unroll
      for (int d = 0; d < 8; ++d) { float keep = up ? o4[2 + i][d] : o4[i][d]; float send = up ? o4[i][d] : o4[2 + i][d]; o2[i][d] = keep + __shfl_xor(send, 16); }
  }
  float o1[8];
  {
    const bool up = ks & 1;
#pragma unroll
    for (int d = 0; d < 8; ++d) { float keep = up ? o2[1][d] : o2[0][d]; float send = up ? o2[0][d] : o2[1][d]; o1[d] = keep + __shfl_xor(send, 4); }
  }
  const float invh = __shfl(inv, ks);
  const u16* bz = (const u16*)(ws + OFF_BZ) + (size_t)t * 512 + ks * 64 + dc * 8;
  uint4 zz = *(const uint4*)bz;
  float zf[8] = {bflo(zz.x), bfhi(zz.x), bflo(zz.y), bfhi(zz.y), bflo(zz.z), bfhi(zz.z), bflo(zz.w), bfhi(zz.w)};
  uint4 ov;
  ov.x = pack2(o1[0] * invh * siluf_(zf[0]), o1[1] * invh * siluf_(zf[1]));
  ov.y = pack2(o1[2] * invh * siluf_(zf[2]), o1[3] * invh * siluf_(zf[3]));
  ov.z = pack2(o1[4] * invh * siluf_(zf[4]), o1[5] * invh * siluf_(zf[5]));
  ov.w = pack2(o1[6] * invh * siluf_(zf[6]), o1[7] * invh * siluf_(zf[7]));
  *(uint4*)((u16*)(ws + OFF_MIXB) + (size_t)t * 512 + ks * 64 + dc * 8) = ov;
}

DI void kb_item(const Params& P, int item, char* lds) {
  const int tid = otid();
  const int lane = tid & 63, wave = __builtin_amdgcn_readfirstlane(tid >> 6), hh = lane >> 5, l31 = lane & 31;
  const int b = item & 3, qt = 1023 - (item >> 2), t0 = qt * 4;
  char* ws = P.ws;
  float* Sl = (float*)lds;
  u16* myidx = (u16*)(lds + wave * 16384);
  float* mySw = (float*)(lds + wave * 16384 + 1024);
  if (t0 + 3 < 255) {
    __syncthreads();
    kb2_query(P, b * 4096 + t0 + wave, mySw, myidx);
    return;
  }
  const u16* IQ = (const u16*)(ws + OFF_IQ);
  const u16* IK = (const u16*)(ws + OFF_IK);
  const float* SMALL = (const float*)(ws + OFF_SMALL);
  const int T0 = b * 4096 + t0;
  __syncthreads();
  {
    bf16x8 af[8];
    const u16* src = IQ + (size_t)(T0 + ((l31 >> 2) & 1) + 2 * ((l31 >> 4) & 1)) * 1024 + ((l31 & 3) + 4 * ((l31 >> 3) & 1)) * 128 + 8 * hh;
#pragma unroll
    for (int s = 0; s < 8; ++s) af[s] = *(const bf16x8*)(src + 16 * s);
    float wv[16];
#pragma unroll
    for (int r = 0; r < 16; ++r) wv[r] = SMALL[(size_t)(T0 + hh + 2 * (r >> 3)) * 16 + 8 + (r & 3) + 4 * ((r >> 2) & 1)] * 0.03125f;
    const int ntile = (t0 + 4 + 31) >> 5;
    const u16* kbase = IK + (size_t)b * 128 * 4096 + lane * 8;
    const int nmine = ntile > wave ? (ntile - wave + 3) >> 2 : 0;
    bf16x8 c0[8], c1[8];
    {
      const int k0 = wave, k1 = nmine > 1 ? wave + 4 : wave;
      if (nmine > 0) {
#pragma unroll
        for (int s = 0; s < 8; ++s) { c0[s] = *(const bf16x8*)(kbase + (size_t)k0 * 4096 + 512 * s); c1[s] = *(const bf16x8*)(kbase + (size_t)k1 * 4096 + 512 * s); }
      }
    }
    for (int j = 0; j < nmine; j += 2) {
      const int kt0 = wave + 4 * j, kt1 = kt0 + 4;
      const bool has1 = j + 1 < nmine;
      bf16x8 n0[8], n1[8];
      {
        const int ka = j + 2 < nmine ? kt0 + 8 : kt0, kb2 = j + 3 < nmine ? kt0 + 12 : kt0;
#pragma unroll
        for (int s = 0; s < 8; ++s) { n0[s] = *(const bf16x8*)(kbase + (size_t)ka * 4096 + 512 * s); n1[s] = *(const bf16x8*)(kbase + (size_t)kb2 * 4096 + 512 * s); }
      }
      f32x16 acc0 = zero16(), acc1 = zero16();
      __builtin_amdgcn_s_setprio(1);
#pragma unroll
      for (int s = 0; s < 8; ++s) { acc0 = MFMA32(af[s], c0[s], acc0); acc1 = MFMA32(af[s], c1[s], acc1); }
      __builtin_amdgcn_s_setprio(0);
#pragma unroll
      for (int s = 0; s < 8; ++s) { c0[s] = n0[s]; c1[s] = n1[s]; }
      float sa0 = 0.f, sa1 = 0.f, sb0 = 0.f, sb1 = 0.f;
#pragma unroll
      for (int i = 0; i < 8; ++i) {
        sa0 += wv[i] * fmaxf(acc0[i], 0.f); sa1 += wv[8 + i] * fmaxf(acc0[8 + i], 0.f);
        sb0 += wv[i] * fmaxf(acc1[i], 0.f); sb1 += wv[8 + i] * fmaxf(acc1[8 + i], 0.f);
      }
      Sl[hh * 4096 + kt0 * 32 + l31] = sa0;
      Sl[(hh + 2) * 4096 + kt0 * 32 + l31] = sa1;
      if (has1) {
        Sl[hh * 4096 + kt1 * 32 + l31] = sb0;
        Sl[(hh + 2) * 4096 + kt1 * 32 + l31] = sb1;
      }
    }
  }
  __syncthreads();
  const int pos = t0 + wave;
  if (pos >= 255) {
    const int nchunk = (pos >> 10) + 1;
    u32 key[64];
#pragma unroll
    for (int c4 = 0; c4 < 4; ++c4) {
      if (c4 < nchunk) {
#pragma unroll
        for (int ii = 0; ii < 16; ++ii) {
          const int i = c4 * 16 + ii;
          const int idx = lane + 64 * i;
          float v = Sl[wave * 4096 + idx] + 0.0f;
          u32 u = __float_as_uint(v);
          u = (u & 0x80000000u) ? ~u : (u | 0x80000000u);
          key[i] = (idx <= pos) ? u : 0u;
        }
      } else {
#pragma unroll
        for (int ii = 0; ii < 16; ++ii) key[c4 * 16 + ii] = 0u;
      }
    }
    u32 g0 = key[0], g1 = key[1], g2 = key[2], g3 = key[3];
#pragma unroll
    for (int i = 4; i < 64; i += 4) { g0 = max(g0, key[i]); g1 = max(g1, key[i + 1]); g2 = max(g2, key[i + 2]); g3 = max(g3, key[i + 3]); }
    u32 lo = min(min(g0, g1), min(g2, g3)), hi = max(max(g0, g1), max(g2, g3));
#pragma unroll
    for (int d = 1; d < 64; d <<= 1) { lo = min(lo, (u32)__shfl_xor((int)lo, d)); hi = max(hi, (u32)__shfl_xor((int)hi, d)); }
    lo = __builtin_amdgcn_readfirstlane(lo); hi = __builtin_amdgcn_readfirstlane(hi);
    const u32 diff = lo ^ hi;
    const int topbit = diff ? 31 - __builtin_clz(diff) : -1;
    u32 Pv = topbit >= 31 ? 0u : (topbit < 0 ? lo : (lo & ~((2u << topbit) - 1u)));
    bool exact = false;
    for (int bit = topbit; bit >= 0; --bit) {
      const u32 cand = Pv | (1u << bit);
      int c = 0;
#pragma unroll
      for (int c4 = 0; c4 < 4; ++c4) {
        if (c4 < nchunk) {
#pragma unroll
          for (int ii = 0; ii < 16; ++ii) {
            c += __popcll(__ballot(key[c4 * 16 + ii] >= cand));
            if ((ii & 7) == 7) __builtin_amdgcn_sched_barrier(0);
          }
        }
      }
      if (c >= 256) {
        Pv = cand;
        if (c == 256) { exact = true; break; }
      }
    }
    int need = 1 << 30;
    if (!exact) {
      int cgt = 0;
#pragma unroll
      for (int c4 = 0; c4 < 4; ++c4) {
        if (c4 < nchunk) {
#pragma unroll
          for (int ii = 0; ii < 16; ++ii) {
            cgt += __popcll(__ballot(key[c4 * 16 + ii] > Pv));
            if ((ii & 7) == 7) __builtin_amdgcn_sched_barrier(0);
          }
        }
      }
      need = 256 - cgt;
    }
    u16* out = myidx;
    if (exact) {
      u32 mlo = 0u, mhi = 0u;
#pragma unroll
      for (int c4 = 0; c4 < 4; ++c4) {
        if (c4 < nchunk) {
#pragma unroll
          for (int ii = 0; ii < 16; ++ii) {
            const int i = c4 * 16 + ii;
            const u32 bit = (key[i] >= Pv) ? (1u << (i & 31)) : 0u;
            if (i < 32) mlo |= bit; else mhi |= bit;
          }
        }
      }
      const int cnt = __popc(mlo) + __popc(mhi);
      int incl = cnt;
#pragma unroll
      for (int d = 1; d < 64; d <<= 1) { const int tv = __shfl_up(incl, d); if (lane >= d) incl += tv; }
      int off = incl - cnt;
      while (mlo) { const int i = __ffs((int)mlo) - 1; out[off++] = (u16)(lane + 64 * i); mlo &= mlo - 1u; }
      while (mhi) { const int i = __ffs((int)mhi) - 1; out[off++] = (u16)(lane + 64 * (32 + i)); mhi &= mhi - 1u; }
    } else {
    int off = 0, eqseen = 0;
    const u64 ltmask = (1ull << lane) - 1ull;
#pragma unroll
    for (int c4 = 0; c4 < 4; ++c4) {
      if (c4 < nchunk) {
#pragma unroll
        for (int ii = 0; ii < 16; ++ii) {
          const int i = c4 * 16 + ii;
          const bool gt = key[i] > Pv, eq = key[i] == Pv;
          const u64 meq = __ballot(eq);
          const int rank = eqseen + __popcll(meq & ltmask);
          const bool sel = gt || (eq && rank < need);
          const u64 ms = __ballot(sel);
          if (sel) out[off + __popcll(ms & ltmask)] = (u16)(lane + 64 * i);
          off += __popcll(ms);
          eqseen += __popcll(meq);
          if ((ii & 3) == 3) __builtin_amdgcn_sched_barrier(0);
        }
      }
    }
    }
  }
  kb2_query(P, T0 + wave, mySw, myidx);
}

constexpr int KB_SPLIT = 1792;
DI int pull_item(unsigned* ctr, char* lds) {
  volatile LAS unsigned* slot = (volatile LAS unsigned*)(lds + LDS_BYTES - 8);
  __syncthreads();
  if (threadIdx.x == 0) *slot = __hip_atomic_fetch_add(ctr, 1u, __ATOMIC_RELAXED, __HIP_MEMORY_SCOPE_AGENT);
  __syncthreads();
  return (int)*slot;
}
DI void phase2(const Params& P, char* lds) {
  for (int it = blockIdx.x; it < 1024; it += gridDim.x) ka1_item(P, it, lds);
  if ((gridDim.x & 3) == 0) {
    const int bb = blockIdx.x & 3;
    unsigned* ctr = (unsigned*)(P.ws + OFF_BAR) + 16 * bb;
    for (;;) {
      const int k = pull_item(ctr, lds);
      if (k >= KB_SPLIT / 4) break;
      kb_item(P, 4 * k + bb, lds);
    }
  } else {
    for (int it = blockIdx.x; it < KB_SPLIT; it += gridDim.x) kb_item(P, it, lds);
  }
}

DI void ka2_scan(const Params& P, int bh, char* lds) {
  const int tid = otid(), lane = tid & 63, wave = tid >> 6, hh = lane >> 5, l31 = lane & 31;
  char* ws = P.ws;
  const int dv = 32 * wave + l31;
  const u16* WNEG = (const u16*)(ws + OFF_WNEG) + (size_t)bh * 64 * 8192;
  const u16* KDT = (const u16*)(ws + OFF_KDT) + (size_t)bh * 64 * 8192;
  const u16* UT = (const u16*)(ws + OFF_UT) + (size_t)bh * 64 * 8192 + dv * 8 + 4 * hh;
  const float* GL = (const float*)(ws + OFF_GL) + bh * 64;
  u16* HST = (u16*)((char*)P.out + OOFF_HST) + (size_t)bh * 64 * 16384 + dv * 8 + 4 * hh;
  u16* VNT = (u16*)((char*)P.out + OOFF_VNT) + (size_t)bh * 64 * 8192 + dv * 8 + 4 * hh;
  const int wbase = (tid >> 4) * 272 + ((tid & 15) << 4);
  const int kbase = 17408 + (tid >> 3) * 144 + ((tid & 7) << 4);
  u32x4 sw[4], sk[4];
  uint2 un[8];
  float gln;
  __syncthreads();
#pragma unroll
  for (int i = 0; i < 4; ++i) {
    sw[i] = *(const u32x4*)(WNEG + (size_t)(tid + 256 * i) * 8);
    sk[i] = *(const u32x4*)(KDT + (size_t)(tid + 256 * i) * 8);
  }
#pragma unroll
  for (int i = 0; i < 8; ++i) un[i] = *(const uint2*)(UT + i * 1024);
  gln = GL[0];
#pragma unroll
  for (int i = 0; i < 4; ++i) { *(u32x4*)(lds + wbase + i * 4352) = sw[i]; *(u32x4*)(lds + kbase + i * 4608) = sk[i]; }
  __syncthreads();
  f32x16 S[4];
#pragma unroll
  for (int m = 0; m < 4; ++m) S[m] = zero16();
  for (int n = 0; n < 64; ++n) {
    const char* buf = lds + (n & 1) * 35840;
    char* nbuf = lds + ((n + 1) & 1) * 35840;
    f32x16 vn[2];
#pragma unroll
    for (int tt = 0; tt < 2; ++tt) {
#pragma unroll
      for (int rg = 0; rg < 4; ++rg) {
        const uint2 u = un[4 * tt + rg];
        vn[tt][4 * rg] = bflo(u.x); vn[tt][4 * rg + 1] = bfhi(u.x); vn[tt][4 * rg + 2] = bflo(u.y); vn[tt][4 * rg + 3] = bfhi(u.y);
      }
    }
    const float gl = gln;
    if (n + 1 < 64) {
      const size_t o = (size_t)(n + 1) * 8192;
#pragma unroll
      for (int i = 0; i < 4; ++i) {
        sw[i] = *(const u32x4*)(WNEG + o + (size_t)(tid + 256 * i) * 8);
        sk[i] = *(const u32x4*)(KDT + o + (size_t)(tid + 256 * i) * 8);
      }
#pragma unroll
      for (int i = 0; i < 8; ++i) un[i] = *(const uint2*)(UT + o + i * 1024);
      gln = GL[n + 1];
    }
    u16* hst = HST + (size_t)n * 16384;
    u16* vnt = VNT + (size_t)n * 8192;
#pragma unroll
    for (int m = 0; m < 4; ++m) {
      u32 pk[8];
#pragma unroll
      for (int r = 0; r < 8; ++r) pk[r] = pack2(S[m][2 * r], S[m][2 * r + 1]);
#pragma unroll
      for (int rg = 0; rg < 4; ++rg) *(uint2*)(hst + (4 * m + rg) * 1024) = make_uint2(pk[2 * rg], pk[2 * rg + 1]);
      u32x4 f0 = {pk[0], pk[1], pk[2], pk[3]}, f1 = {pk[4], pk[5], pk[6], pk[7]};
      const bf16x8 sf0 = __builtin_bit_cast(bf16x8, f0), sf1 = __builtin_bit_cast(bf16x8, f1);
#pragma unroll
      for (int tt = 0; tt < 2; ++tt) {
        bf16x8 a0 = *(const bf16x8*)(buf + (l31 * 272 + 16 * hh) + (tt * 8704 + 32 * (2 * m)));
        bf16x8 a1 = *(const bf16x8*)(buf + (l31 * 272 + 16 * hh) + (tt * 8704 + 32 * (2 * m + 1)));
        vn[tt] = MFMA32(a0, sf0, vn[tt]);
        vn[tt] = MFMA32(a1, sf1, vn[tt]);
      }
      __builtin_amdgcn_sched_barrier(0);
    }
    bf16x8 vf[4];
#pragma unroll
    for (int tt = 0; tt < 2; ++tt) {
      u32 pk[8];
#pragma unroll
      for (int r = 0; r < 8; ++r) pk[r] = pack2(vn[tt][2 * r], vn[tt][2 * r + 1]);
#pragma unroll
      for (int rg = 0; rg < 4; ++rg) *(uint2*)(vnt + (4 * tt + rg) * 1024) = make_uint2(pk[2 * rg], pk[2 * rg + 1]);
      u32x4 f0 = {pk[0], pk[1], pk[2], pk[3]}, f1 = {pk[4], pk[5], pk[6], pk[7]};
      vf[2 * tt] = __builtin_bit_cast(bf16x8, f0);
      vf[2 * tt + 1] = __builtin_bit_cast(bf16x8, f1);
    }
#pragma unroll
    for (int m = 0; m < 4; ++m) {
#pragma unroll
      for (int r = 0; r < 16; ++r) S[m][r] *= gl;
    }
#pragma unroll
    for (int ks = 0; ks < 4; ++ks) {
#pragma unroll
      for (int m = 0; m < 4; ++m) {
        bf16x8 a = *(const bf16x8*)(buf + 17408 + (l31 * 144 + 16 * hh) + (m * 4608 + 32 * ks));
        S[m] = MFMA32(a, vf[ks], S[m]);
      }
      __builtin_amdgcn_sched_barrier(0);
    }
    if (n + 1 < 64) {
#pragma unroll
      for (int i = 0; i < 4; ++i) { *(u32x4*)(nbuf + wbase + i * 4352) = sw[i]; *(u32x4*)(nbuf + kbase + i * 4608) = sk[i]; }
    }
    __syncthreads();
  }
}

DI void phase3(const Params& P, char* lds) {
  const int G = gridDim.x;
  const int nscan = G > 32 ? 16 : 0;
  int first = KB_SPLIT + (int)blockIdx.x - nscan, stride = G - nscan;
  if ((int)blockIdx.x < 16 || nscan == 0) {
    for (int bh = blockIdx.x; bh < 16; bh += G) ka2_scan(P, bh, lds);
    if (nscan) first = 4096;
  }
  if (nscan && (G & 3) == 0) {
    if ((int)blockIdx.x >= 16) {
      const int bb = blockIdx.x & 3;
      unsigned* ctr = (unsigned*)(P.ws + OFF_BAR) + 64 + 16 * bb;
      for (;;) {
        const int k = KB_SPLIT / 4 + pull_item(ctr, lds);
        if (k >= 1024) break;
        kb_item(P, 4 * k + bb, lds);
      }
    }
  } else {
    for (int it = first; it < 4096; it += stride) kb_item(P, it, lds);
  }
}

DI void phase4(const Params& P, char* lds) {
  const int tid4 = otid(), lane = tid4 & 63, wave = tid4 >> 6, l15 = lane & 15, g4 = lane >> 4;
  char* ws = P.ws;
  float nw[8];
#pragma unroll
  for (int nt = 0; nt < 8; ++nt) nw[nt] = P.a_out_norm_w[16 * nt + l15];
  for (int ch = blockIdx.x; ch < 1024; ch += gridDim.x) {
    const int b = ch >> 8, h = (ch >> 6) & 3, n = ch & 63;
    const int tok0 = b * 4096 + n * 64;
    const u16* QD = (const u16*)(ws + OFF_QD) + (size_t)ch * 8192;
    const u16* ATT = (const u16*)(ws + OFF_ATT) + (size_t)ch * 4096;
    const u16* HST = (const u16*)((const char*)P.out + OOFF_HST) + (size_t)ch * 16384;
    const u16* VNT = (const u16*)((const char*)P.out + OOFF_VNT) + (size_t)ch * 8192;
    __syncthreads();
    {
      u32x4 st[12];
#pragma unroll
      for (int i = 0; i < 8; ++i) st[i] = *(const u32x4*)(HST + (size_t)(tid4 + 256 * i) * 8);
#pragma unroll
      for (int i = 0; i < 4; ++i) st[8 + i] = *(const u32x4*)(VNT + (size_t)(tid4 + 256 * i) * 8);
#pragma unroll
      for (int i = 0; i < 8; ++i) *(u32x4*)(lds + (tid4 + 256 * i) * 16) = st[i];
#pragma unroll
      for (int i = 0; i < 4; ++i) *(u32x4*)(lds + 32768 + (tid4 + 256 * i) * 16) = st[8 + i];
    }
    __syncthreads();
    const u16* HSl = (const u16*)lds;
    const u16* VNl = (const u16*)(lds + 32768);
    f32x4 acc[8];
#pragma unroll
    for (int nt = 0; nt < 8; ++nt) acc[nt] = zero4();
#pragma unroll
    for (int ks = 0; ks < 4; ++ks) {
      bf16x8 a = *(const bf16x8*)(QD + (16 * wave + l15) * 128 + 32 * ks + 8 * g4);
#pragma unroll
      for (int nt = 0; nt < 8; ++nt) {
        bf16x8 bb = *(const bf16x8*)(HSl + (4 * ks + g4) * 1024 + (16 * nt + l15) * 8);
        acc[nt] = MFMA16(a, bb, acc[nt]);
      }
    }
#pragma unroll
    for (int ks = 0; ks < 2; ++ks) {
      bf16x8 a = *(const bf16x8*)(ATT + (16 * wave + l15) * 64 + 32 * ks + 8 * g4);
#pragma unroll
      for (int nt = 0; nt < 8; ++nt) {
        bf16x8 bb = *(const bf16x8*)(VNl + (4 * ks + g4) * 1024 + (16 * nt + l15) * 8);
        acc[nt] = MFMA16(a, bb, acc[nt]);
      }
    }
    float zg[4][8];
#pragma unroll
    for (int r = 0; r < 4; ++r) {
      const u16* az = (const u16*)(ws + OFF_AZ) + (size_t)(tok0 + 16 * wave + 4 * g4 + r) * 512 + h * 128;
#pragma unroll
      for (int nt = 0; nt < 8; ++nt) zg[r][nt] = bf2f(az[16 * nt + l15]);
    }
#pragma unroll
    for (int r = 0; r < 4; ++r) {
      float ss = 0.f;
#pragma unroll
      for (int nt = 0; nt < 8; ++nt) ss += acc[nt][r] * acc[nt][r];
      ss += __shfl_xor(ss, 1); ss += __shfl_xor(ss, 2); ss += __shfl_xor(ss, 4); ss += __shfl_xor(ss, 8);
      const float rs = rsqrtf(ss * (1.f / 128.f) + EPS);
      const int t = tok0 + 16 * wave + 4 * g4 + r;
      u16* mix = (u16*)(ws + OFF_MIXA) + (size_t)t * 512 + h * 128;
#pragma unroll
      for (int nt = 0; nt < 8; ++nt) {
        const int dv = 16 * nt + l15;
        mix[dv] = f2bf(acc[nt][r] * rs * nw[nt] * siluf_(zg[r][nt]));
      }
    }
  }
}

DI void phase5(const Params& P, char* lds) {
  char* ws = P.ws;
  const u16* MIXA = (const u16*)(ws + OFF_MIXA);
  const u16* MIXB = (const u16*)(ws + OFF_MIXB);
  const u16* WT = (const u16*)(ws + OFF_WT_OUT);
  float* X1 = (float*)(ws + OFF_X1);
  u16* X1B = (u16*)(ws + OFF_X1B);
  float* SS = (float*)(ws + OFF_SUMSQ);
  const int lane = otid() & 63, wave = otid() >> 6;
  const int wm = wave & 1, wn = wave >> 1, l31 = lane & 31, hh = lane >> 5;
  const bool xswz = (gridDim.x & 7) == 0;
  const int xq = blockIdx.x >> 3, xn = gridDim.x >> 3, xx = blockIdx.x & 7;
  for (int tile = xswz ? xq : (int)blockIdx.x; tile < (xswz ? 64 : 512); tile += (xswz ? xn : (int)gridDim.x)) {
    const int mt = xswz ? 8 * xx + (tile & 7) : (tile >> 3), nt = xswz ? (tile >> 3) : (tile & 7);
    f32x16 acc[4][2];
#pragma unroll
    for (int i = 0; i < 4; ++i)
#pragma unroll
      for (int j = 0; j < 2; ++j) acc[i][j] = zero16();
    gemm_mainloop<4>(MIXA, 512, WT, 1024, 512, mt * 256, nt * 128, lds, acc);
    gemm_mainloop<4>(MIXB, 512, WT + 512, 1024, 512, mt * 256, nt * 128, lds, acc);
    {
      const size_t e0 = (size_t)(mt * 256 + wm * 128 + 4 * hh) * 1024 + nt * 128 + wn * 64 + l31;
      float* ssp0 = SS + (mt * 256 + wm * 128 + 4 * hh);
#pragma unroll
      for (int i = 0; i < 4; ++i) {
        float xa[16], xb[16];
        {
          const float* xp = P.x + e0 + (size_t)i * 32 * 1024;
#pragma unroll
          for (int r = 0; r < 16; ++r) {
            xa[r] = xp[0]; xb[r] = xp[32];
            xp += (((r & 3) == 3) ? 5 : 1) * 1024;
            asm volatile("" : "+v"(xp));
          }
        }
        float* x1p = X1 + e0 + (size_t)i * 32 * 1024;
        u16* x1bp = X1B + e0 + (size_t)i * 32 * 1024;
        float* ssp = ssp0 + i * 32;
#pragma unroll
        for (int r = 0; r < 16; ++r) {
          const float va = xa[r] + acc[i][0][r], vb = xb[r] + acc[i][1][r];
          x1p[0] = va; x1p[32] = vb;
          x1bp[0] = f2bf(va); x1bp[32] = f2bf(vb);
          float ss = va * va + vb * vb;
          ss += dpp_xor1(ss); ss += dpp_xor2(ss); ss += __shfl_xor(ss, 4); ss += dpp_xor8(ss); ss += __shfl_xor(ss, 16);
          if (l31 == 0) atomicAdd(ssp, ss);
          const int step = ((r & 3) == 3) ? 5 : 1;
          x1p += step * 1024; x1bp += step * 1024; ssp += step;
          asm volatile("" : "+v"(x1p), "+v"(x1bp), "+v"(ssp));
        }
      }
    }
  }
}

DI void phase6(const Params& P, char* lds) {
  char* ws = P.ws;
  const u16* X1B = (const u16*)(ws + OFF_X1B);
  const float* X1 = (const float*)(ws + OFF_X1);
  const u16* WG = (const u16*)(ws + OFF_WT_GATE);
  const u16* WP = (const u16*)(ws + OFF_WT_PLE);
  const u16* PB = (const u16*)(ws + OFF_PB);
  const float* SS = (const float*)(ws + OFF_SUMSQ);
  const int lane = otid() & 63, wave = otid() >> 6;
  const int wm = wave & 1, wn = wave >> 1, l31 = lane & 31, hh = lane >> 5;
  const bool xswz = (gridDim.x & 7) == 0;
  const int xq = blockIdx.x >> 3, xn = gridDim.x >> 3, xx = blockIdx.x & 7;
  for (int tile = xswz ? xq : (int)blockIdx.x; tile < (xswz ? 128 : 1024); tile += (xswz ? xn : (int)gridDim.x)) {
    const int mt = xswz ? 16 * xx + (tile & 15) : (tile >> 3), nt = xswz ? (tile >> 4) : (tile & 7);
    f32x16 ag[2][2], ap[2][2];
#pragma unroll
    for (int i = 0; i < 2; ++i)
#pragma unroll
      for (int j = 0; j < 2; ++j) { ag[i][j] = zero16(); ap[i][j] = zero16(); }
    gemm_mainloop<2>(X1B, 1024, WG, 1024, 1024, mt * 128, nt * 128, lds, ag);
    gemm_mainloop<2>(PB, 256, WP, 256, 256, mt * 128, nt * 128, lds, ap);
    const size_t e0 = (size_t)(mt * 128 + wm * 64 + 4 * hh) * 1024 + nt * 128 + wn * 64 + l31;
    const float b0 = P.b_ple_gate[nt * 128 + wn * 64 + l31], b1 = P.b_ple_gate[nt * 128 + wn * 64 + 32 + l31];
    const float* ssp0 = SS + (mt * 128 + wm * 64 + 4 * hh);
#pragma unroll
    for (int i = 0; i < 2; ++i) {
      float rsv[16], xa[16], xb[16];
#pragma unroll
      for (int r = 0; r < 16; ++r) rsv[r] = ssp0[i * 32 + (r & 3) + 8 * (r >> 2)];
      {
        const float* x1p = X1 + e0 + (size_t)i * 32 * 1024;
#pragma unroll
        for (int r = 0; r < 16; ++r) {
          xa[r] = x1p[0]; xb[r] = x1p[32];
          x1p += (((r & 3) == 3) ? 5 : 1) * 1024;
          asm volatile("" : "+v"(x1p));
        }
      }
      float* op = P.out + e0 + (size_t)i * 32 * 1024;
#pragma unroll
      for (int r = 0; r < 16; ++r) {
        const float rs = rsqrtf(rsv[r] * (1.f / 1024.f) + EPS);
        op[0] = xa[r] + ap[i][0][r] * sigmoidf_(rs * ag[i][0][r] + b0);
        op[32] = xb[r] + ap[i][1][r] * sigmoidf_(rs * ag[i][1][r] + b1);
        op += (((r & 3) == 3) ? 5 : 1) * 1024;
        asm volatile("" : "+v"(op));
      }
    }
  }
}

template <int PH>
DI void run_phase(const Params& P, char* lds) {
  if (PH == 0) phase0(P);
  else if (PH == 1) phase1(P, lds);
  else if (PH == 2) phase2(P, lds);
  else if (PH == 3) phase3(P, lds);
  else if (PH == 4) phase4(P, lds);
  else if (PH == 5) phase5(P, lds);
  else phase6(P, lds);
}

template <int PH>
__global__ void __launch_bounds__(256, 2) phase_kernel(Params P) {
  __shared__ __attribute__((aligned(16))) char lds[LDS_BYTES];
  run_phase<PH>(P, lds);
}

__global__ void __launch_bounds__(256, 2) mega(Params P) {
  __shared__ __attribute__((aligned(16))) char lds[LDS_BYTES];
  volatile LAS unsigned* st = (volatile LAS unsigned*)(lds + LDS_BYTES - 16);
  if (threadIdx.x == 0) { st[0] = 0u; st[1] = 0u; }
  __syncthreads();
  if (P.ws == nullptr) cg::this_grid().sync();
  XcdBarrier xb = xcd_barrier_post((unsigned*)(P.ws + OFF_BAR), st);
  run_phase<0>(P, lds); xcd_barrier(xb);
  run_phase<1>(P, lds); xcd_barrier(xb);
  run_phase<2>(P, lds); xcd_barrier(xb);
  run_phase<3>(P, lds); xcd_barrier(xb);
  run_phase<4>(P, lds); xcd_barrier(xb);
  run_phase<5>(P, lds); xcd_barrier(xb);
  run_phase<6>(P, lds);
}

extern "C" void kernel_launch(void* const* d_in, const int* in_sizes, int n_in, void* d_out, int out_size, void* d_ws,
                              size_t ws_size, hipStream_t stream) {
  Params P{};
  P.x = (const float*)d_in[0]; P.p = (const float*)d_in[1]; P.attn_norm_w = (const float*)d_in[2];
  P.w_in = (const float*)d_in[3]; P.conv_w = (const float*)d_in[4]; P.a_log = (const float*)d_in[5];
  P.dt_bias = (const float*)d_in[6]; P.a_out_norm_w = (const float*)d_in[7]; P.b_q_norm_w = (const float*)d_in[8];
  P.b_k_norm_w = (const float*)d_in[9]; P.w_out = (const float*)d_in[10]; P.w_ple = (const float*)d_in[11];
  P.ple_gate_norm_w = (const float*)d_in[12]; P.w_ple_gate = (const float*)d_in[13]; P.b_ple_gate = (const float*)d_in[14];
  P.out = (float*)d_out; P.ws = (char*)d_ws;
  static int grid_blocks = 0;
  if (!grid_blocks) {
    int dev = 0, cus = 0, per_cu = 0;
    (void)hipGetDevice(&dev);
    (void)hipDeviceGetAttribute(&cus, hipDeviceAttributeMultiprocessorCount, dev);
    (void)hipOccupancyMaxActiveBlocksPerMultiprocessor(&per_cu, mega, 256, 0);
    if (per_cu > 2) per_cu = 2;
    if (per_cu < 1) per_cu = 1;
    grid_blocks = cus * per_cu;
  }
#ifdef MULTI_LAUNCH
  hipLaunchKernelGGL(phase_kernel<0>, dim3(grid_blocks), dim3(256), 0, stream, P);
  hipLaunchKernelGGL(phase_kernel<1>, dim3(grid_blocks), dim3(256), 0, stream, P);
  hipLaunchKernelGGL(phase_kernel<2>, dim3(grid_blocks), dim3(256), 0, stream, P);
  hipLaunchKernelGGL(phase_kernel<3>, dim3(grid_blocks), dim3(256), 0, stream, P);
  hipLaunchKernelGGL(phase_kernel<4>, dim3(grid_blocks), dim3(256), 0, stream, P);
  hipLaunchKernelGGL(phase_kernel<5>, dim3(grid_blocks), dim3(256), 0, stream, P);
  hipLaunchKernelGGL(phase_kernel<6>, dim3(grid_blocks), dim3(256), 0, stream, P);
#else
  (void)hipMemsetAsync((char*)d_ws + OFF_BAR, 0, XCD_BAR_WORDS * 4, stream);
  void* args[] = {&P};
  hipError_t e = hipLaunchCooperativeKernel((void*)mega, dim3(grid_blocks), dim3(256), args, 0, stream);
  if (e != hipSuccess) fprintf(stderr, "cooperative launch failed: %s (grid %d)\n", hipGetErrorString(e), grid_blocks);
#endif
}
```

```cpp
#include <hip/hip_runtime.h>
#include <hip/hip_cooperative_groups.h>
#include <cstdio>
namespace cg = cooperative_groups;

typedef unsigned short u16;
typedef unsigned int u32;
typedef unsigned long long u64;
using bf16x8 = __attribute__((ext_vector_type(8))) short;
using f32x16 = __attribute__((ext_vector_type(16))) float;
using f32x4 = __attribute__((ext_vector_type(4))) float;
using u32x4 = __attribute__((ext_vector_type(4))) unsigned;
#define DI __device__ __forceinline__
#define MFMA32(a, b, c) __builtin_amdgcn_mfma_f32_32x32x16_bf16((a), (b), (c), 0, 0, 0)
#define MFMA16(a, b, c) __builtin_amdgcn_mfma_f32_16x16x32_bf16((a), (b), (c), 0, 0, 0)

constexpr int T_ = 16384;
constexpr float EPS = 1e-6f;

constexpr size_t OFF_WT_IN = 0;
constexpr size_t OFF_WT_OUT = OFF_WT_IN + (size_t)4608 * 1024 * 2;
constexpr size_t OFF_WT_GATE = OFF_WT_OUT + (size_t)1024 * 1024 * 2;
constexpr size_t OFF_WT_PLE = OFF_WT_GATE + (size_t)1024 * 1024 * 2;
constexpr size_t OFF_PB = OFF_WT_PLE + (size_t)1024 * 256 * 2;
constexpr size_t OFF_SUMSQ = OFF_PB + (size_t)T_ * 256 * 2;
constexpr size_t OFF_QKV = OFF_SUMSQ + (size_t)T_ * 4;
constexpr size_t OFF_MIXA = OFF_QKV;
constexpr size_t OFF_AZ = OFF_QKV + (size_t)T_ * 1536 * 2;
constexpr size_t OFF_BQ = OFF_AZ + (size_t)T_ * 512 * 2;
constexpr size_t OFF_BKV = OFF_BQ + (size_t)T_ * 512 * 2;
constexpr size_t OFF_BZ = OFF_BKV + (size_t)T_ * 256 * 2;
constexpr size_t OFF_IQ = OFF_BZ + (size_t)T_ * 512 * 2;
constexpr size_t OFF_IK = OFF_IQ + (size_t)T_ * 1024 * 2;
constexpr size_t OFF_SMALL = OFF_IK + (size_t)T_ * 128 * 2;
constexpr size_t OFF_H = OFF_SMALL + (size_t)T_ * 16 * 4;
constexpr size_t OFF_WNEG = OFF_H;
constexpr size_t OFF_KDT = OFF_WNEG + (size_t)1024 * 8192 * 2;
constexpr size_t OFF_UT = OFF_H + (size_t)T_ * 1024 * 2;
constexpr size_t OFF_QD = OFF_UT + (size_t)1024 * 8192 * 2;
constexpr size_t OFF_ATT = OFF_QD + (size_t)1024 * 8192 * 2;
constexpr size_t OFF_GL = OFF_ATT + (size_t)1024 * 4096 * 2;
constexpr size_t OFF_BAR = OFF_GL + 4096;
constexpr size_t OFF_MIXB = OFF_BAR + 16384;
constexpr size_t WS_END = OFF_MIXB + (size_t)T_ * 512 * 2;
constexpr size_t OFF_X1 = OFF_AZ;
constexpr size_t OFF_X1B = OFF_X1 + (size_t)T_ * 1024 * 4;
static_assert(OFF_X1B + (size_t)T_ * 1024 * 2 <= OFF_UT, "x1 alias overlaps live data");
static_assert(WS_END <= (size_t)256 * 1024 * 1024, "ws too small");
constexpr size_t OOFF_HST = 0;
constexpr size_t OOFF_VNT = OOFF_HST + (size_t)1024 * 16384 * 2;
constexpr size_t OOFF_IDX = OOFF_VNT + (size_t)1024 * 8192 * 2;
static_assert(OOFF_IDX + (size_t)T_ * 256 * 2 <= (size_t)T_ * 1024 * 4, "d_out scratch");

constexpr int LDS_BYTES = 72 * 1024;

struct Params {
  const float *x, *p, *attn_norm_w, *w_in, *conv_w, *a_log, *dt_bias, *a_out_norm_w, *b_q_norm_w, *b_k_norm_w,
      *w_out, *w_ple, *ple_gate_norm_w, *w_ple_gate, *b_ple_gate;
  float* out;
  char* ws;
};

DI int otid() { int t = threadIdx.x; asm volatile("" : "+v"(t)); return t; }
DI float dpp_xor1(float v) { return __int_as_float(__builtin_amdgcn_update_dpp(0, __float_as_int(v), 0xB1, 0xF, 0xF, true)); }
DI float dpp_xor2(float v) { return __int_as_float(__builtin_amdgcn_update_dpp(0, __float_as_int(v), 0x4E, 0xF, 0xF, true)); }
DI float dpp_xor8(float v) { return __int_as_float(__builtin_amdgcn_update_dpp(0, __float_as_int(v), 0x128, 0xF, 0xF, true)); }
DI u16 f2bf(float x) { u32 u = __float_as_uint(x); u += 0x7fffu + ((u >> 16) & 1u); return (u16)(u >> 16); }
DI float bf2f(u16 v) { return __uint_as_float(((u32)v) << 16); }
DI u32 pack2(float a, float b) { return (u32)f2bf(a) | ((u32)f2bf(b) << 16); }
DI float bflo(u32 v) { return __uint_as_float(v << 16); }
DI float bfhi(u32 v) { return __uint_as_float(v & 0xffff0000u); }
DI float sigmoidf_(float x) { return 1.f / (1.f + __expf(-x)); }
DI float siluf_(float x) { return x / (1.f + __expf(-x)); }
DI f32x16 zero16() { f32x16 z; for (int i = 0; i < 16; ++i) z[i] = 0.f; return z; }
DI f32x4 zero4() { f32x4 z; for (int i = 0; i < 4; ++i) z[i] = 0.f; return z; }


#define XB_TMO      128
#define XB_XCNT(j)  (256  + 64 * (j))
#define XB_XSUB(j)  (1280 + 64 * (j))
#define XB_XGEN(j)  (2304 + 64 * (j))
#define XB_TOP      3328
#define XB_TOPGEN   3392
#define XCD_BAR_WORDS 3456
#define XB_SPIN_CAP (1u << 22)
#define LAS __attribute__((address_space(3)))
DI unsigned xb_ld(unsigned* p) { return __hip_atomic_load(p, __ATOMIC_RELAXED, __HIP_MEMORY_SCOPE_AGENT); }
DI unsigned xb_add(unsigned* p, unsigned v) { return __hip_atomic_fetch_add(p, v, __ATOMIC_RELAXED, __HIP_MEMORY_SCOPE_AGENT); }
DI unsigned xb_xcc_id() { return (unsigned)__builtin_amdgcn_s_getreg((3 << 11) | 20) & 0xFu; }
#define XB_SPIN(cond, bar) do { unsigned _sp = 0; while (cond) { __builtin_amdgcn_s_sleep(1); \
    if ((++_sp & 255u) == 0u) { if (xb_ld(&(bar)[XB_TMO])) break; if (_sp > XB_SPIN_CAP) { atomicAdd(&(bar)[XB_TMO], 1u); break; } } } } while (0)
struct XcdBarrier { unsigned* bar; unsigned x; volatile LAS unsigned* st; };
DI XcdBarrier xcd_barrier_post(unsigned* bar, volatile LAS unsigned* st) {
  XcdBarrier b; b.bar = bar; b.x = xb_xcc_id(); b.st = st;
  if (threadIdx.x == 0) (void)xb_add(&bar[XB_XCNT(b.x)], 1u);
  return b;
}
DI void xcd_barrier_complete(unsigned* bar, unsigned x, unsigned& nloc, unsigned& nx) {
  const unsigned G = gridDim.x * gridDim.y * gridDim.z;
  unsigned sum, cnt, mine, sp = 0u;
  for (;;) {
    sum = 0u; cnt = 0u; mine = 0u;
#pragma unroll
    for (unsigned j = 0; j < 16; ++j) { const unsigned c = xb_ld(&bar[XB_XCNT(j)]); sum += c; cnt += (c > 0u) ? 1u : 0u; mine = (j == x) ? c : mine; }
    if (sum == G) break;
    __builtin_amdgcn_s_sleep(1);
    if ((++sp & 255u) == 0u) { if (xb_ld(&bar[XB_TMO])) break; if (sp > XB_SPIN_CAP) { atomicAdd(&bar[XB_TMO], 1u); break; } }
  }
  nloc = mine > 0u ? mine : 1u; nx = cnt > 0u ? cnt : 1u;
}
DI void xcd_barrier(const XcdBarrier& b) {
  asm volatile("s_waitcnt vmcnt(0)" ::: "memory");
  __syncthreads();
  if (threadIdx.x == 0) {
    unsigned* bar = b.bar;
    __builtin_amdgcn_s_waitcnt(0);
    unsigned nloc = b.st[0], nx = b.st[1];
    if (nloc == 0u) { xcd_barrier_complete(bar, b.x, nloc, nx); b.st[0] = nloc; b.st[1] = nx; }
    const unsigned old = xb_add(&bar[XB_XSUB(b.x)], 1u);
    const unsigned gen = old / nloc;
    if (old + 1u == (gen + 1u) * nloc) {
      __builtin_amdgcn_fence(__ATOMIC_RELEASE, "agent");
      asm volatile("s_waitcnt vmcnt(0)" ::: "memory");
      const unsigned og = xb_add(&bar[XB_TOP], 1u);
      const unsigned tg = og / nx;
      if (og + 1u == (tg + 1u) * nx) xb_add(&bar[XB_TOPGEN], 1u);
      else XB_SPIN(xb_ld(&bar[XB_TOPGEN]) == tg, bar);
      __builtin_amdgcn_fence(__ATOMIC_ACQUIRE, "agent");
      xb_add(&bar[XB_XGEN(b.x)], 1u);
      asm volatile("s_waitcnt vmcnt(0)" ::: "memory");
    } else {
      XB_SPIN(xb_ld(&bar[XB_XGEN(b.x)]) == gen, bar);
      __builtin_amdgcn_fence(__ATOMIC_ACQUIRE, "agent");
      asm volatile("s_waitcnt vmcnt(0)" ::: "memory");
    }
  }
  __syncthreads();
}

template <bool SCALE>
DI void transpose_w(const float* __restrict__ W, int ldw, int K, int NP, int NV, u16* __restrict__ wt,
                    const float* __restrict__ scale, bool remap, size_t gtid, size_t gsz) {
  const int kchunks = K / 8;
  for (size_t it = gtid; it < (size_t)NP * kchunks; it += gsz) {
    int j = (int)(it % NP), kc = (int)(it / NP);
    uint4 o = make_uint4(0, 0, 0, 0);
    if (j < NV) {
      int src = j;
      if (remap) src = j < 2048 ? j : (j < 4480 ? j + 8 : (j < 4488 ? 2048 + (j - 4480) : j));
      float v[8];
#pragma unroll
      for (int i = 0; i < 8; ++i) {
        v[i] = W[(size_t)(kc * 8 + i) * ldw + src];
        if (SCALE) v[i] *= scale[kc * 8 + i];
      }
      o.x = pack2(v[0], v[1]); o.y = pack2(v[2], v[3]); o.z = pack2(v[4], v[5]); o.w = pack2(v[6], v[7]);
    }
    *(uint4*)(wt + (size_t)j * K + kc * 8) = o;
  }
}

DI void phase0(const Params& P) {
  const int tid = otid(), lane = tid & 63, wave = tid >> 6;
  const size_t gtid = (size_t)blockIdx.x * 256 + tid, gsz = (size_t)gridDim.x * 256;
  char* ws = P.ws;
  transpose_w<false>(P.w_in, 4496, 1024, 4608, 4496, (u16*)(ws + OFF_WT_IN), nullptr, true, gtid, gsz);
  transpose_w<false>(P.w_out, 1024, 1024, 1024, 1024, (u16*)(ws + OFF_WT_OUT), nullptr, false, gtid, gsz);
  transpose_w<true>(P.w_ple_gate, 1024, 1024, 1024, 1024, (u16*)(ws + OFF_WT_GATE), P.ple_gate_norm_w, false, gtid, gsz);
  transpose_w<false>(P.w_ple, 1024, 256, 1024, 1024, (u16*)(ws + OFF_WT_PLE), nullptr, false, gtid, gsz);
  {
    u16* pb = (u16*)(ws + OFF_PB);
    for (size_t it = gtid; it < (size_t)T_ * 256 / 8; it += gsz) {
      float4 a = *(const float4*)(P.p + it * 8), b = *(const float4*)(P.p + it * 8 + 4);
      uint4 o; o.x = pack2(a.x, a.y); o.y = pack2(a.z, a.w); o.z = pack2(b.x, b.y); o.w = pack2(b.z, b.w);
      *(uint4*)(pb + it * 8) = o;
    }
  }
  {
    float* ss = (float*)(ws + OFF_SUMSQ);
    for (size_t it = gtid; it < (size_t)T_; it += gsz) ss[it] = 0.f;
  }
  {
    u16* H = (u16*)(ws + OFF_H);
    const int gw = blockIdx.x * 4 + wave, nw = gridDim.x * 4;
    for (int row0 = gw * 4; row0 < T_; row0 += nw * 4) {
      float4 v[4][4];
#pragma unroll
      for (int rr = 0; rr < 4; ++rr)
#pragma unroll
        for (int i = 0; i < 4; ++i) v[rr][i] = *(const float4*)(P.x + (size_t)(row0 + rr) * 1024 + lane * 4 + 256 * i);
      float4 g[4];
#pragma unroll
      for (int i = 0; i < 4; ++i) g[i] = *(const float4*)(P.attn_norm_w + lane * 4 + 256 * i);
#pragma unroll
      for (int rr = 0; rr < 4; ++rr) {
        float ss = 0.f;
#pragma unroll
        for (int i = 0; i < 4; ++i) ss += v[rr][i].x * v[rr][i].x + v[rr][i].y * v[rr][i].y + v[rr][i].z * v[rr][i].z + v[rr][i].w * v[rr][i].w;
#pragma unroll
        for (int d = 1; d < 64; d <<= 1) ss += __shfl_xor(ss, d);
        const float r = rsqrtf(ss * (1.f / 1024.f) + EPS);
#pragma unroll
        for (int i = 0; i < 4; ++i) {
          uint2 o; o.x = pack2(v[rr][i].x * r * g[i].x, v[rr][i].y * r * g[i].y); o.y = pack2(v[rr][i].z * r * g[i].z, v[rr][i].w * r * g[i].w);
          *(uint2*)(H + (size_t)(row0 + rr) * 1024 + lane * 4 + 256 * i) = o;
        }
      }
    }
  }
}

template <int MT>
DI void gemm_mainloop(const u16* __restrict__ A, int lda, const u16* __restrict__ Bt, int ldb, int K, int m0, int n0,
                      char* lds, f32x16 (&acc)[MT][2]) {
  const int tid = otid(), lane = tid & 63, wave = tid >> 6;
  const int wm = wave & 1, wn = wave >> 1, l31 = lane & 31, hh = lane >> 5;
  constexpr int BM = 64 * MT;
  char* ldsA = lds;
  char* ldsB = lds + BM * 128;
  const int lrow = tid >> 3, kc = tid & 7;
  const u16* ga = A + (size_t)(m0 + lrow) * lda + kc * 8;
  const u16* gb = Bt + (size_t)(n0 + lrow) * ldb + kc * 8;
  u32x4 ra[2 * MT], rb[4];
#pragma unroll
  for (int i = 0; i < 2 * MT; ++i) ra[i] = *(const u32x4*)(ga + (size_t)(32 * i) * lda);
#pragma unroll
  for (int i = 0; i < 4; ++i) rb[i] = *(const u32x4*)(gb + (size_t)(32 * i) * ldb);
  const int woff = lrow * 128 + ((kc ^ ((lrow >> 1) & 7)) << 4);
  const int nk = K >> 6;
  for (int kt = 0; kt < nk; ++kt) {
    __syncthreads();
#pragma unroll
    for (int i = 0; i < 2 * MT; ++i) *(u32x4*)(ldsA + woff + i * 4096) = ra[i];
#pragma unroll
    for (int i = 0; i < 4; ++i) *(u32x4*)(ldsB + woff + i * 4096) = rb[i];
    __syncthreads();
    if (kt + 1 < nk) {
#pragma unroll
      for (int i = 0; i < 2 * MT; ++i) ra[i] = *(const u32x4*)(ga + (size_t)(32 * i) * lda + (kt + 1) * 64);
#pragma unroll
      for (int i = 0; i < 4; ++i) rb[i] = *(const u32x4*)(gb + (size_t)(32 * i) * ldb + (kt + 1) * 64);
    }
#pragma unroll
    for (int s = 0; s < 4; ++s) {
      bf16x8 af[MT], bfr[2];
      const int c = 2 * s + hh;
#pragma unroll
      for (int i = 0; i < MT; ++i) {
        int row = wm * (32 * MT) + i * 32 + l31;
        af[i] = *(const bf16x8*)(ldsA + row * 128 + ((c ^ ((row >> 1) & 7)) << 4));
      }
#pragma unroll
      for (int j = 0; j < 2; ++j) {
        int rowb = wn * 64 + j * 32 + l31;
        bfr[j] = *(const bf16x8*)(ldsB + rowb * 128 + ((c ^ ((rowb >> 1) & 7)) << 4));
      }
#pragma unroll
      for (int i = 0; i < MT; ++i)
#pragma unroll
        for (int j = 0; j < 2; ++j) acc[i][j] = MFMA32(af[i], bfr[j], acc[i][j]);
    }
  }
}

DI void phase1(const Params& P, char* lds) {
  char* ws = P.ws;
  const u16* H = (const u16*)(ws + OFF_H);
  const u16* WT = (const u16*)(ws + OFF_WT_IN);
  const int lane = otid() & 63, wave = otid() >> 6;
  const int wm = wave & 1, wn = wave >> 1, l31 = lane & 31, hh = lane >> 5;
  const bool xswz = (gridDim.x & 7) == 0;
  const int xq = blockIdx.x >> 3, xn = gridDim.x >> 3, xx = blockIdx.x & 7;
  for (int tile = xswz ? xq : (int)blockIdx.x; tile < (xswz ? 8 * 36 : 64 * 36); tile += (xswz ? xn : (int)gridDim.x)) {
    const int mt = xswz ? 8 * xx + (tile & 7) : tile / 36, nt = xswz ? (tile >> 3) : tile % 36;
    f32x16 acc[4][2];
#pragma unroll
    for (int i = 0; i < 4; ++i)
#pragma unroll
      for (int j = 0; j < 2; ++j) acc[i][j] = zero16();
    gemm_mainloop<4>(H, 1024, WT, 1024, 1024, mt * 256, nt * 128, lds, acc);
    const int n0 = nt * 128;
    if (n0 < 4480) {
      u16* base; int ld, c0;
      if (n0 < 1536) { base = (u16*)(ws + OFF_QKV); ld = 1536; c0 = n0; }
      else if (n0 < 2048) { base = (u16*)(ws + OFF_AZ); ld = 512; c0 = n0 - 1536; }
      else if (n0 < 2560) { base = (u16*)(ws + OFF_BQ); ld = 512; c0 = n0 - 2048; }
      else if (n0 < 2816) { base = (u16*)(ws + OFF_BKV); ld = 256; c0 = n0 - 2560; }
      else if (n0 < 3328) { base = (u16*)(ws + OFF_BZ); ld = 512; c0 = n0 - 2816; }
      else if (n0 < 4352) { base = (u16*)(ws + OFF_IQ); ld = 1024; c0 = n0 - 3328; }
      else { base = (u16*)(ws + OFF_IK); ld = 128; c0 = n0 - 4352; }
      const bool qn = (n0 >= 2048 && n0 < 2560), kn = (n0 == 2560);
      float w0 = 1.f, w1 = 1.f;
      if (qn) { w0 = P.b_q_norm_w[l31] * 0.125f; w1 = P.b_q_norm_w[32 + l31] * 0.125f; }
      if (kn) { w0 = P.b_k_norm_w[l31]; w1 = P.b_k_norm_w[32 + l31]; }
      const int rowbase = mt * 256 + wm * 128;
      char* p0; int rs, ts, c1;
      if (n0 == 4352) {
        const int ca = wn * 64 + l31;
        p0 = (char*)base + (size_t)(rowbase >> 5) * 8192 + hh * 64 + ((ca >> 4) * 512 + ((ca >> 3) & 1) * 256 + (ca & 7)) * 2;
        rs = 16; ts = 8192; c1 = 2048;
      } else {
        p0 = (char*)base + ((size_t)(rowbase + 4 * hh) * ld + c0 + wn * 64 + l31) * 2;
        rs = ld * 2; ts = 64 * ld; c1 = 64;
      }
#pragma unroll
      for (int i = 0; i < 4; ++i) {
        char* pr = p0 + (size_t)i * ts;
#pragma unroll
        for (int r = 0; r < 16; ++r) {
          float v0 = acc[i][0][r], v1 = acc[i][1][r];
          if (qn || kn) {
            float ss = v0 * v0 + v1 * v1;
            ss += dpp_xor1(ss); ss += dpp_xor2(ss); ss += __shfl_xor(ss, 4); ss += dpp_xor8(ss); ss += __shfl_xor(ss, 16);
            const float rsq = rsqrtf(ss * (1.f / 64.f) + EPS);
            v0 *= rsq * w0; v1 *= rsq * w1;
          }
          *(u16*)pr = f2bf(v0);
          *(u16*)(pr + c1) = f2bf(v1);
          pr += ((r & 3) == 3) ? 5 * rs : rs;
          asm volatile("" : "+v"(pr));
        }
      }
    } else {
      if (wn == 0 && l31 < 16) {
        float* sp = (float*)(ws + OFF_SMALL) + (size_t)(mt * 256 + wm * 128 + 4 * hh) * 16 + l31;
#pragma unroll
        for (int i = 0; i < 4; ++i)
#pragma unroll
          for (int r = 0; r < 16; ++r) {
            *sp = acc[i][0][r];
            sp += ((r & 3) == 3) ? 5 * 16 : 16;
            asm volatile("" : "+v"(sp));
          }
      }
    }
  }
}

DI void knorm_all(const Params& P) {
  const int lane = otid() & 63, wave = otid() >> 6;
  u32* BKV = (u32*)(P.ws + OFF_BKV);
  const int gw = blockIdx.x * 4 + wave, nw = gridDim.x * 4;
  const float w0 = P.b_k_norm_w[(2 * lane) & 63], w1 = P.b_k_norm_w[(2 * lane + 1) & 63];
  for (int tok = gw; tok < T_; tok += nw) {
    u32 v = BKV[(size_t)tok * 128 + lane];
    float a = bflo(v), b = bfhi(v);
    float ss = a * a + b * b;
#pragma unroll
    for (int d = 1; d < 32; d <<= 1) ss += __shfl_xor(ss, d);
    float r = rsqrtf(ss * (1.f / 64.f) + EPS);
    BKV[(size_t)tok * 128 + lane] = pack2(a * r * w0, b * r * w1);
  }
}

DI int perm16(int x) { return (x & 3) | ((x & 8) >> 1) | ((x & 4) << 1); }

DI void ka1_item(const Params& P, int ch, char* lds) {
  const int tid = otid(), lane = tid & 63, wave = tid >> 6, hh = lane >> 5, l31 = lane & 31;
  const int b = ch >> 8, h = (ch >> 6) & 3, n = ch & 63;
  const int tok0 = b * 4096 + n * 64;
  char* ws = P.ws;
  u16* QV = (u16*)lds;
  u16* Ks = (u16*)(lds + 18432);
  u16* KBT = (u16*)(lds + 18432 + 17408);
  float* Am = (float*)(lds + 18432 + 17408 + 18432);
  u16* Tm = Ks;
  float* sm = (float*)(lds + 18432 + 17408 + 18432 + 16384);
  const u16* QKV = (const u16*)(ws + OFF_QKV);
  const float* SMALL = (const float*)(ws + OFF_SMALL);
  u16* QD = (u16*)(ws + OFF_QD) + (size_t)ch * 8192;
  u16* ATT = (u16*)(ws + OFF_ATT) + (size_t)ch * 4096;
  u16* KDT = (u16*)(ws + OFF_KDT) + (size_t)ch * 8192;
  u16* WNEG = (u16*)(ws + OFF_WNEG) + (size_t)ch * 8192;
  u16* UT = (u16*)(ws + OFF_UT) + (size_t)ch * 8192;
  __syncthreads();
  if (wave == 0) {
    float ab = SMALL[(size_t)(tok0 + lane) * 16 + h];
    float aa = SMALL[(size_t)(tok0 + lane) * 16 + 4 + h];
    float beta = sigmoidf_(ab);
    float xs = aa + P.dt_bias[h];
    float sp = fmaxf(xs, 0.f) + log1pf(__expf(-fabsf(xs)));
    float g = -__expf(P.a_log[h]) * sp;
#pragma unroll
    for (int d = 1; d < 64; d <<= 1) { float t = __shfl_up(g, d); if (lane >= d) g += t; }
    float glast = __shfl(g, 63);
    sm[lane] = g; sm[64 + lane] = beta; sm[128 + lane] = __expf(g); sm[192 + lane] = __expf(glast - g);
  }
  __syncthreads();
  const float* cw = P.conv_w;
  {
    const int cq = h * 128 + 2 * lane, ck = 512 + cq;
    float wq[4][2], wk[4][2];
#pragma unroll
    for (int j = 0; j < 4; ++j) {
      wq[j][0] = cw[j * 1536 + cq]; wq[j][1] = cw[j * 1536 + cq + 1];
      wk[j][0] = cw[j * 1536 + ck]; wk[j][1] = cw[j * 1536 + ck + 1];
    }
    const int i0 = wave * 16;
    float xq[3][2], xk[3][2];
#pragma unroll
    for (int j = 0; j < 3; ++j) {
      int pos = n * 64 + i0 - 3 + j;
      u32 vq = 0, vk = 0;
      if (pos >= 0) {
        const u16* rp = QKV + (size_t)(tok0 + i0 - 3 + j) * 1536;
        vq = *(const u32*)(rp + cq); vk = *(const u32*)(rp + ck);
      }
      xq[j][0] = bflo(vq); xq[j][1] = bfhi(vq); xk[j][0] = bflo(vk); xk[j][1] = bfhi(vk);
    }
    u32 rq_[16], rk_[16];
#pragma unroll
    for (int ii = 0; ii < 16; ++ii) {
      const u16* rp = QKV + (size_t)(tok0 + i0 + ii) * 1536;
      rq_[ii] = *(const u32*)(rp + cq); rk_[ii] = *(const u32*)(rp + ck);
    }
#pragma unroll
    for (int ii = 0; ii < 16; ++ii) {
      const int i = i0 + ii;
      const u32 vq = rq_[ii], vk = rk_[ii];
      float cq0 = bflo(vq), cq1 = bfhi(vq), ck0 = bflo(vk), ck1 = bfhi(vk);
      float yq0 = wq[0][0] * xq[0][0] + wq[1][0] * xq[1][0] + wq[2][0] * xq[2][0] + wq[3][0] * cq0;
      float yq1 = wq[0][1] * xq[0][1] + wq[1][1] * xq[1][1] + wq[2][1] * xq[2][1] + wq[3][1] * cq1;
      float yk0 = wk[0][0] * xk[0][0] + wk[1][0] * xk[1][0] + wk[2][0] * xk[2][0] + wk[3][0] * ck0;
      float yk1 = wk[0][1] * xk[0][1] + wk[1][1] * xk[1][1] + wk[2][1] * xk[2][1] + wk[3][1] * ck1;
      xq[0][0] = xq[1][0]; xq[0][1] = xq[1][1]; xq[1][0] = xq[2][0]; xq[1][1] = xq[2][1]; xq[2][0] = cq0; xq[2][1] = cq1;
      xk[0][0] = xk[1][0]; xk[0][1] = xk[1][1]; xk[1][0] = xk[2][0]; xk[1][1] = xk[2][1]; xk[2][0] = ck0; xk[2][1] = ck1;
      yq0 = siluf_(yq0); yq1 = siluf_(yq1); yk0 = siluf_(yk0); yk1 = siluf_(yk1);
      float sq = yq0 * yq0 + yq1 * yq1, sk = yk0 * yk0 + yk1 * yk1;
#pragma unroll
      for (int d = 1; d < 64; d <<= 1) { sq += __shfl_xor(sq, d); sk += __shfl_xor(sk, d); }
      const float rq = rsqrtf(sq + EPS) * 0.08838834764831845f, rk = rsqrtf(sk + EPS);
      yq0 *= rq; yq1 *= rq; yk0 *= rk; yk1 *= rk;
      *(u32*)(QV + i * 136 + 2 * lane) = pack2(yq0, yq1);
      *(u32*)(Ks + i * 136 + 2 * lane) = pack2(yk0, yk1);
      KBT[(2 * lane) * 72 + i] = f2bf(yk0);
      KBT[(2 * lane + 1) * 72 + i] = f2bf(yk1);
      const float eg = sm[128 + i];
      *(u32*)(QD + i * 128 + 2 * lane) = pack2(yq0 * eg, yq1 * eg);
    }
  }
  __syncthreads();
  {
    const int mt = wave & 1, nt = wave >> 1;
    f32x16 akk = zero16(), aqk = zero16();
#pragma unroll
    for (int s = 0; s < 8; ++s) {
      const int kof = 16 * s + 8 * hh;
      bf16x8 aq = *(const bf16x8*)(QV + (32 * mt + l31) * 136 + kof);
      bf16x8 ak = *(const bf16x8*)(Ks + (32 * mt + l31) * 136 + kof);
      bf16x8 bk = *(const bf16x8*)(Ks + (32 * nt + l31) * 136 + kof);
      akk = MFMA32(ak, bk, akk);
      aqk = MFMA32(aq, bk, aqk);
    }
    const int j = 32 * nt + l31;
    const float gj = sm[j];
#pragma unroll
    for (int r = 0; r < 16; ++r) {
      const int i = 32 * mt + (r & 3) + 8 * (r >> 2) + 4 * hh;
      const float gi = sm[i], bi = sm[64 + i];
      const float dec = (j <= i) ? __expf(gi - gj) : 0.f;
      Am[i * 64 + j] = (j < i) ? bi * akk[r] * dec : 0.f;
      ATT[i * 64 + j] = f2bf(aqk[r] * dec);
    }
  }
  {
    const int dk = tid >> 1, th = tid & 1;
    u16* kr = KBT + dk * 72 + th * 32;
#pragma unroll
    for (int g2 = 0; g2 < 2; ++g2) {
      u16 ov[16];
#pragma unroll
      for (int x = 0; x < 16; ++x) {
        const int tok = th * 32 + g2 * 16 + x;
        const float kv = bf2f(kr[g2 * 16 + x]);
        ov[perm16(x)] = f2bf(kv * sm[192 + tok]);
        kr[g2 * 16 + x] = f2bf(kv * sm[64 + tok] * sm[128 + tok]);
      }
      uint4 o0, o1;
      o0.x = ov[0] | ((u32)ov[1] << 16); o0.y = ov[2] | ((u32)ov[3] << 16); o0.z = ov[4] | ((u32)ov[5] << 16); o0.w = ov[6] | ((u32)ov[7] << 16);
      o1.x = ov[8] | ((u32)ov[9] << 16); o1.y = ov[10] | ((u32)ov[11] << 16); o1.z = ov[12] | ((u32)ov[13] << 16); o1.w = ov[14] | ((u32)ov[15] << 16);
      *(uint4*)(KDT + dk * 64 + th * 32 + g2 * 16) = o0;
      *(uint4*)(KDT + dk * 64 + th * 32 + g2 * 16 + 8) = o1;
    }
  }
  __syncthreads();
  {
    u16* VBT = QV;
    const int cv = 1024 + h * 128 + 2 * lane;
    float wv[4][2];
#pragma unroll
    for (int j = 0; j < 4; ++j) { wv[j][0] = cw[j * 1536 + cv]; wv[j][1] = cw[j * 1536 + cv + 1]; }
    const int i0 = wave * 16;
    float xv[3][2];
#pragma unroll
    for (int j = 0; j < 3; ++j) {
      int pos = n * 64 + i0 - 3 + j;
      u32 vv = 0;
      if (pos >= 0) vv = *(const u32*)(QKV + (size_t)(tok0 + i0 - 3 + j) * 1536 + cv);
      xv[j][0] = bflo(vv); xv[j][1] = bfhi(vv);
    }
    u32 rv_[16];
#pragma unroll
    for (int ii = 0; ii < 16; ++ii) rv_[ii] = *(const u32*)(QKV + (size_t)(tok0 + i0 + ii) * 1536 + cv);
#pragma unroll
    for (int ii = 0; ii < 16; ++ii) {
      const int i = i0 + ii;
      const u32 vv = rv_[ii];
      float c0 = bflo(vv), c1 = bfhi(vv);
      float y0 = wv[0][0] * xv[0][0] + wv[1][0] * xv[1][0] + wv[2][0] * xv[2][0] + wv[3][0] * c0;
      float y1 = wv[0][1] * xv[0][1] + wv[1][1] * xv[1][1] + wv[2][1] * xv[2][1] + wv[3][1] * c1;
      xv[0][0] = xv[1][0]; xv[0][1] = xv[1][1]; xv[1][0] = xv[2][0]; xv[1][1] = xv[2][1]; xv[2][0] = c0; xv[2][1] = c1;
      const float bi = sm[64 + i];
      VBT[(2 * lane) * 72 + i] = f2bf(siluf_(y0) * bi);
      VBT[(2 * lane + 1) * 72 + i] = f2bf(siluf_(y1) * bi);
    }
  }
  if (wave == 0) {
    float Tc[63];
#pragma unroll
    for (int i = 0; i < 64; ++i) {
      float a = (i == lane) ? 1.f : 0.f;
#pragma unroll
      for (int j = 0; j < i; ++j) a -= Am[i * 64 + j] * Tc[j];
      if (i < 63) Tc[i] = a;
      Tm[i * 72 + lane] = f2bf(a);
      if ((i & 3) == 3) __builtin_amdgcn_sched_barrier(0);
    }
  }
  __syncthreads();
  {
    const u16* VBT = QV;
    f32x16 c0 = zero16(), c1 = zero16(), d0 = zero16(), d1 = zero16();
#pragma unroll
    for (int s = 0; s < 4; ++s) {
      const int kof = 16 * s + 8 * hh;
      bf16x8 t0 = *(const bf16x8*)(Tm + l31 * 72 + kof);
      bf16x8 t1 = *(const bf16x8*)(Tm + (32 + l31) * 72 + kof);
      bf16x8 a = *(const bf16x8*)(KBT + (32 * wave + l31) * 72 + kof);
      bf16x8 bv = *(const bf16x8*)(VBT + (32 * wave + l31) * 72 + kof);
      c0 = MFMA32(a, t0, c0);
      c1 = MFMA32(a, t1, c1);
      d0 = MFMA32(t0, bv, d0);
      d1 = MFMA32(t1, bv, d1);
    }
#pragma unroll
    for (int rg = 0; rg < 4; ++rg) {
      const int dkpos = 16 * (2 * wave + (rg >> 1)) + 8 * hh + 4 * (rg & 1);
      uint2 o;
      o.x = pack2(-c0[4 * rg], -c0[4 * rg + 1]); o.y = pack2(-c0[4 * rg + 2], -c0[4 * rg + 3]);
      *(uint2*)(WNEG + (l31) * 128 + dkpos) = o;
      o.x = pack2(-c1[4 * rg], -c1[4 * rg + 1]); o.y = pack2(-c1[4 * rg + 2], -c1[4 * rg + 3]);
      *(uint2*)(WNEG + (32 + l31) * 128 + dkpos) = o;
      const int dv = 32 * wave + l31;
      o.x = pack2(d0[4 * rg], d0[4 * rg + 1]); o.y = pack2(d0[4 * rg + 2], d0[4 * rg + 3]);
      *(uint2*)(UT + rg * 1024 + dv * 8 + 4 * hh) = o;
      o.x = pack2(d1[4 * rg], d1[4 * rg + 1]); o.y = pack2(d1[4 * rg + 2], d1[4 * rg + 3]);
      *(uint2*)(UT + (4 + rg) * 1024 + dv * 8 + 4 * hh) = o;
    }
    if (tid == 0) ((float*)(ws + OFF_GL))[ch] = sm[128 + 63];
  }
}

#define ATT_UNROLL 8
typedef __bf16 bf2_t __attribute__((ext_vector_type(2)));
DI float fdot2(u32 a, u32 b, float c) { return __builtin_amdgcn_fdot2_f32_bf16(__builtin_bit_cast(bf2_t, a), __builtin_bit_cast(bf2_t, b), c, false); }
DI float dot8(const uint4& k, const u32* q, float acc) {
  acc = fdot2(k.x, q[0], acc);
  acc = fdot2(k.y, q[1], acc);
  acc = fdot2(k.z, q[2], acc);
  acc = fdot2(k.w, q[3], acc);
  return acc;
}

DI void kb2_query(const Params& P, int t, float* Sw, const u16* idxp) {
  const int lane = otid() & 63;
  char* ws = P.ws;
  const int b = t >> 12, pos = t & 4095;
  const int nvalid = pos + 1 < 256 ? pos + 1 : 256;
  const bool uselist = pos >= 255;
  const u16* BKVb = (const u16*)(ws + OFF_BKV) + (size_t)b * 4096 * 256;
  float inv;
  {
    const int l15 = lane & 15, g4 = lane >> 4;
    bf16x8 qf[4];
    {
      const u16* qrow = (const u16*)(ws + OFF_BQ) + (size_t)t * 512;
#pragma unroll
      for (int s = 0; s < 4; ++s) {
        bf16x8 z = {0, 0, 0, 0, 0, 0, 0, 0};
        if (l15 < 8 && (l15 >> 2) == (s >> 1)) z = *(const bf16x8*)(qrow + l15 * 64 + 32 * (s & 1) + 8 * g4);
        qf[s] = z;
      }
    }
    float sum = 0.f;
#pragma unroll 4
    for (int tau = 0; tau < 16; ++tau) {
      const int slotA = 16 * tau + l15;
      int kidx = uselist ? (int)idxp[slotA] : slotA;
      if (slotA >= nvalid) kidx = 0;
      const u16* row = BKVb + (size_t)kidx * 256 + 8 * g4;
      bf16x8 ka[4];
#pragma unroll
      for (int s = 0; s < 4; ++s) ka[s] = *(const bf16x8*)(row + 32 * s);
      f32x4 c = zero4();
      __builtin_amdgcn_s_setprio(1);
#pragma unroll
      for (int s = 0; s < 4; ++s) c = MFMA16(ka[s], qf[s], c);
      __builtin_amdgcn_s_setprio(0);
#pragma unroll
      for (int r = 0; r < 4; ++r) {
        const int slot = 16 * tau + 4 * g4 + r;
        const float pe = (slot < nvalid) ? __expf(c[r]) : 0.f;
        sum += pe;
        if (l15 < 8) Sw[slot * 8 + l15] = pe;
      }
    }
    sum += __shfl_xor(sum, 16); sum += __shfl_xor(sum, 32);
    inv = 1.f / sum;
  }
  const int dc = (lane & 3) | (((lane >> 3) & 1) << 2);
  const int ks = ((lane >> 2) & 1) | ((lane >> 4) << 1);
  float o[8][8];
#pragma unroll
  for (int hd = 0; hd < 8; ++hd)
#pragma unroll
    for (int d = 0; d < 8; ++d) o[hd][d] = 0.f;
#pragma unroll ATT_UNROLL
  for (int it = 0; it < 32; ++it) {
    const int slot = it * 8 + ks;
    int kidx = uselist ? (int)idxp[slot] : slot;
    if (slot >= nvalid) kidx = 0;
    const u16* row = BKVb + (size_t)kidx * 256;
    const uint4 v0 = *(const uint4*)(row + 128 + dc * 8);
    const uint4 v1 = *(const uint4*)(row + 192 + dc * 8);
    const f32x4 pa = *(const f32x4*)(Sw + slot * 8);
    const f32x4 pb = *(const f32x4*)(Sw + slot * 8 + 4);
    float f0[8] = {bflo(v0.x), bfhi(v0.x), bflo(v0.y), bfhi(v0.y), bflo(v0.z), bfhi(v0.z), bflo(v0.w), bfhi(v0.w)};
    float f1[8] = {bflo(v1.x), bfhi(v1.x), bflo(v1.y), bfhi(v1.y), bflo(v1.z), bfhi(v1.z), bflo(v1.w), bfhi(v1.w)};
#pragma unroll
    for (int r = 0; r < 4; ++r) {
#pragma unroll
      for (int d = 0; d < 8; ++d) { o[r][d] += pa[r] * f0[d]; o[4 + r][d] += pb[r] * f1[d]; }
    }
  }
  float o4[4][8];
  {
    const bool up = ks & 4;
#pragma unroll
    for (int i = 0; i < 4; ++i)
#pragma unroll
      for (int d = 0; d < 8; ++d) { float keep = up ? o[4 + i][d] : o[i][d]; float send = up ? o[i][d] : o[4 + i][d]; o4[i][d] = keep + __shfl_xor(send, 32); }
  }
  float o2[2][8];
  {
    const bool up = ks & 2;
#pragma unroll
    for (int i = 0; i < 2; ++i)
#pragma unroll
      for (int d = 0; d < 8; ++d) { float keep = up ? o4[2 + i][d] : o4[i][d]; float send = up ? o4[i][d] : o4[2 + i][d]; o2[i][d] = keep + __shfl_xor(send, 16); }
  }
  float o1[8];
  {
    const bool up = ks & 1;
#pragma unroll
    for (int d = 0; d < 8; ++d) { float keep = up ? o2[1][d] : o2[0][d]; float send = up ? o2[0][d] : o2[1][d]; o1[d] = keep + __shfl_xor(send, 4); }
  }
  const float invh = __shfl(inv, ks);
  const u16* bz = (const u16*)(ws + OFF_BZ) + (size_t)t * 512 + ks * 64 + dc * 8;
  uint4 zz = *(const uint4*)bz;
  float zf[8] = {bflo(zz.x), bfhi(zz.x), bflo(zz.y), bfhi(zz.y), bflo(zz.z), bfhi(zz.z), bflo(zz.w), bfhi(zz.w)};
  uint4 ov;
  ov.x = pack2(o1[0] * invh * siluf_(zf[0]), o1[1] * invh * siluf_(zf[1]));
  ov.y = pack2(o1[2] * invh * siluf_(zf[2]), o1[3] * invh * siluf_(zf[3]));
  ov.z = pack2(o1[4] * invh * siluf_(zf[4]), o1[5] * invh * siluf_(zf[5]));
  ov.w = pack2(o1[6] * invh * siluf_(zf[6]), o1[7] * invh * siluf_(zf[7]));
  *(uint4*)((u16*)(ws + OFF_MIXB) + (size_t)t * 512 + ks * 64 + dc * 8) = ov;
}

DI void kb_item(const Params& P, int item, char* lds) {
  const int tid = otid();
  const int lane = tid & 63, wave = __builtin_amdgcn_readfirstlane(tid >> 6), hh = lane >> 5, l31 = lane & 31;
  const int b = item & 3, qt = 1023 - (item >> 2), t0 = qt * 4;
  char* ws = P.ws;
  float* Sl = (float*)lds;
  u16* myidx = (u16*)(lds + wave * 16384);
  float* mySw = (float*)(lds + wave * 16384 + 1024);
  if (t0 + 3 < 255) {
    __syncthreads();
    kb2_query(P, b * 4096 + t0 + wave, mySw, myidx);
    return;
  }
  const u16* IQ = (const u16*)(ws + OFF_IQ);
  const u16* IK = (const u16*)(ws + OFF_IK);
  const float* SMALL = (const float*)(ws + OFF_SMALL);
  const int T0 = b * 4096 + t0;
  __syncthreads();
  {
    bf16x8 af[8];
    const u16* src = IQ + (size_t)(T0 + ((l31 >> 2) & 1) + 2 * ((l31 >> 4) & 1)) * 1024 + ((l31 & 3) + 4 * ((l31 >> 3) & 1)) * 128 + 8 * hh;
#pragma unroll
    for (int s = 0; s < 8; ++s) af[s] = *(const bf16x8*)(src + 16 * s);
    float wv[16];
#pragma unroll
    for (int r = 0; r < 16; ++r) wv[r] = SMALL[(size_t)(T0 + hh + 2 * (r >> 3)) * 16 + 8 + (r & 3) + 4 * ((r >> 2) & 1)] * 0.03125f;
    const int ntile = (t0 + 4 + 31) >> 5;
    const u16* kbase = IK + (size_t)b * 128 * 4096 + lane * 8;
    const int nmine = ntile > wave ? (ntile - wave + 3) >> 2 : 0;
    bf16x8 c0[8], c1[8];
    {
      const int k0 = wave, k1 = nmine > 1 ? wave + 4 : wave;
      if (nmine > 0) {
#pragma unroll
        for (int s = 0; s < 8; ++s) { c0[s] = *(const bf16x8*)(kbase + (size_t)k0 * 4096 + 512 * s); c1[s] = *(const bf16x8*)(kbase + (size_t)k1 * 4096 + 512 * s); }
      }
    }
    for (int j = 0; j < nmine; j += 2) {
      const int kt0 = wave + 4 * j, kt1 = kt0 + 4;
      const bool has1 = j + 1 < nmine;
      bf16x8 n0[8], n1[8];
      {
        const int ka = j + 2 < nmine ? kt0 + 8 : kt0, kb2 = j + 3 < nmine ? kt0 + 12 : kt0;
#pragma unroll
        for (int s = 0; s < 8; ++s) { n0[s] = *(const bf16x8*)(kbase + (size_t)ka * 4096 + 512 * s); n1[s] = *(const bf16x8*)(kbase + (size_t)kb2 * 4096 + 512 * s); }
      }
      f32x16 acc0 = zero16(), acc1 = zero16();
      __builtin_amdgcn_s_setprio(1);
#pragma unroll
      for (int s = 0; s < 8; ++s) { acc0 = MFMA32(af[s], c0[s], acc0); acc1 = MFMA32(af[s], c1[s], acc1); }
      __builtin_amdgcn_s_setprio(0);
#pragma unroll
      for (int s = 0; s < 8; ++s) { c0[s] = n0[s]; c1[s] = n1[s]; }
      float sa0 = 0.f, sa1 = 0.f, sb0 = 0.f, sb1 = 0.f;
#pragma unroll
      for (int i = 0; i < 8; ++i) {
        sa0 += wv[i] * fmaxf(acc0[i], 0.f); sa1 += wv[8 + i] * fmaxf(acc0[8 + i], 0.f);
        sb0 += wv[i] * fmaxf(acc1[i], 0.f); sb1 += wv[8 + i] * fmaxf(acc1[8 + i], 0.f);
      }
      Sl[hh * 4096 + kt0 * 32 + l31] = sa0;
      Sl[(hh + 2) * 4096 + kt0 * 32 + l31] = sa1;
      if (has1) {
        Sl[hh * 4096 + kt1 * 32 + l31] = sb0;
        Sl[(hh + 2) * 4096 + kt1 * 32 + l31] = sb1;
      }
    }
  }
  __syncthreads();
  const int pos = t0 + wave;
  if (pos >= 255) {
    const int nchunk = (pos >> 10) + 1;
    u32 key[64];
#pragma unroll
    for (int c4 = 0; c4 < 4; ++c4) {
      if (c4 < nchunk) {
#pragma unroll
        for (int ii = 0; ii < 16; ++ii) {
          const int i = c4 * 16 + ii;
          const int idx = lane + 64 * i;
          float v = Sl[wave * 4096 + idx] + 0.0f;
          u32 u = __float_as_uint(v);
          u = (u & 0x80000000u) ? ~u : (u | 0x80000000u);
          key[i] = (idx <= pos) ? u : 0u;
        }
      } else {
#pragma unroll
        for (int ii = 0; ii < 16; ++ii) key[c4 * 16 + ii] = 0u;
      }
    }
    u32 g0 = key[0], g1 = key[1], g2 = key[2], g3 = key[3];
#pragma unroll
    for (int i = 4; i < 64; i += 4) { g0 = max(g0, key[i]); g1 = max(g1, key[i + 1]); g2 = max(g2, key[i + 2]); g3 = max(g3, key[i + 3]); }
    u32 lo = min(min(g0, g1), min(g2, g3)), hi = max(max(g0, g1), max(g2, g3));
#pragma unroll
    for (int d = 1; d < 64; d <<= 1) { lo = min(lo, (u32)__shfl_xor((int)lo, d)); hi = max(hi, (u32)__shfl_xor((int)hi, d)); }
    lo = __builtin_amdgcn_readfirstlane(lo); hi = __builtin_amdgcn_readfirstlane(hi);
    const u32 diff = lo ^ hi;
    const int topbit = diff ? 31 - __builtin_clz(diff) : -1;
    u32 Pv = topbit >= 31 ? 0u : (topbit < 0 ? lo : (lo & ~((2u << topbit) - 1u)));
    bool exact = false;
    for (int bit = topbit; bit >= 0; --bit) {
      const u32 cand = Pv | (1u << bit);
      int c = 0;
#pragma unroll
      for (int c4 = 0; c4 < 4; ++c4) {
        if (c4 < nchunk) {
#pragma unroll
          for (int ii = 0; ii < 16; ++ii) {
            c += __popcll(__ballot(key[c4 * 16 + ii] >= cand));
            if ((ii & 7) == 7) __builtin_amdgcn_sched_barrier(0);
          }
        }
      }
      if (c >= 256) {
        Pv = cand;
        if (c == 256) { exact = true; break; }
      }
    }
    int need = 1 << 30;
    if (!exact) {
      int cgt = 0;
#pragma unroll
      for (int c4 = 0; c4 < 4; ++c4) {
        if (c4 < nchunk) {
#pragma unroll
          for (int ii = 0; ii < 16; ++ii) {
            cgt += __popcll(__ballot(key[c4 * 16 + ii] > Pv));
            if ((ii & 7) == 7) __builtin_amdgcn_sched_barrier(0);
          }
        }
      }
      need = 256 - cgt;
    }
    u16* out = myidx;
    if (exact) {
      u32 mlo = 0u, mhi = 0u;
#pragma unroll
      for (int c4 = 0; c4 < 4; ++c4) {
        if (c4 < nchunk) {
#pragma unroll
          for (int ii = 0; ii < 16; ++ii) {
            const int i = c4 * 16 + ii;
            const u32 bit = (key[i] >= Pv) ? (1u << (i & 31)) : 0u;
            if (i < 32) mlo |= bit; else mhi |= bit;
          }
        }
      }
      const int cnt = __popc(mlo) + __popc(mhi);
      int incl = cnt;
#pragma unroll
      for (int d = 1; d < 64; d <<= 1) { const int tv = __shfl_up(incl, d); if (lane >= d) incl += tv; }
      int off = incl - cnt;
      while (mlo) { const int i = __ffs((int)mlo) - 1; out[off++] = (u16)(lane + 64 * i); mlo &= mlo - 1u; }
      while (mhi) { const int i = __ffs((int)mhi) - 1; out[off++] = (u16)(lane + 64 * (32 + i)); mhi &= mhi - 1u; }
    } else {
    int off = 0, eqseen = 0;
    const u64 ltmask = (1ull << lane) - 1ull;
#pragma unroll
    for (int c4 = 0; c4 < 4; ++c4) {
      if (c4 < nchunk) {
#pragma unroll
        for (int ii = 0; ii < 16; ++ii) {
          const int i = c4 * 16 + ii;
          const bool gt = key[i] > Pv, eq = key[i] == Pv;
          const u64 meq = __ballot(eq);
          const int rank = eqseen + __popcll(meq & ltmask);
          const bool sel = gt || (eq && rank < need);
          const u64 ms = __ballot(sel);
          if (sel) out[off + __popcll(ms & ltmask)] = (u16)(lane + 64 * i);
          off += __popcll(ms);
          eqseen += __popcll(meq);
          if ((ii & 3) == 3) __builtin_amdgcn_sched_barrier(0);
        }
      }
    }
    }
  }
  kb2_query(P, T0 + wave, mySw, myidx);
}

constexpr int KB_SPLIT = 1792;
DI int pull_item(unsigned* ctr, char* lds) {
  volatile LAS unsigned* slot = (volatile LAS unsigned*)(lds + LDS_BYTES - 8);
  __syncthreads();
  if (threadIdx.x == 0) *slot = __hip_atomic_fetch_add(ctr, 1u, __ATOMIC_RELAXED, __HIP_MEMORY_SCOPE_AGENT);
  __syncthreads();
  return (int)*slot;
}
DI void phase2(const Params& P, char* lds) {
  for (int it = blockIdx.x; it < 1024; it += gridDim.x) ka1_item(P, it, lds);
  if ((gridDim.x & 3) == 0) {
    const int bb = blockIdx.x & 3;
    unsigned* ctr = (unsigned*)(P.ws + OFF_BAR) + 16 * bb;
    for (;;) {
      const int k = pull_item(ctr, lds);
      if (k >= KB_SPLIT / 4) break;
      kb_item(P, 4 * k + bb, lds);
    }
  } else {
    for (int it = blockIdx.x; it < KB_SPLIT; it += gridDim.x) kb_item(P, it, lds);
  }
}

DI void ka2_scan(const Params& P, int bh, char* lds) {
  const int tid = otid(), lane = tid & 63, wave = tid >> 6, hh = lane >> 5, l31 = lane & 31;
  char* ws = P.ws;
  const int dv = 32 * wave + l31;
  const u16* WNEG = (const u16*)(ws + OFF_WNEG) + (size_t)bh * 64 * 8192;
  const u16* KDT = (const u16*)(ws + OFF_KDT) + (size_t)bh * 64 * 8192;
  const u16* UT = (const u16*)(ws + OFF_UT) + (size_t)bh * 64 * 8192 + dv * 8 + 4 * hh;
  const float* GL = (const float*)(ws + OFF_GL) + bh * 64;
  u16* HST = (u16*)((char*)P.out + OOFF_HST) + (size_t)bh * 64 * 16384 + dv * 8 + 4 * hh;
  u16* VNT = (u16*)((char*)P.out + OOFF_VNT) + (size_t)bh * 64 * 8192 + dv * 8 + 4 * hh;
  const int wbase = (tid >> 4) * 272 + ((tid & 15) << 4);
  const int kbase = 17408 + (tid >> 3) * 144 + ((tid & 7) << 4);
  u32x4 sw[4], sk[4];
  uint2 un[8];
  float gln;
  __syncthreads();
#pragma unroll
  for (int i = 0; i < 4; ++i) {
    sw[i] = *(const u32x4*)(WNEG + (size_t)(tid + 256 * i) * 8);
    sk[i] = *(const u32x4*)(KDT + (size_t)(tid + 256 * i) * 8);
  }
#pragma unroll
  for (int i = 0; i < 8; ++i) un[i] = *(const uint2*)(UT + i * 1024);
  gln = GL[0];
#pragma unroll
  for (int i = 0; i < 4; ++i) { *(u32x4*)(lds + wbase + i * 4352) = sw[i]; *(u32x4*)(lds + kbase + i * 4608) = sk[i]; }
  __syncthreads();
  f32x16 S[4];
#pragma unroll
  for (int m = 0; m < 4; ++m) S[m] = zero16();
  for (int n = 0; n < 64; ++n) {
    const char* buf = lds + (n & 1) * 35840;
    char* nbuf = lds + ((n + 1) & 1) * 35840;
    f32x16 vn[2];
#pragma unroll
    for (int tt = 0; tt < 2; ++tt) {
#pragma unroll
      for (int rg = 0; rg < 4; ++rg) {
        const uint2 u = un[4 * tt + rg];
        vn[tt][4 * rg] = bflo(u.x); vn[tt][4 * rg + 1] = bfhi(u.x); vn[tt][4 * rg + 2] = bflo(u.y); vn[tt][4 * rg + 3] = bfhi(u.y);
      }
    }
    const float gl = gln;
    if (n + 1 < 64) {
      const size_t o = (size_t)(n + 1) * 8192;
#pragma unroll
      for (int i = 0; i < 4; ++i) {
        sw[i] = *(const u32x4*)(WNEG + o + (size_t)(tid + 256 * i) * 8);
        sk[i] = *(const u32x4*)(KDT + o + (size_t)(tid + 256 * i) * 8);
      }
#pragma unroll
      for (int i = 0; i < 8; ++i) un[i] = *(const uint2*)(UT + o + i * 1024);
      gln = GL[n + 1];
    }
    u16* hst = HST + (size_t)n * 16384;
    u16* vnt = VNT + (size_t)n * 8192;
#pragma unroll
    for (int m = 0; m < 4; ++m) {
      u32 pk[8];
#pragma unroll
      for (int r = 0; r < 8; ++r) pk[r] = pack2(S[m][2 * r], S[m][2 * r + 1]);
#pragma unroll
      for (int rg = 0; rg < 4; ++rg) *(uint2*)(hst + (4 * m + rg) * 1024) = make_uint2(pk[2 * rg], pk[2 * rg + 1]);
      u32x4 f0 = {pk[0], pk[1], pk[2], pk[3]}, f1 = {pk[4], pk[5], pk[6], pk[7]};
      const bf16x8 sf0 = __builtin_bit_cast(bf16x8, f0), sf1 = __builtin_bit_cast(bf16x8, f1);
#pragma unroll
      for (int tt = 0; tt < 2; ++tt) {
        bf16x8 a0 = *(const bf16x8*)(buf + (l31 * 272 + 16 * hh) + (tt * 8704 + 32 * (2 * m)));
        bf16x8 a1 = *(const bf16x8*)(buf + (l31 * 272 + 16 * hh) + (tt * 8704 + 32 * (2 * m + 1)));
        vn[tt] = MFMA32(a0, sf0, vn[tt]);
        vn[tt] = MFMA32(a1, sf1, vn[tt]);
      }
      __builtin_amdgcn_sched_barrier(0);
    }
    bf16x8 vf[4];
#pragma unroll
    for (int tt = 0; tt < 2; ++tt) {
      u32 pk[8];
#pragma unroll
      for (int r = 0; r < 8; ++r) pk[r] = pack2(vn[tt][2 * r], vn[tt][2 * r + 1]);
#pragma unroll
      for (int rg = 0; rg < 4; ++rg) *(uint2*)(vnt + (4 * tt + rg) * 1024) = make_uint2(pk[2 * rg], pk[2 * rg + 1]);
      u32x4 f0 = {pk[0], pk[1], pk[2], pk[3]}, f1 = {pk[4], pk[5], pk[6], pk[7]};
      vf[2 * tt] = __builtin_bit_cast(bf16x8, f0);
      vf[2 * tt + 1] = __builtin_bit_cast(bf16x8, f1);
    }
#pragma unroll
    for (int m = 0; m < 4; ++m) {
#pragma unroll
      for (int r = 0; r < 16; ++r) S[m][r] *= gl;
    }
#pragma unroll
    for (int ks = 0; ks < 4; ++ks) {
#pragma unroll
      for (int m = 0; m < 4; ++m) {
        bf16x8 a = *(const bf16x8*)(buf + 17408 + (l31 * 144 + 16 * hh) + (m * 4608 + 32 * ks));
        S[m] = MFMA32(a, vf[ks], S[m]);
      }
      __builtin_amdgcn_sched_barrier(0);
    }
    if (n + 1 < 64) {
#pragma unroll
      for (int i = 0; i < 4; ++i) { *(u32x4*)(nbuf + wbase + i * 4352) = sw[i]; *(u32x4*)(nbuf + kbase + i * 4608) = sk[i]; }
    }
    __syncthreads();
  }
}

DI void phase3(const Params& P, char* lds) {
  const int G = gridDim.x;
  const int nscan = G > 32 ? 16 : 0;
  int first = KB_SPLIT + (int)blockIdx.x - nscan, stride = G - nscan;
  if ((int)blockIdx.x < 16 || nscan == 0) {
    for (int bh = blockIdx.x; bh < 16; bh += G) ka2_scan(P, bh, lds);
    if (nscan) first = 4096;
  }
  if (nscan && (G & 3) == 0) {
    if ((int)blockIdx.x >= 16) {
      const int bb = blockIdx.x & 3;
      unsigned* ctr = (unsigned*)(P.ws + OFF_BAR) + 64 + 16 * bb;
      for (;;) {
        const int k = KB_SPLIT / 4 + pull_item(ctr, lds);
        if (k >= 1024) break;
        kb_item(P, 4 * k + bb, lds);
      }
    }
  } else {
    for (int it = first; it < 4096; it += stride) kb_item(P, it, lds);
  }
}

DI void phase4(const Params& P, char* lds) {
  const int tid4 = otid(), lane = tid4 & 63, wave = tid4 >> 6, l15 = lane & 15, g4 = lane >> 4;
  char* ws = P.ws;
  float nw[8];
#pragma unroll
  for (int nt = 0; nt < 8; ++nt) nw[nt] = P.a_out_norm_w[16 * nt + l15];
  for (int ch = blockIdx.x; ch < 1024; ch += gridDim.x) {
    const int b = ch >> 8, h = (ch >> 6) & 3, n = ch & 63;
    const int tok0 = b * 4096 + n * 64;
    const u16* QD = (const u16*)(ws + OFF_QD) + (size_t)ch * 8192;
    const u16* ATT = (const u16*)(ws + OFF_ATT) + (size_t)ch * 4096;
    const u16* HST = (const u16*)((const char*)P.out + OOFF_HST) + (size_t)ch * 16384;
    const u16* VNT = (const u16*)((const char*)P.out + OOFF_VNT) + (size_t)ch * 8192;
    __syncthreads();
    {
      u32x4 st[12];
#pragma unroll
      for (int i = 0; i < 8; ++i) st[i] = *(const u32x4*)(HST + (size_t)(tid4 + 256 * i) * 8);
#pragma unroll
      for (int i = 0; i < 4; ++i) st[8 + i] = *(const u32x4*)(VNT + (size_t)(tid4 + 256 * i) * 8);
#pragma unroll
      for (int i = 0; i < 8; ++i) *(u32x4*)(lds + (tid4 + 256 * i) * 16) = st[i];
#pragma unroll
      for (int i = 0; i < 4; ++i) *(u32x4*)(lds + 32768 + (tid4 + 256 * i) * 16) = st[8 + i];
    }
    __syncthreads();
    const u16* HSl = (const u16*)lds;
    const u16* VNl = (const u16*)(lds + 32768);
    f32x4 acc[8];
#pragma unroll
    for (int nt = 0; nt < 8; ++nt) acc[nt] = zero4();
#pragma unroll
    for (int ks = 0; ks < 4; ++ks) {
      bf16x8 a = *(const bf16x8*)(QD + (16 * wave + l15) * 128 + 32 * ks + 8 * g4);
#pragma unroll
      for (int nt = 0; nt < 8; ++nt) {
        bf16x8 bb = *(const bf16x8*)(HSl + (4 * ks + g4) * 1024 + (16 * nt + l15) * 8);
        acc[nt] = MFMA16(a, bb, acc[nt]);
      }
    }
#pragma unroll
    for (int ks = 0; ks < 2; ++ks) {
      bf16x8 a = *(const bf16x8*)(ATT + (16 * wave + l15) * 64 + 32 * ks + 8 * g4);
#pragma unroll
      for (int nt = 0; nt < 8; ++nt) {
        bf16x8 bb = *(const bf16x8*)(VNl + (4 * ks + g4) * 1024 + (16 * nt + l15) * 8);
        acc[nt] = MFMA16(a, bb, acc[nt]);
      }
    }
    float zg[4][8];
#pragma unroll
    for (int r = 0; r < 4; ++r) {
      const u16* az = (const u16*)(ws + OFF_AZ) + (size_t)(tok0 + 16 * wave + 4 * g4 + r) * 512 + h * 128;
#pragma unroll
      for (int nt = 0; nt < 8; ++nt) zg[r][nt] = bf2f(az[16 * nt + l15]);
    }
#pragma unroll
    for (int r = 0; r < 4; ++r) {
      float ss = 0.f;
#pragma unroll
      for (int nt = 0; nt < 8; ++nt) ss += acc[nt][r] * acc[nt][r];
      ss += __shfl_xor(ss, 1); ss += __shfl_xor(ss, 2); ss += __shfl_xor(ss, 4); ss += __shfl_xor(ss, 8);
      const float rs = rsqrtf(ss * (1.f / 128.f) + EPS);
      const int t = tok0 + 16 * wave + 4 * g4 + r;
      u16* mix = (u16*)(ws + OFF_MIXA) + (size_t)t * 512 + h * 128;
#pragma unroll
      for (int nt = 0; nt < 8; ++nt) {
        const int dv = 16 * nt + l15;
        mix[dv] = f2bf(acc[nt][r] * rs * nw[nt] * siluf_(zg[r][nt]));
      }
    }
  }
}

DI void phase5(const Params& P, char* lds) {
  char* ws = P.ws;
  const u16* MIXA = (const u16*)(ws + OFF_MIXA);
  const u16* MIXB = (const u16*)(ws + OFF_MIXB);
  const u16* WT = (const u16*)(ws + OFF_WT_OUT);
  float* X1 = (float*)(ws + OFF_X1);
  u16* X1B = (u16*)(ws + OFF_X1B);
  float* SS = (float*)(ws + OFF_SUMSQ);
  const int lane = otid() & 63, wave = otid() >> 6;
  const int wm = wave & 1, wn = wave >> 1, l31 = lane & 31, hh = lane >> 5;
  const bool xswz = (gridDim.x & 7) == 0;
  const int xq = blockIdx.x >> 3, xn = gridDim.x >> 3, xx = blockIdx.x & 7;
  for (int tile = xswz ? xq : (int)blockIdx.x; tile < (xswz ? 64 : 512); tile += (xswz ? xn : (int)gridDim.x)) {
    const int mt = xswz ? 8 * xx + (tile & 7) : (tile >> 3), nt = xswz ? (tile >> 3) : (tile & 7);
    f32x16 acc[4][2];
#pragma unroll
    for (int i = 0; i < 4; ++i)
#pragma unroll
      for (int j = 0; j < 2; ++j) acc[i][j] = zero16();
    gemm_mainloop<4>(MIXA, 512, WT, 1024, 512, mt * 256, nt * 128, lds, acc);
    gemm_mainloop<4>(MIXB, 512, WT + 512, 1024, 512, mt * 256, nt * 128, lds, acc);
    {
      const size_t e0 = (size_t)(mt * 256 + wm * 128 + 4 * hh) * 1024 + nt * 128 + wn * 64 + l31;
      float* ssp0 = SS + (mt * 256 + wm * 128 + 4 * hh);
#pragma unroll
      for (int i = 0; i < 4; ++i) {
        float xa[16], xb[16];
        {
          const float* xp = P.x + e0 + (size_t)i * 32 * 1024;
#pragma unroll
          for (int r = 0; r < 16; ++r) {
            xa[r] = xp[0]; xb[r] = xp[32];
            xp += (((r & 3) == 3) ? 5 : 1) * 1024;
            asm volatile("" : "+v"(xp));
          }
        }
        float* x1p = X1 + e0 + (size_t)i * 32 * 1024;
        u16* x1bp = X1B + e0 + (size_t)i * 32 * 1024;
        float* ssp = ssp0 + i * 32;
#pragma unroll
        for (int r = 0; r < 16; ++r) {
          const float va = xa[r] + acc[i][0][r], vb = xb[r] + acc[i][1][r];
          x1p[0] = va; x1p[32] = vb;
          x1bp[0] = f2bf(va); x1bp[32] = f2bf(vb);
          float ss = va * va + vb * vb;
          ss += dpp_xor1(ss); ss += dpp_xor2(ss); ss += __shfl_xor(ss, 4); ss += dpp_xor8(ss); ss += __shfl_xor(ss, 16);
          if (l31 == 0) atomicAdd(ssp, ss);
          const int step = ((r & 3) == 3) ? 5 : 1;
          x1p += step * 1024; x1bp += step * 1024; ssp += step;
          asm volatile("" : "+v"(x1p), "+v"(x1bp), "+v"(ssp));
        }
      }
    }
  }
}

DI void phase6(const Params& P, char* lds) {
  char* ws = P.ws;
  const u16* X1B = (const u16*)(ws + OFF_X1B);
  const float* X1 = (const float*)(ws + OFF_X1);
  const u16* WG = (const u16*)(ws + OFF_WT_GATE);
  const u16* WP = (const u16*)(ws + OFF_WT_PLE);
  const u16* PB = (const u16*)(ws + OFF_PB);
  const float* SS = (const float*)(ws + OFF_SUMSQ);
  const int lane = otid() & 63, wave = otid() >> 6;
  const int wm = wave & 1, wn = wave >> 1, l31 = lane & 31, hh = lane >> 5;
  const bool xswz = (gridDim.x & 7) == 0;
  const int xq = blockIdx.x >> 3, xn = gridDim.x >> 3, xx = blockIdx.x & 7;
  for (int tile = xswz ? xq : (int)blockIdx.x; tile < (xswz ? 128 : 1024); tile += (xswz ? xn : (int)gridDim.x)) {
    const int mt = xswz ? 16 * xx + (tile & 15) : (tile >> 3), nt = xswz ? (tile >> 4) : (tile & 7);
    f32x16 ag[2][2], ap[2][2];
#pragma unroll
    for (int i = 0; i < 2; ++i)
#pragma unroll
      for (int j = 0; j < 2; ++j) { ag[i][j] = zero16(); ap[i][j] = zero16(); }
    gemm_mainloop<2>(X1B, 1024, WG, 1024, 1024, mt * 128, nt * 128, lds, ag);
    gemm_mainloop<2>(PB, 256, WP, 256, 256, mt * 128, nt * 128, lds, ap);
    const size_t e0 = (size_t)(mt * 128 + wm * 64 + 4 * hh) * 1024 + nt * 128 + wn * 64 + l31;
    const float b0 = P.b_ple_gate[nt * 128 + wn * 64 + l31], b1 = P.b_ple_gate[nt * 128 + wn * 64 + 32 + l31];
    const float* ssp0 = SS + (mt * 128 + wm * 64 + 4 * hh);
#pragma unroll
    for (int i = 0; i < 2; ++i) {
      float rsv[16], xa[16], xb[16];
#pragma unroll
      for (int r = 0; r < 16; ++r) rsv[r] = ssp0[i * 32 + (r & 3) + 8 * (r >> 2)];
      {
        const float* x1p = X1 + e0 + (size_t)i * 32 * 1024;
#pragma unroll
        for (int r = 0; r < 16; ++r) {
          xa[r] = x1p[0]; xb[r] = x1p[32];
          x1p += (((r & 3) == 3) ? 5 : 1) * 1024;
          asm volatile("" : "+v"(x1p));
        }
      }
      float* op = P.out + e0 + (size_t)i * 32 * 1024;
#pragma unroll
      for (int r = 0; r < 16; ++r) {
        const float rs = rsqrtf(rsv[r] * (1.f / 1024.f) + EPS);
        op[0] = xa[r] + ap[i][0][r] * sigmoidf_(rs * ag[i][0][r] + b0);
        op[32] = xb[r] + ap[i][1][r] * sigmoidf_(rs * ag[i][1][r] + b1);
        op += (((r & 3) == 3) ? 5 : 1) * 1024;
        asm volatile("" : "+v"(op));
      }
    }
  }
}

template <int PH>
DI void run_phase(const Params& P, char* lds) {
  if (PH == 0) phase0(P);
  else if (PH == 1) phase1(P, lds);
  else if (PH == 2) phase2(P, lds);
  else if (PH == 3) phase3(P, lds);
  else if (PH == 4) phase4(P, lds);
  else if (PH == 5) phase5(P, lds);
  else phase6(P, lds);
}

template <int PH>
__global__ void __launch_bounds__(256, 2) phase_kernel(Params P) {
  __shared__ __attribute__((aligned(16))) char lds[LDS_BYTES];
  run_phase<PH>(P, lds);
}

__global__ void __launch_bounds__(256, 2) mega(Params P) {
  __shared__ __attribute__((aligned(16))) char lds[LDS_BYTES];
  volatile LAS unsigned* st = (volatile LAS unsigned*)(lds + LDS_BYTES - 16);
  if (threadIdx.x == 0) { st[0] = 0u; st[1] = 0u; }
  __syncthreads();
  if (P.ws == nullptr) cg::this_grid().sync();
  XcdBarrier xb = xcd_barrier_post((unsigned*)(P.ws + OFF_BAR), st);
  run_phase<0>(P, lds); xcd_barrier(xb);
  run_phase<1>(P, lds); xcd_barrier(xb);
  run_phase<2>(P, lds); xcd_barrier(xb);
  run_phase<3>(P, lds); xcd_barrier(xb);
  run_phase<4>(P, lds); xcd_barrier(xb);
  run_phase<5>(P, lds); xcd_barrier(xb);
  run_phase<6>(P, lds);
}

extern "C" void kernel_launch(void* const* d_in, const int* in_sizes, int n_in, void* d_out, int out_size, void* d_ws,
                              size_t ws_size, hipStream_t stream) {
  Params P{};
  P.x = (const float*)d_in[0]; P.p = (const float*)d_in[1]; P.attn_norm_w = (const float*)d_in[2];
  P.w_in = (const float*)d_in[3]; P.conv_w = (const float*)d_in[4]; P.a_log = (const float*)d_in[5];
  P.dt_bias = (const float*)d_in[6]; P.a_out_norm_w = (const float*)d_in[7]; P.b_q_norm_w = (const float*)d_in[8];
  P.b_k_norm_w = (const float*)d_in[9]; P.w_out = (const float*)d_in[10]; P.w_ple = (const float*)d_in[11];
  P.ple_gate_norm_w = (const float*)d_in[12]; P.w_ple_gate = (const float*)d_in[13]; P.b_ple_gate = (const float*)d_in[14];
  P.out = (float*)d_out; P.ws = (char*)d_ws;
  static int grid_blocks = 0;
  if (!grid_blocks) {
    int dev = 0, cus = 0, per_cu = 0;
    (void)hipGetDevice(&dev);
    (void)hipDeviceGetAttribute(&cus, hipDeviceAttributeMultiprocessorCount, dev);
    (void)hipOccupancyMaxActiveBlocksPerMultiprocessor(&per_cu, mega, 256, 0);
    if (per_cu > 2) per_cu = 2;
    if (per_cu < 1) per_cu = 1;
    grid_blocks = cus * per_cu;
  }
#ifdef MULTI_LAUNCH
  hipLaunchKernelGGL(phase_kernel<0>, dim3(grid_blocks), dim3(256), 0, stream, P);
  hipLaunchKernelGGL(phase_kernel<1>, dim3(grid_blocks), dim3(256), 0, stream, P);
  hipLaunchKernelGGL(phase_kernel<2>, dim3(grid_blocks), dim3(256), 0, stream, P);
  hipLaunchKernelGGL(phase_kernel<3>, dim3(grid_blocks), dim3(256), 0, stream, P);
  hipLaunchKernelGGL(phase_kernel<4>, dim3(grid_blocks), dim3(256), 0, stream, P);
  hipLaunchKernelGGL(phase_kernel<5>, dim3(grid_blocks), dim3(256), 0, stream, P);
  hipLaunchKernelGGL(phase_kernel<6>, dim3(grid_blocks), dim3(256), 0, stream, P);
#else
  (void)hipMemsetAsync((char*)d_ws + OFF_BAR, 0, XCD_BAR_WORDS * 4, stream);
  void* args[] = {&P};
  hipError_t e = hipLaunchCooperativeKernel((void*)mega, dim3(grid_blocks), dim3(256), args, 0, stream);
  if (e != hipSuccess) fprintf(stderr, "cooperative launch failed: %s (grid %d)\n", hipGetErrorString(e), grid_blocks);
#endif
}
```

```cpp
#include <hip/hip_runtime.h>
#include <hip/hip_cooperative_groups.h>
#include <cstdio>
namespace cg = cooperative_groups;

typedef unsigned short u16;
typedef unsigned int u32;
typedef unsigned long long u64;
using bf16x8 = __attribute__((ext_vector_type(8))) short;
using f32x16 = __attribute__((ext_vector_type(16))) float;
using f32x4 = __attribute__((ext_vector_type(4))) float;
using u32x4 = __attribute__((ext_vector_type(4))) unsigned;
#define DI __device__ __forceinline__
#define MFMA32(a, b, c) __builtin_amdgcn_mfma_f32_32x32x16_bf16((a), (b), (c), 0, 0, 0)
#define MFMA16(a, b, c) __builtin_amdgcn_mfma_f32_16x16x32_bf16((a), (b), (c), 0, 0, 0)

constexpr int T_ = 16384;
constexpr float EPS = 1e-6f;

constexpr size_t OFF_WT_IN = 0;
constexpr size_t OFF_WT_OUT = OFF_WT_IN + (size_t)4608 * 1024 * 2;
constexpr size_t OFF_WT_GATE = OFF_WT_OUT + (size_t)1024 * 1024 * 2;
constexpr size_t OFF_WT_PLE = OFF_WT_GATE + (size_t)1024 * 1024 * 2;
constexpr size_t OFF_PB = OFF_WT_PLE + (size_t)1024 * 256 * 2;
constexpr size_t OFF_SUMSQ = OFF_PB + (size_t)T_ * 256 * 2;
constexpr size_t OFF_QKV = OFF_SUMSQ + (size_t)T_ * 4;
constexpr size_t OFF_MIXA = OFF_QKV;
constexpr size_t OFF_AZ = OFF_QKV + (size_t)T_ * 1536 * 2;
constexpr size_t OFF_BQ = OFF_AZ + (size_t)T_ * 512 * 2;
constexpr size_t OFF_BKV = OFF_BQ + (size_t)T_ * 512 * 2;
constexpr size_t OFF_BZ = OFF_BKV + (size_t)T_ * 256 * 2;
constexpr size_t OFF_IQ = OFF_BZ + (size_t)T_ * 512 * 2;
constexpr size_t OFF_IK = OFF_IQ + (size_t)T_ * 1024 * 2;
constexpr size_t OFF_SMALL = OFF_IK + (size_t)T_ * 128 * 2;
constexpr size_t OFF_H = OFF_SMALL + (size_t)T_ * 16 * 4;
constexpr size_t OFF_WNEG = OFF_H;
constexpr size_t OFF_KDT = OFF_WNEG + (size_t)1024 * 8192 * 2;
constexpr size_t OFF_UT = OFF_H + (size_t)T_ * 1024 * 2;
constexpr size_t OFF_QD = OFF_UT + (size_t)1024 * 8192 * 2;
constexpr size_t OFF_ATT = OFF_QD + (size_t)1024 * 8192 * 2;
constexpr size_t OFF_GL = OFF_ATT + (size_t)1024 * 4096 * 2;
constexpr size_t OFF_BAR = OFF_GL + 4096;
constexpr size_t OFF_MIXB = OFF_BAR + 16384;
constexpr size_t WS_END = OFF_MIXB + (size_t)T_ * 512 * 2;
constexpr size_t OFF_X1 = OFF_AZ;
constexpr size_t OFF_X1B = OFF_X1 + (size_t)T_ * 1024 * 4;
static_assert(OFF_X1B + (size_t)T_ * 1024 * 2 <= OFF_UT, "x1 alias overlaps live data");
static_assert(WS_END <= (size_t)256 * 1024 * 1024, "ws too small");
constexpr size_t OOFF_HST = 0;
constexpr size_t OOFF_VNT = OOFF_HST + (size_t)1024 * 16384 * 2;
constexpr size_t OOFF_IDX = OOFF_VNT + (size_t)1024 * 8192 * 2;
static_assert(OOFF_IDX + (size_t)T_ * 256 * 2 <= (size_t)T_ * 1024 * 4, "d_out scratch");

constexpr int LDS_BYTES = 72 * 1024;

struct Params {
  const float *x, *p, *attn_norm_w, *w_in, *conv_w, *a_log, *dt_bias, *a_out_norm_w, *b_q_norm_w, *b_k_norm_w,
      *w_out, *w_ple, *ple_gate_norm_w, *w_ple_gate, *b_ple_gate;
  float* out;
  char* ws;
};

DI int otid() { int t = threadIdx.x; asm volatile("" : "+v"(t)); return t; }
DI float dpp_xor1(float v) { return __int_as_float(__builtin_amdgcn_update_dpp(0, __float_as_int(v), 0xB1, 0xF, 0xF, true)); }
DI float dpp_xor2(float v) { return __int_as_float(__builtin_amdgcn_update_dpp(0, __float_as_int(v), 0x4E, 0xF, 0xF, true)); }
DI float dpp_xor8(float v) { return __int_as_float(__builtin_amdgcn_update_dpp(0, __float_as_int(v), 0x128, 0xF, 0xF, true)); }
DI u16 f2bf(float x) { u32 u = __float_as_uint(x); u += 0x7fffu + ((u >> 16) & 1u); return (u16)(u >> 16); }
DI float bf2f(u16 v) { return __uint_as_float(((u32)v) << 16); }
DI u32 pack2(float a, float b) { return (u32)f2bf(a) | ((u32)f2bf(b) << 16); }
DI float bflo(u32 v) { return __uint_as_float(v << 16); }
DI float bfhi(u32 v) { return __uint_as_float(v & 0xffff0000u); }
DI float sigmoidf_(float x) { return 1.f / (1.f + __expf(-x)); }
DI float siluf_(float x) { return x / (1.f + __expf(-x)); }
DI f32x16 zero16() { f32x16 z; for (int i = 0; i < 16; ++i) z[i] = 0.f; return z; }
DI f32x4 zero4() { f32x4 z; for (int i = 0; i < 4; ++i) z[i] = 0.f; return z; }


#define XB_TMO      128
#define XB_XCNT(j)  (256  + 64 * (j))
#define XB_XSUB(j)  (1280 + 64 * (j))
#define XB_XGEN(j)  (2304 + 64 * (j))
#define XB_TOP      3328
#define XB_TOPGEN   3392
#define XCD_BAR_WORDS 3456
#define XB_SPIN_CAP (1u << 22)
#define LAS __attribute__((address_space(3)))
DI unsigned xb_ld(unsigned* p) { return __hip_atomic_load(p, __ATOMIC_RELAXED, __HIP_MEMORY_SCOPE_AGENT); }
DI unsigned xb_add(unsigned* p, unsigned v) { return __hip_atomic_fetch_add(p, v, __ATOMIC_RELAXED, __HIP_MEMORY_SCOPE_AGENT); }
DI unsigned xb_xcc_id() { return (unsigned)__builtin_amdgcn_s_getreg((3 << 11) | 20) & 0xFu; }
#define XB_SPIN(cond, bar) do { unsigned _sp = 0; while (cond) { __builtin_amdgcn_s_sleep(1); \
    if ((++_sp & 255u) == 0u) { if (xb_ld(&(bar)[XB_TMO])) break; if (_sp > XB_SPIN_CAP) { atomicAdd(&(bar)[XB_TMO], 1u); break; } } } } while (0)
struct XcdBarrier { unsigned* bar; unsigned x; volatile LAS unsigned* st; };
DI XcdBarrier xcd_barrier_post(unsigned* bar, volatile LAS unsigned* st) {
  XcdBarrier b; b.bar = bar; b.x = xb_xcc_id(); b.st = st;
  if (threadIdx.x == 0) (void)xb_add(&bar[XB_XCNT(b.x)], 1u);
  return b;
}
DI void xcd_barrier_complete(unsigned* bar, unsigned x, unsigned& nloc, unsigned& nx) {
  const unsigned G = gridDim.x * gridDim.y * gridDim.z;
  unsigned sum, cnt, mine, sp = 0u;
  for (;;) {
    sum = 0u; cnt = 0u; mine = 0u;
#pragma unroll
    for (unsigned j = 0; j < 16; ++j) { const unsigned c = xb_ld(&bar[XB_XCNT(j)]); sum += c; cnt += (c > 0u) ? 1u : 0u; mine = (j == x) ? c : mine; }
    if (sum == G) break;
    __builtin_amdgcn_s_sleep(1);
    if ((++sp & 255u) == 0u) { if (xb_ld(&bar[XB_TMO])) break; if (sp > XB_SPIN_CAP) { atomicAdd(&bar[XB_TMO], 1u); break; } }
  }
  nloc = mine > 0u ? mine : 1u; nx = cnt > 0u ? cnt : 1u;
}
DI void xcd_barrier(const XcdBarrier& b) {
  asm volatile("s_waitcnt vmcnt(0)" ::: "memory");
  __syncthreads();
  if (threadIdx.x == 0) {
    unsigned* bar = b.bar;
    __builtin_amdgcn_s_waitcnt(0);
    unsigned nloc = b.st[0], nx = b.st[1];
    if (nloc == 0u) { xcd_barrier_complete(bar, b.x, nloc, nx); b.st[0] = nloc; b.st[1] = nx; }
    const unsigned old = xb_add(&bar[XB_XSUB(b.x)], 1u);
    const unsigned gen = old / nloc;
    if (old + 1u == (gen + 1u) * nloc) {
      __builtin_amdgcn_fence(__ATOMIC_RELEASE, "agent");
      asm volatile("s_waitcnt vmcnt(0)" ::: "memory");
      const unsigned og = xb_add(&bar[XB_TOP], 1u);
      const unsigned tg = og / nx;
      if (og + 1u == (tg + 1u) * nx) xb_add(&bar[XB_TOPGEN], 1u);
      else XB_SPIN(xb_ld(&bar[XB_TOPGEN]) == tg, bar);
      __builtin_amdgcn_fence(__ATOMIC_ACQUIRE, "agent");
      xb_add(&bar[XB_XGEN(b.x)], 1u);
      asm volatile("s_waitcnt vmcnt(0)" ::: "memory");
    } else {
      XB_SPIN(xb_ld(&bar[XB_XGEN(b.x)]) == gen, bar);
      __builtin_amdgcn_fence(__ATOMIC_ACQUIRE, "agent");
      asm volatile("s_waitcnt vmcnt(0)" ::: "memory");
    }
  }
  __syncthreads();
}

template <bool SCALE>
DI void transpose_w(const float* __restrict__ W, int ldw, int K, int NP, int NV, u16* __restrict__ wt,
                    const float* __restrict__ scale, bool remap, size_t gtid, size_t gsz) {
  const int kchunks = K / 8;
  for (size_t it = gtid; it < (size_t)NP * kchunks; it += gsz) {
    int j = (int)(it % NP), kc = (int)(it / NP);
    uint4 o = make_uint4(0, 0, 0, 0);
    if (j < NV) {
      int src = j;
      if (remap) src = j < 2048 ? j : (j < 4480 ? j + 8 : (j < 4488 ? 2048 + (j - 4480) : j));
      float v[8];
#pragma unroll
      for (int i = 0; i < 8; ++i) {
        v[i] = W[(size_t)(kc * 8 + i) * ldw + src];
        if (SCALE) v[i] *= scale[kc * 8 + i];
      }
      o.x = pack2(v[0], v[1]); o.y = pack2(v[2], v[3]); o.z = pack2(v[4], v[5]); o.w = pack2(v[6], v[7]);
    }
    *(uint4*)(wt + (size_t)j * K + kc * 8) = o;
  }
}

DI void phase0(const Params& P) {
  const int tid = otid(), lane = tid & 63, wave = tid >> 6;
  const size_t gtid = (size_t)blockIdx.x * 256 + tid, gsz = (size_t)gridDim.x * 256;
  char* ws = P.ws;
  transpose_w<false>(P.w_in, 4496, 1024, 4608, 4496, (u16*)(ws + OFF_WT_IN), nullptr, true, gtid, gsz);
  transpose_w<false>(P.w_out, 1024, 1024, 1024, 1024, (u16*)(ws + OFF_WT_OUT), nullptr, false, gtid, gsz);
  transpose_w<true>(P.w_ple_gate, 1024, 1024, 1024, 1024, (u16*)(ws + OFF_WT_GATE), P.ple_gate_norm_w, false, gtid, gsz);
  transpose_w<false>(P.w_ple, 1024, 256, 1024, 1024, (u16*)(ws + OFF_WT_PLE), nullptr, false, gtid, gsz);
  {
    u16* pb = (u16*)(ws + OFF_PB);
    for (size_t it = gtid; it < (size_t)T_ * 256 / 8; it += gsz) {
      float4 a = *(const float4*)(P.p + it * 8), b = *(const float4*)(P.p + it * 8 + 4);
      uint4 o; o.x = pack2(a.x, a.y); o.y = pack2(a.z, a.w); o.z = pack2(b.x, b.y); o.w = pack2(b.z, b.w);
      *(uint4*)(pb + it * 8) = o;
    }
  }
  {
    float* ss = (float*)(ws + OFF_SUMSQ);
    for (size_t it = gtid; it < (size_t)T_; it += gsz) ss[it] = 0.f;
  }
  {
    u16* H = (u16*)(ws + OFF_H);
    const int gw = blockIdx.x * 4 + wave, nw = gridDim.x * 4;
    for (int row0 = gw * 4; row0 < T_; row0 += nw * 4) {
      float4 v[4][4];
#pragma unroll
      for (int rr = 0; rr < 4; ++rr)
#pragma unroll
        for (int i = 0; i < 4; ++i) v[rr][i] = *(const float4*)(P.x + (size_t)(row0 + rr) * 1024 + lane * 4 + 256 * i);
      float4 g[4];
#pragma unroll
      for (int i = 0; i < 4; ++i) g[i] = *(const float4*)(P.attn_norm_w + lane * 4 + 256 * i);
#pragma unroll
      for (int rr = 0; rr < 4; ++rr) {
        float ss = 0.f;
#pragma unroll
        for (int i = 0; i < 4; ++i) ss += v[rr][i].x * v[rr][i].x + v[rr][i].y * v[rr][i].y + v[rr][i].z * v[rr][i].z + v[rr][i].w * v[rr][i].w;
#pragma unroll
        for (int d = 1; d < 64; d <<= 1) ss += __shfl_xor(ss, d);
        const float r = rsqrtf(ss * (1.f / 1024.f) + EPS);
#pragma unroll
        for (int i = 0; i < 4; ++i) {
          uint2 o; o.x = pack2(v[rr][i].x * r * g[i].x, v[rr][i].y * r * g[i].y); o.y = pack2(v[rr][i].z * r * g[i].z, v[rr][i].w * r * g[i].w);
          *(uint2*)(H + (size_t)(row0 + rr) * 1024 + lane * 4 + 256 * i) = o;
        }
      }
    }
  }
}

template <int MT>
DI void gemm_mainloop(const u16* __restrict__ A, int lda, const u16* __restrict__ Bt, int ldb, int K, int m0, int n0,
                      char* lds, f32x16 (&acc)[MT][2]) {
  const int tid = otid(), lane = tid & 63, wave = tid >> 6;
  const int wm = wave & 1, wn = wave >> 1, l31 = lane & 31, hh = lane >> 5;
  constexpr int BM = 64 * MT;
  char* ldsA = lds;
  char* ldsB = lds + BM * 128;
  const int lrow = tid >> 3, kc = tid & 7;
  const u16* ga = A + (size_t)(m0 + lrow) * lda + kc * 8;
  const u16* gb = Bt + (size_t)(n0 + lrow) * ldb + kc * 8;
  u32x4 ra[2 * MT], rb[4];
#pragma unroll
  for (int i = 0; i < 2 * MT; ++i) ra[i] = *(const u32x4*)(ga + (size_t)(32 * i) * lda);
#pragma unroll
  for (int i = 0; i < 4; ++i) rb[i] = *(const u32x4*)(gb + (size_t)(32 * i) * ldb);
  const int woff = lrow * 128 + ((kc ^ ((lrow >> 1) & 7)) << 4);
  const int nk = K >> 6;
  for (int kt = 0; kt < nk; ++kt) {
    __syncthreads();
#pragma unroll
    for (int i = 0; i < 2 * MT; ++i) *(u32x4*)(ldsA + woff + i * 4096) = ra[i];
#pragma unroll
    for (int i = 0; i < 4; ++i) *(u32x4*)(ldsB + woff + i * 4096) = rb[i];
    __syncthreads();
    if (kt + 1 < nk) {
#pragma unroll
      for (int i = 0; i < 2 * MT; ++i) ra[i] = *(const u32x4*)(ga + (size_t)(32 * i) * lda + (kt + 1) * 64);
#pragma unroll
      for (int i = 0; i < 4; ++i) rb[i] = *(const u32x4*)(gb + (size_t)(32 * i) * ldb + (kt + 1) * 64);
    }
#pragma unroll
    for (int s = 0; s < 4; ++s) {
      bf16x8 af[MT], bfr[2];
      const int c = 2 * s + hh;
#pragma unroll
      for (int i = 0; i < MT; ++i) {
        int row = wm * (32 * MT) + i * 32 + l31;
        af[i] = *(const bf16x8*)(ldsA + row * 128 + ((c ^ ((row >> 1) & 7)) << 4));
      }
#pragma unroll
      for (int j = 0; j < 2; ++j) {
        int rowb = wn * 64 + j * 32 + l31;
        bfr[j] = *(const bf16x8*)(ldsB + rowb * 128 + ((c ^ ((rowb >> 1) & 7)) << 4));
      }
#pragma unroll
      for (int i = 0; i < MT; ++i)
#pragma unroll
        for (int j = 0; j < 2; ++j) acc[i][j] = MFMA32(af[i], bfr[j], acc[i][j]);
    }
  }
}

DI void phase1(const Params& P, char* lds) {
  char* ws = P.ws;
  const u16* H = (const u16*)(ws + OFF_H);
  const u16* WT = (const u16*)(ws + OFF_WT_IN);
  const int lane = otid() & 63, wave = otid() >> 6;
  const int wm = wave & 1, wn = wave >> 1, l31 = lane & 31, hh = lane >> 5;
  const bool xswz = (gridDim.x & 7) == 0;
  const int xq = blockIdx.x >> 3, xn = gridDim.x >> 3, xx = blockIdx.x & 7;
  for (int tile = xswz ? xq : (int)blockIdx.x; tile < (xswz ? 8 * 36 : 64 * 36); tile += (xswz ? xn : (int)gridDim.x)) {
    const int mt = xswz ? 8 * xx + (tile & 7) : tile / 36, nt = xswz ? (tile >> 3) : tile % 36;
    f32x16 acc[4][2];
#pragma unroll
    for (int i = 0; i < 4; ++i)
#pragma unroll
      for (int j = 0; j < 2; ++j) acc[i][j] = zero16();
    gemm_mainloop<4>(H, 1024, WT, 1024, 1024, mt * 256, nt * 128, lds, acc);
    const int n0 = nt * 128;
    if (n0 < 4480) {
      u16* base; int ld, c0;
      if (n0 < 1536) { base = (u16*)(ws + OFF_QKV); ld = 1536; c0 = n0; }
      else if (n0 < 2048) { base = (u16*)(ws + OFF_AZ); ld = 512; c0 = n0 - 1536; }
      else if (n0 < 2560) { base = (u16*)(ws + OFF_BQ); ld = 512; c0 = n0 - 2048; }
      else if (n0 < 2816) { base = (u16*)(ws + OFF_BKV); ld = 256; c0 = n0 - 2560; }
      else if (n0 < 3328) { base = (u16*)(ws + OFF_BZ); ld = 512; c0 = n0 - 2816; }
      else if (n0 < 4352) { base = (u16*)(ws + OFF_IQ); ld = 1024; c0 = n0 - 3328; }
      else { base = (u16*)(ws + OFF_IK); ld = 128; c0 = n0 - 4352; }
      const bool qn = (n0 >= 2048 && n0 < 2560), kn = (n0 == 2560);
      float w0 = 1.f, w1 = 1.f;
      if (qn) { w0 = P.b_q_norm_w[l31] * 0.125f; w1 = P.b_q_norm_w[32 + l31] * 0.125f; }
      if (kn) { w0 = P.b_k_norm_w[l31]; w1 = P.b_k_norm_w[32 + l31]; }
      const int rowbase = mt * 256 + wm * 128;
      char* p0; int rs, ts, c1;
      if (n0 == 4352) {
        const int ca = wn * 64 + l31;
        p0 = (char*)base + (size_t)(rowbase >> 5) * 8192 + hh * 64 + ((ca >> 4) * 512 + ((ca >> 3) & 1) * 256 + (ca & 7)) * 2;
        rs = 16; ts = 8192; c1 = 2048;
      } else {
        p0 = (char*)base + ((size_t)(rowbase + 4 * hh) * ld + c0 + wn * 64 + l31) * 2;
        rs = ld * 2; ts = 64 * ld; c1 = 64;
      }
#pragma unroll
      for (int i = 0; i < 4; ++i) {
        char* pr = p0 + (size_t)i * ts;
#pragma unroll
        for (int r = 0; r < 16; ++r) {
          float v0 = acc[i][0][r], v1 = acc[i][1][r];
          if (qn || kn) {
            float ss = v0 * v0 + v1 * v1;
            ss += dpp_xor1(ss); ss += dpp_xor2(ss); ss += __shfl_xor(ss, 4); ss += dpp_xor8(ss); ss += __shfl_xor(ss, 16);
            const float rsq = rsqrtf(ss * (1.f / 64.f) + EPS);
            v0 *= rsq * w0; v1 *= rsq * w1;
          }
          *(u16*)pr = f2bf(v0);
          *(u16*)(pr + c1) = f2bf(v1);
          pr += ((r & 3) == 3) ? 5 * rs : rs;
          asm volatile("" : "+v"(pr));
        }
      }
    } else {
      if (wn == 0 && l31 < 16) {
        float* sp = (float*)(ws + OFF_SMALL) + (size_t)(mt * 256 + wm * 128 + 4 * hh) * 16 + l31;
#pragma unroll
        for (int i = 0; i < 4; ++i)
#pragma unroll
          for (int r = 0; r < 16; ++r) {
            *sp = acc[i][0][r];
            sp += ((r & 3) == 3) ? 5 * 16 : 16;
            asm volatile("" : "+v"(sp));
          }
      }
    }
  }
}

DI void knorm_all(const Params& P) {
  const int lane = otid() & 63, wave = otid() >> 6;
  u32* BKV = (u32*)(P.ws + OFF_BKV);
  const int gw = blockIdx.x * 4 + wave, nw = gridDim.x * 4;
  const float w0 = P.b_k_norm_w[(2 * lane) & 63], w1 = P.b_k_norm_w[(2 * lane + 1) & 63];
  for (int tok = gw; tok < T_; tok += nw) {
    u32 v = BKV[(size_t)tok * 128 + lane];
    float a = bflo(v), b = bfhi(v);
    float ss = a * a + b * b;
#pragma unroll
    for (int d = 1; d < 32; d <<= 1) ss += __shfl_xor(ss, d);
    float r = rsqrtf(ss * (1.f / 64.f) + EPS);
    BKV[(size_t)tok * 128 + lane] = pack2(a * r * w0, b * r * w1);
  }
}

DI int perm16(int x) { return (x & 3) | ((x & 8) >> 1) | ((x & 4) << 1); }

DI void ka1_item(const Params& P, int ch, char* lds) {
  const int tid = otid(), lane = tid & 63, wave = tid >> 6, hh = lane >> 5, l31 = lane & 31;
  const int b = ch >> 8, h = (ch >> 6) & 3, n = ch & 63;
  const int tok0 = b * 4096 + n * 64;
  char* ws = P.ws;
  u16* QV = (u16*)lds;
  u16* Ks = (u16*)(lds + 18432);
  u16* KBT = (u16*)(lds + 18432 + 17408);
  float* Am = (float*)(lds + 18432 + 17408 + 18432);
  u16* Tm = Ks;
  float* sm = (float*)(lds + 18432 + 17408 + 18432 + 16384);
  const u16* QKV = (const u16*)(ws + OFF_QKV);
  const float* SMALL = (const float*)(ws + OFF_SMALL);
  u16* QD = (u16*)(ws + OFF_QD) + (size_t)ch * 8192;
  u16* ATT = (u16*)(ws + OFF_ATT) + (size_t)ch * 4096;
  u16* KDT = (u16*)(ws + OFF_KDT) + (size_t)ch * 8192;
  u16* WNEG = (u16*)(ws + OFF_WNEG) + (size_t)ch * 8192;
  u16* UT = (u16*)(ws + OFF_UT) + (size_t)ch * 8192;
  __syncthreads();
  if (wave == 0) {
    float ab = SMALL[(size_t)(tok0 + lane) * 16 + h];
    float aa = SMALL[(size_t)(tok0 + lane) * 16 + 4 + h];
    float beta = sigmoidf_(ab);
    float xs = aa + P.dt_bias[h];
    float sp = fmaxf(xs, 0.f) + log1pf(__expf(-fabsf(xs)));
    float g = -__expf(P.a_log[h]) * sp;
#pragma unroll
    for (int d = 1; d < 64; d <<= 1) { float t = __shfl_up(g, d); if (lane >= d) g += t; }
    float glast = __shfl(g, 63);
    sm[lane] = g; sm[64 + lane] = beta; sm[128 + lane] = __expf(g); sm[192 + lane] = __expf(glast - g);
  }
  __syncthreads();
  const float* cw = P.conv_w;
  {
    const int cq = h * 128 + 2 * lane, ck = 512 + cq;
    float wq[4][2], wk[4][2];
#pragma unroll
    for (int j = 0; j < 4; ++j) {
      wq[j][0] = cw[j * 1536 + cq]; wq[j][1] = cw[j * 1536 + cq + 1];
      wk[j][0] = cw[j * 1536 + ck]; wk[j][1] = cw[j * 1536 + ck + 1];
    }
    const int i0 = wave * 16;
    float xq[3][2], xk[3][2];
#pragma unroll
    for (int j = 0; j < 3; ++j) {
      int pos = n * 64 + i0 - 3 + j;
      u32 vq = 0, vk = 0;
      if (pos >= 0) {
        const u16* rp = QKV + (size_t)(tok0 + i0 - 3 + j) * 1536;
        vq = *(const u32*)(rp + cq); vk = *(const u32*)(rp + ck);
      }
      xq[j][0] = bflo(vq); xq[j][1] = bfhi(vq); xk[j][0] = bflo(vk); xk[j][1] = bfhi(vk);
    }
    u32 rq_[16], rk_[16];
#pragma unroll
    for (int ii = 0; ii < 16; ++ii) {
      const u16* rp = QKV + (size_t)(tok0 + i0 + ii) * 1536;
      rq_[ii] = *(const u32*)(rp + cq); rk_[ii] = *(const u32*)(rp + ck);
    }
#pragma unroll
    for (int ii = 0; ii < 16; ++ii) {
      const int i = i0 + ii;
      const u32 vq = rq_[ii], vk = rk_[ii];
      float cq0 = bflo(vq), cq1 = bfhi(vq), ck0 = bflo(vk), ck1 = bfhi(vk);
      float yq0 = wq[0][0] * xq[0][0] + wq[1][0] * xq[1][0] + wq[2][0] * xq[2][0] + wq[3][0] * cq0;
      float yq1 = wq[0][1] * xq[0][1] + wq[1][1] * xq[1][1] + wq[2][1] * xq[2][1] + wq[3][1] * cq1;
      float yk0 = wk[0][0] * xk[0][0] + wk[1][0] * xk[1][0] + wk[2][0] * xk[2][0] + wk[3][0] * ck0;
      float yk1 = wk[0][1] * xk[0][1] + wk[1][1] * xk[1][1] + wk[2][1] * xk[2][1] + wk[3][1] * ck1;
      xq[0][0] = xq[1][0]; xq[0][1] = xq[1][1]; xq[1][0] = xq[2][0]; xq[1][1] = xq[2][1]; xq[2][0] = cq0; xq[2][1] = cq1;
      xk[0][0] = xk[1][0]; xk[0][1] = xk[1][1]; xk[1][0] = xk[2][0]; xk[1][1] = xk[2][1]; xk[2][0] = ck0; xk[2][1] = ck1;
      yq0 = siluf_(yq0); yq1 = siluf_(yq1); yk0 = siluf_(yk0); yk1 = siluf_(yk1);
      float sq = yq0 * yq0 + yq1 * yq1, sk = yk0 * yk0 + yk1 * yk1;
      sq += dpp_xor1(sq); sk += dpp_xor1(sk);
      sq += dpp_xor2(sq); sk += dpp_xor2(sk);
      sq += __shfl_xor(sq, 4); sk += __shfl_xor(sk, 4);
      sq += dpp_xor8(sq); sk += dpp_xor8(sk);
      sq += __shfl_xor(sq, 16); sk += __shfl_xor(sk, 16);
      sq += __shfl_xor(sq, 32); sk += __shfl_xor(sk, 32);
      const float rq = rsqrtf(sq + EPS) * 0.08838834764831845f, rk = rsqrtf(sk + EPS);
      yq0 *= rq; yq1 *= rq; yk0 *= rk; yk1 *= rk;
      *(u32*)(QV + i * 136 + 2 * lane) = pack2(yq0, yq1);
      *(u32*)(Ks + i * 136 + 2 * lane) = pack2(yk0, yk1);
      KBT[(2 * lane) * 72 + i] = f2bf(yk0);
      KBT[(2 * lane + 1) * 72 + i] = f2bf(yk1);
      const float eg = sm[128 + i];
      *(u32*)(QD + i * 128 + 2 * lane) = pack2(yq0 * eg, yq1 * eg);
    }
  }
  __syncthreads();
  {
    const int mt = wave & 1, nt = wave >> 1;
    f32x16 akk = zero16(), aqk = zero16();
#pragma unroll
    for (int s = 0; s < 8; ++s) {
      const int kof = 16 * s + 8 * hh;
      bf16x8 aq = *(const bf16x8*)(QV + (32 * mt + l31) * 136 + kof);
      bf16x8 ak = *(const bf16x8*)(Ks + (32 * mt + l31) * 136 + kof);
      bf16x8 bk = *(const bf16x8*)(Ks + (32 * nt + l31) * 136 + kof);
      akk = MFMA32(ak, bk, akk);
      aqk = MFMA32(aq, bk, aqk);
    }
    const int j = 32 * nt + l31;
    const float gj = sm[j];
#pragma unroll
    for (int r = 0; r < 16; ++r) {
      const int i = 32 * mt + (r & 3) + 8 * (r >> 2) + 4 * hh;
      const float gi = sm[i], bi = sm[64 + i];
      const float dec = (j <= i) ? __expf(gi - gj) : 0.f;
      Am[i * 64 + j] = (j < i) ? bi * akk[r] * dec : 0.f;
      ATT[i * 64 + j] = f2bf(aqk[r] * dec);
    }
  }
  {
    const int dk = tid >> 1, th = tid & 1;
    u16* kr = KBT + dk * 72 + th * 32;
#pragma unroll
    for (int g2 = 0; g2 < 2; ++g2) {
      u16 ov[16];
#pragma unroll
      for (int x = 0; x < 16; ++x) {
        const int tok = th * 32 + g2 * 16 + x;
        const float kv = bf2f(kr[g2 * 16 + x]);
        ov[perm16(x)] = f2bf(kv * sm[192 + tok]);
        kr[g2 * 16 + x] = f2bf(kv * sm[64 + tok] * sm[128 + tok]);
      }
      uint4 o0, o1;
      o0.x = ov[0] | ((u32)ov[1] << 16); o0.y = ov[2] | ((u32)ov[3] << 16); o0.z = ov[4] | ((u32)ov[5] << 16); o0.w = ov[6] | ((u32)ov[7] << 16);
      o1.x = ov[8] | ((u32)ov[9] << 16); o1.y = ov[10] | ((u32)ov[11] << 16); o1.z = ov[12] | ((u32)ov[13] << 16); o1.w = ov[14] | ((u32)ov[15] << 16);
      *(uint4*)(KDT + dk * 64 + th * 32 + g2 * 16) = o0;
      *(uint4*)(KDT + dk * 64 + th * 32 + g2 * 16 + 8) = o1;
    }
  }
  __syncthreads();
  {
    u16* VBT = QV;
    const int cv = 1024 + h * 128 + 2 * lane;
    float wv[4][2];
#pragma unroll
    for (int j = 0; j < 4; ++j) { wv[j][0] = cw[j * 1536 + cv]; wv[j][1] = cw[j * 1536 + cv + 1]; }
    const int i0 = wave * 16;
    float xv[3][2];
#pragma unroll
    for (int j = 0; j < 3; ++j) {
      int pos = n * 64 + i0 - 3 + j;
      u32 vv = 0;
      if (pos >= 0) vv = *(const u32*)(QKV + (size_t)(tok0 + i0 - 3 + j) * 1536 + cv);
      xv[j][0] = bflo(vv); xv[j][1] = bfhi(vv);
    }
    u32 rv_[16];
#pragma unroll
    for (int ii = 0; ii < 16; ++ii) rv_[ii] = *(const u32*)(QKV + (size_t)(tok0 + i0 + ii) * 1536 + cv);
#pragma unroll
    for (int ii = 0; ii < 16; ++ii) {
      const int i = i0 + ii;
      const u32 vv = rv_[ii];
      float c0 = bflo(vv), c1 = bfhi(vv);
      float y0 = wv[0][0] * xv[0][0] + wv[1][0] * xv[1][0] + wv[2][0] * xv[2][0] + wv[3][0] * c0;
      float y1 = wv[0][1] * xv[0][1] + wv[1][1] * xv[1][1] + wv[2][1] * xv[2][1] + wv[3][1] * c1;
      xv[0][0] = xv[1][0]; xv[0][1] = xv[1][1]; xv[1][0] = xv[2][0]; xv[1][1] = xv[2][1]; xv[2][0] = c0; xv[2][1] = c1;
      const float bi = sm[64 + i];
      VBT[(2 * lane) * 72 + i] = f2bf(siluf_(y0) * bi);
      VBT[(2 * lane + 1) * 72 + i] = f2bf(siluf_(y1) * bi);
    }
  }
  if (wave == 0) {
    float Tc[63];
#pragma unroll
    for (int i = 0; i < 64; ++i) {
      float a = (i == lane) ? 1.f : 0.f;
#pragma unroll
      for (int j = 0; j < i; ++j) a -= Am[i * 64 + j] * Tc[j];
      if (i < 63) Tc[i] = a;
      Tm[i * 72 + lane] = f2bf(a);
      if ((i & 3) == 3) __builtin_amdgcn_sched_barrier(0);
    }
  }
  __syncthreads();
  {
    const u16* VBT = QV;
    f32x16 c0 = zero16(), c1 = zero16(), d0 = zero16(), d1 = zero16();
#pragma unroll
    for (int s = 0; s < 4; ++s) {
      const int kof = 16 * s + 8 * hh;
      bf16x8 t0 = *(const bf16x8*)(Tm + l31 * 72 + kof);
      bf16x8 t1 = *(const bf16x8*)(Tm + (32 + l31) * 72 + kof);
      bf16x8 a = *(const bf16x8*)(KBT + (32 * wave + l31) * 72 + kof);
      bf16x8 bv = *(const bf16x8*)(VBT + (32 * wave + l31) * 72 + kof);
      c0 = MFMA32(a, t0, c0);
      c1 = MFMA32(a, t1, c1);
      d0 = MFMA32(t0, bv, d0);
      d1 = MFMA32(t1, bv, d1);
    }
#pragma unroll
    for (int rg = 0; rg < 4; ++rg) {
      const int dkpos = 16 * (2 * wave + (rg >> 1)) + 8 * hh + 4 * (rg & 1);
      uint2 o;
      o.x = pack2(-c0[4 * rg], -c0[4 * rg + 1]); o.y = pack2(-c0[4 * rg + 2], -c0[4 * rg + 3]);
      *(uint2*)(WNEG + (l31) * 128 + dkpos) = o;
      o.x = pack2(-c1[4 * rg], -c1[4 * rg + 1]); o.y = pack2(-c1[4 * rg + 2], -c1[4 * rg + 3]);
      *(uint2*)(WNEG + (32 + l31) * 128 + dkpos) = o;
      const int dv = 32 * wave + l31;
      o.x = pack2(d0[4 * rg], d0[4 * rg + 1]); o.y = pack2(d0[4 * rg + 2], d0[4 * rg + 3]);
      *(uint2*)(UT + rg * 1024 + dv * 8 + 4 * hh) = o;
      o.x = pack2(d1[4 * rg], d1[4 * rg + 1]); o.y = pack2(d1[4 * rg + 2], d1[4 * rg + 3]);
      *(uint2*)(UT + (4 + rg) * 1024 + dv * 8 + 4 * hh) = o;
    }
    if (tid == 0) ((float*)(ws + OFF_GL))[ch] = sm[128 + 63];
  }
}

#define ATT_UNROLL 8
typedef __bf16 bf2_t __attribute__((ext_vector_type(2)));
DI float fdot2(u32 a, u32 b, float c) { return __builtin_amdgcn_fdot2_f32_bf16(__builtin_bit_cast(bf2_t, a), __builtin_bit_cast(bf2_t, b), c, false); }
DI float dot8(const uint4& k, const u32* q, float acc) {
  acc = fdot2(k.x, q[0], acc);
  acc = fdot2(k.y, q[1], acc);
  acc = fdot2(k.z, q[2], acc);
  acc = fdot2(k.w, q[3], acc);
  return acc;
}

DI void kb2_query(const Params& P, int t, float* Sw, const u16* idxp) {
  const int lane = otid() & 63;
  char* ws = P.ws;
  const int b = t >> 12, pos = t & 4095;
  const int nvalid = pos + 1 < 256 ? pos + 1 : 256;
  const bool uselist = pos >= 255;
  const u16* BKVb = (const u16*)(ws + OFF_BKV) + (size_t)b * 4096 * 256;
  float inv;
  {
    const int l15 = lane & 15, g4 = lane >> 4;
    bf16x8 qf[4];
    {
      const u16* qrow = (const u16*)(ws + OFF_BQ) + (size_t)t * 512;
#pragma unroll
      for (int s = 0; s < 4; ++s) {
        bf16x8 z = {0, 0, 0, 0, 0, 0, 0, 0};
        if (l15 < 8 && (l15 >> 2) == (s >> 1)) z = *(const bf16x8*)(qrow + l15 * 64 + 32 * (s & 1) + 8 * g4);
        qf[s] = z;
      }
    }
    float sum = 0.f;
#pragma unroll 4
    for (int tau = 0; tau < 16; ++tau) {
      const int slotA = 16 * tau + l15;
      int kidx = uselist ? (int)idxp[slotA] : slotA;
      if (slotA >= nvalid) kidx = 0;
      const u16* row = BKVb + (size_t)kidx * 256 + 8 * g4;
      bf16x8 ka[4];
#pragma unroll
      for (int s = 0; s < 4; ++s) ka[s] = *(const bf16x8*)(row + 32 * s);
      f32x4 c = zero4();
      __builtin_amdgcn_s_setprio(1);
#pragma unroll
      for (int s = 0; s < 4; ++s) c = MFMA16(ka[s], qf[s], c);
      __builtin_amdgcn_s_setprio(0);
#pragma unroll
      for (int r = 0; r < 4; ++r) {
        const int slot = 16 * tau + 4 * g4 + r;
        const float pe = (slot < nvalid) ? __expf(c[r]) : 0.f;
        sum += pe;
        if (l15 < 8) Sw[slot * 8 + l15] = pe;
      }
    }
    sum += __shfl_xor(sum, 16); sum += __shfl_xor(sum, 32);
    inv = 1.f / sum;
  }
  const int dc = (lane & 3) | (((lane >> 3) & 1) << 2);
  const int ks = ((lane >> 2) & 1) | ((lane >> 4) << 1);
  float o[8][8];
#pragma unroll
  for (int hd = 0; hd < 8; ++hd)
#pragma unroll
    for (int d = 0; d < 8; ++d) o[hd][d] = 0.f;
#pragma unroll ATT_UNROLL
  for (int it = 0; it < 32; ++it) {
    const int slot = it * 8 + ks;
    int kidx = uselist ? (int)idxp[slot] : slot;
    if (slot >= nvalid) kidx = 0;
    const u16* row = BKVb + (size_t)kidx * 256;
    const uint4 v0 = *(const uint4*)(row + 128 + dc * 8);
    const uint4 v1 = *(const uint4*)(row + 192 + dc * 8);
    const f32x4 pa = *(const f32x4*)(Sw + slot * 8);
    const f32x4 pb = *(const f32x4*)(Sw + slot * 8 + 4);
    float f0[8] = {bflo(v0.x), bfhi(v0.x), bflo(v0.y), bfhi(v0.y), bflo(v0.z), bfhi(v0.z), bflo(v0.w), bfhi(v0.w)};
    float f1[8] = {bflo(v1.x), bfhi(v1.x), bflo(v1.y), bfhi(v1.y), bflo(v1.z), bfhi(v1.z), bflo(v1.w), bfhi(v1.w)};
#pragma unroll
    for (int r = 0; r < 4; ++r) {
#pragma unroll
      for (int d = 0; d < 8; ++d) { o[r][d] += pa[r] * f0[d]; o[4 + r][d] += pb[r] * f1[d]; }
    }
  }
  float o4[4][8];
  {
    const bool up = ks & 4;
#pragma unroll
    for (int i = 0; i < 4; ++i)
#pragma unroll
      for (int d = 0; d < 8; ++d) { float keep = up ? o[4 + i][d] : o[i][d]; float send = up ? o[i][d] : o[4 + i][d]; o4[i][d] = keep + __shfl_xor(send, 32); }
  }
  float o2[2][8];
  {
    const bool up = ks & 2;
#pragma unroll
    for (int i = 0; i < 2; ++i)
#pragma unroll
      for (int d = 0; d < 8; ++d) { float keep = up ? o4[2 + i][d] : o4[i][d]; float send = up ? o4[i][d] : o4[2 + i][d]; o2[i][d] = keep + __shfl_xor(send, 16); }
  }
  float o1[8];
  {
    const bool up = ks & 1;
#pragma unroll
    for (int d = 0; d < 8; ++d) { float keep = up ? o2[1][d] : o2[0][d]; float send = up ? o2[0][d] : o2[1][d]; o1[d] = keep + __shfl_xor(send, 4); }
  }
  const float invh = __shfl(inv, ks);
  const u16* bz = (const u16*)(ws + OFF_BZ) + (size_t)t * 512 + ks * 64 + dc * 8;
  uint4 zz = *(const uint4*)bz;
  float zf[8] = {bflo(zz.x), bfhi(zz.x), bflo(zz.y), bfhi(zz.y), bflo(zz.z), bfhi(zz.z), bflo(zz.w), bfhi(zz.w)};
  uint4 ov;
  ov.x = pack2(o1[0] * invh * siluf_(zf[0]), o1[1] * invh * siluf_(zf[1]));
  ov.y = pack2(o1[2] * invh * siluf_(zf[2]), o1[3] * invh * siluf_(zf[3]));
  ov.z = pack2(o1[4] * invh * siluf_(zf[4]), o1[5] * invh * siluf_(zf[5]));
  ov.w = pack2(o1[6] * invh * siluf_(zf[6]), o1[7] * invh * siluf_(zf[7]));
  *(uint4*)((u16*)(ws + OFF_MIXB) + (size_t)t * 512 + ks * 64 + dc * 8) = ov;
}

DI void kb_item(const Params& P, int item, char* lds) {
  const int tid = otid();
  const int lane = tid & 63, wave = __builtin_amdgcn_readfirstlane(tid >> 6), hh = lane >> 5, l31 = lane & 31;
  const int b = item & 3, qt = 1023 - (item >> 2), t0 = qt * 4;
  char* ws = P.ws;
  float* Sl = (float*)lds;
  u16* myidx = (u16*)(lds + wave * 16384);
  float* mySw = (float*)(lds + wave * 16384 + 1024);
  if (t0 + 3 < 255) {
    __syncthreads();
    kb2_query(P, b * 4096 + t0 + wave, mySw, myidx);
    return;
  }
  const u16* IQ = (const u16*)(ws + OFF_IQ);
  const u16* IK = (const u16*)(ws + OFF_IK);
  const float* SMALL = (const float*)(ws + OFF_SMALL);
  const int T0 = b * 4096 + t0;
  __syncthreads();
  {
    bf16x8 af[8];
    const u16* src = IQ + (size_t)(T0 + ((l31 >> 2) & 1) + 2 * ((l31 >> 4) & 1)) * 1024 + ((l31 & 3) + 4 * ((l31 >> 3) & 1)) * 128 + 8 * hh;
#pragma unroll
    for (int s = 0; s < 8; ++s) af[s] = *(const bf16x8*)(src + 16 * s);
    float wv[16];
#pragma unroll
    for (int r = 0; r < 16; ++r) wv[r] = SMALL[(size_t)(T0 + hh + 2 * (r >> 3)) * 16 + 8 + (r & 3) + 4 * ((r >> 2) & 1)] * 0.03125f;
    const int ntile = (t0 + 4 + 31) >> 5;
    const u16* kbase = IK + (size_t)b * 128 * 4096 + lane * 8;
    const int nmine = ntile > wave ? (ntile - wave + 3) >> 2 : 0;
    bf16x8 c0[8], c1[8];
    {
      const int k0 = wave, k1 = nmine > 1 ? wave + 4 : wave;
      if (nmine > 0) {
#pragma unroll
        for (int s = 0; s < 8; ++s) { c0[s] = *(const bf16x8*)(kbase + (size_t)k0 * 4096 + 512 * s); c1[s] = *(const bf16x8*)(kbase + (size_t)k1 * 4096 + 512 * s); }
      }
    }
    for (int j = 0; j < nmine; j += 2) {
      const int kt0 = wave + 4 * j, kt1 = kt0 + 4;
      const bool has1 = j + 1 < nmine;
      bf16x8 n0[8], n1[8];
      {
        const int ka = j + 2 < nmine ? kt0 + 8 : kt0, kb2 = j + 3 < nmine ? kt0 + 12 : kt0;
#pragma unroll
        for (int s = 0; s < 8; ++s) { n0[s] = *(const bf16x8*)(kbase + (size_t)ka * 4096 + 512 * s); n1[s] = *(const bf16x8*)(kbase + (size_t)kb2 * 4096 + 512 * s); }
      }
      f32x16 acc0 = zero16(), acc1 = zero16();
      __builtin_amdgcn_s_setprio(1);
#pragma unroll
      for (int s = 0; s < 8; ++s) { acc0 = MFMA32(af[s], c0[s], acc0); acc1 = MFMA32(af[s], c1[s], acc1); }
      __builtin_amdgcn_s_setprio(0);
#pragma unroll
      for (int s = 0; s < 8; ++s) { c0[s] = n0[s]; c1[s] = n1[s]; }
      float sa0 = 0.f, sa1 = 0.f, sb0 = 0.f, sb1 = 0.f;
#pragma unroll
      for (int i = 0; i < 8; ++i) {
        sa0 += wv[i] * fmaxf(acc0[i], 0.f); sa1 += wv[8 + i] * fmaxf(acc0[8 + i], 0.f);
        sb0 += wv[i] * fmaxf(acc1[i], 0.f); sb1 += wv[8 + i] * fmaxf(acc1[8 + i], 0.f);
      }
      Sl[hh * 4096 + kt0 * 32 + l31] = sa0;
      Sl[(hh + 2) * 4096 + kt0 * 32 + l31] = sa1;
      if (has1) {
        Sl[hh * 4096 + kt1 * 32 + l31] = sb0;
        Sl[(hh + 2) * 4096 + kt1 * 32 + l31] = sb1;
      }
    }
  }
  __syncthreads();
  const int pos = t0 + wave;
  if (pos >= 255) {
    const int nchunk = (pos >> 10) + 1;
    u32 key[64];
#pragma unroll
    for (int c4 = 0; c4 < 4; ++c4) {
      if (c4 < nchunk) {
#pragma unroll
        for (int ii = 0; ii < 16; ++ii) {
          const int i = c4 * 16 + ii;
          const int idx = lane + 64 * i;
          float v = Sl[wave * 4096 + idx] + 0.0f;
          u32 u = __float_as_uint(v);
          u = (u & 0x80000000u) ? ~u : (u | 0x80000000u);
          key[i] = (idx <= pos) ? u : 0u;
        }
      } else {
#pragma unroll
        for (int ii = 0; ii < 16; ++ii) key[c4 * 16 + ii] = 0u;
      }
    }
    u32 g0 = key[0], g1 = key[1], g2 = key[2], g3 = key[3];
#pragma unroll
    for (int i = 4; i < 64; i += 4) { g0 = max(g0, key[i]); g1 = max(g1, key[i + 1]); g2 = max(g2, key[i + 2]); g3 = max(g3, key[i + 3]); }
    u32 lo = min(min(g0, g1), min(g2, g3)), hi = max(max(g0, g1), max(g2, g3));
#pragma unroll
    for (int d = 1; d < 64; d <<= 1) { lo = min(lo, (u32)__shfl_xor((int)lo, d)); hi = max(hi, (u32)__shfl_xor((int)hi, d)); }
    lo = __builtin_amdgcn_readfirstlane(lo); hi = __builtin_amdgcn_readfirstlane(hi);
    const u32 diff = lo ^ hi;
    const int topbit = diff ? 31 - __builtin_clz(diff) : -1;
    u32 Pv = topbit >= 31 ? 0u : (topbit < 0 ? lo : (lo & ~((2u << topbit) - 1u)));
    bool exact = false;
    for (int bit = topbit; bit >= 0; --bit) {
      const u32 cand = Pv | (1u << bit);
      int c = 0;
#pragma unroll
      for (int c4 = 0; c4 < 4; ++c4) {
        if (c4 < nchunk) {
#pragma unroll
          for (int ii = 0; ii < 16; ++ii) {
            c += __popcll(__ballot(key[c4 * 16 + ii] >= cand));
            if ((ii & 7) == 7) __builtin_amdgcn_sched_barrier(0);
          }
        }
      }
      if (c >= 256) {
        Pv = cand;
        if (c == 256) { exact = true; break; }
      }
    }
    int need = 1 << 30;
    if (!exact) {
      int cgt = 0;
#pragma unroll
      for (int c4 = 0; c4 < 4; ++c4) {
        if (c4 < nchunk) {
#pragma unroll
          for (int ii = 0; ii < 16; ++ii) {
            cgt += __popcll(__ballot(key[c4 * 16 + ii] > Pv));
            if ((ii & 7) == 7) __builtin_amdgcn_sched_barrier(0);
          }
        }
      }
      need = 256 - cgt;
    }
    u16* out = myidx;
    if (exact) {
      u32 mlo = 0u, mhi = 0u;
#pragma unroll
      for (int c4 = 0; c4 < 4; ++c4) {
        if (c4 < nchunk) {
#pragma unroll
          for (int ii = 0; ii < 16; ++ii) {
            const int i = c4 * 16 + ii;
            const u32 bit = (key[i] >= Pv) ? (1u << (i & 31)) : 0u;
            if (i < 32) mlo |= bit; else mhi |= bit;
          }
        }
      }
      const int cnt = __popc(mlo) + __popc(mhi);
      int incl = cnt;
#pragma unroll
      for (int d = 1; d < 64; d <<= 1) { const int tv = __shfl_up(incl, d); if (lane >= d) incl += tv; }
      int off = incl - cnt;
      while (mlo) { const int i = __ffs((int)mlo) - 1; out[off++] = (u16)(lane + 64 * i); mlo &= mlo - 1u; }
      while (mhi) { const int i = __ffs((int)mhi) - 1; out[off++] = (u16)(lane + 64 * (32 + i)); mhi &= mhi - 1u; }
    } else {
    int off = 0, eqseen = 0;
    const u64 ltmask = (1ull << lane) - 1ull;
#pragma unroll
    for (int c4 = 0; c4 < 4; ++c4) {
      if (c4 < nchunk) {
#pragma unroll
        for (int ii = 0; ii < 16; ++ii) {
          const int i = c4 * 16 + ii;
          const bool gt = key[i] > Pv, eq = key[i] == Pv;
          const u64 meq = __ballot(eq);
          const int rank = eqseen + __popcll(meq & ltmask);
          const bool sel = gt || (eq && rank < need);
          const u64 ms = __ballot(sel);
          if (sel) out[off + __popcll(ms & ltmask)] = (u16)(lane + 64 * i);
          off += __popcll(ms);
          eqseen += __popcll(meq);
          if ((ii & 3) == 3) __builtin_amdgcn_sched_barrier(0);
        }
      }
    }
    }
  }
  kb2_query(P, T0 + wave, mySw, myidx);
}

constexpr int KB_SPLIT = 1792;
DI int pull_item(unsigned* ctr, char* lds) {
  volatile LAS unsigned* slot = (volatile LAS unsigned*)(lds + LDS_BYTES - 8);
  __syncthreads();
  if (threadIdx.x == 0) *slot = __hip_atomic_fetch_add(ctr, 1u, __ATOMIC_RELAXED, __HIP_MEMORY_SCOPE_AGENT);
  __syncthreads();
  return (int)*slot;
}
DI void phase2(const Params& P, char* lds) {
  for (int it = blockIdx.x; it < 1024; it += gridDim.x) ka1_item(P, it, lds);
  if ((gridDim.x & 3) == 0) {
    const int bb = blockIdx.x & 3;
    unsigned* ctr = (unsigned*)(P.ws + OFF_BAR) + 16 * bb;
    for (;;) {
      const int k = pull_item(ctr, lds);
      if (k >= KB_SPLIT / 4) break;
      kb_item(P, 4 * k + bb, lds);
    }
  } else {
    for (int it = blockIdx.x; it < KB_SPLIT; it += gridDim.x) kb_item(P, it, lds);
  }
}

DI void ka2_scan(const Params& P, int bh, char* lds) {
  const int tid = otid(), lane = tid & 63, wave = tid >> 6, hh = lane >> 5, l31 = lane & 31;
  char* ws = P.ws;
  const int dv = 32 * wave + l31;
  const u16* WNEG = (const u16*)(ws + OFF_WNEG) + (size_t)bh * 64 * 8192;
  const u16* KDT = (const u16*)(ws + OFF_KDT) + (size_t)bh * 64 * 8192;
  const u16* UT = (const u16*)(ws + OFF_UT) + (size_t)bh * 64 * 8192 + dv * 8 + 4 * hh;
  const float* GL = (const float*)(ws + OFF_GL) + bh * 64;
  u16* HST = (u16*)((char*)P.out + OOFF_HST) + (size_t)bh * 64 * 16384 + dv * 8 + 4 * hh;
  u16* VNT = (u16*)((char*)P.out + OOFF_VNT) + (size_t)bh * 64 * 8192 + dv * 8 + 4 * hh;
  const int wbase = (tid >> 4) * 272 + ((tid & 15) << 4);
  const int kbase = 17408 + (tid >> 3) * 144 + ((tid & 7) << 4);
  u32x4 sw[4], sk[4];
  uint2 un[8];
  float gln;
  __syncthreads();
#pragma unroll
  for (int i = 0; i < 4; ++i) {
    sw[i] = *(const u32x4*)(WNEG + (size_t)(tid + 256 * i) * 8);
    sk[i] = *(const u32x4*)(KDT + (size_t)(tid + 256 * i) * 8);
  }
#pragma unroll
  for (int i = 0; i < 8; ++i) un[i] = *(const uint2*)(UT + i * 1024);
  gln = GL[0];
#pragma unroll
  for (int i = 0; i < 4; ++i) { *(u32x4*)(lds + wbase + i * 4352) = sw[i]; *(u32x4*)(lds + kbase + i * 4608) = sk[i]; }
  __syncthreads();
  f32x16 S[4];
#pragma unroll
  for (int m = 0; m < 4; ++m) S[m] = zero16();
  for (int n = 0; n < 64; ++n) {
    const char* buf = lds + (n & 1) * 35840;
    char* nbuf = lds + ((n + 1) & 1) * 35840;
    f32x16 vn[2];
#pragma unroll
    for (int tt = 0; tt < 2; ++tt) {
#pragma unroll
      for (int rg = 0; rg < 4; ++rg) {
        const uint2 u = un[4 * tt + rg];
        vn[tt][4 * rg] = bflo(u.x); vn[tt][4 * rg + 1] = bfhi(u.x); vn[tt][4 * rg + 2] = bflo(u.y); vn[tt][4 * rg + 3] = bfhi(u.y);
      }
    }
    const float gl = gln;
    if (n + 1 < 64) {
      const size_t o = (size_t)(n + 1) * 8192;
#pragma unroll
      for (int i = 0; i < 4; ++i) {
        sw[i] = *(const u32x4*)(WNEG + o + (size_t)(tid + 256 * i) * 8);
        sk[i] = *(const u32x4*)(KDT + o + (size_t)(tid + 256 * i) * 8);
      }
#pragma unroll
      for (int i = 0; i < 8; ++i) un[i] = *(const uint2*)(UT + o + i * 1024);
      gln = GL[n + 1];
    }
    u16* hst = HST + (size_t)n * 16384;
    u16* vnt = VNT + (size_t)n * 8192;
#pragma unroll
    for (int m = 0; m < 4; ++m) {
      u32 pk[8];
#pragma unroll
      for (int r = 0; r < 8; ++r) pk[r] = pack2(S[m][2 * r], S[m][2 * r + 1]);
#pragma unroll
      for (int rg = 0; rg < 4; ++rg) *(uint2*)(hst + (4 * m + rg) * 1024) = make_uint2(pk[2 * rg], pk[2 * rg + 1]);
      u32x4 f0 = {pk[0], pk[1], pk[2], pk[3]}, f1 = {pk[4], pk[5], pk[6], pk[7]};
      const bf16x8 sf0 = __builtin_bit_cast(bf16x8, f0), sf1 = __builtin_bit_cast(bf16x8, f1);
#pragma unroll
      for (int tt = 0; tt < 2; ++tt) {
        bf16x8 a0 = *(const bf16x8*)(buf + (l31 * 272 + 16 * hh) + (tt * 8704 + 32 * (2 * m)));
        bf16x8 a1 = *(const bf16x8*)(buf + (l31 * 272 + 16 * hh) + (tt * 8704 + 32 * (2 * m + 1)));
        vn[tt] = MFMA32(a0, sf0, vn[tt]);
        vn[tt] = MFMA32(a1, sf1, vn[tt]);
      }
      __builtin_amdgcn_sched_barrier(0);
    }
    bf16x8 vf[4];
#pragma unroll
    for (int tt = 0; tt < 2; ++tt) {
      u32 pk[8];
#pragma unroll
      for (int r = 0; r < 8; ++r) pk[r] = pack2(vn[tt][2 * r], vn[tt][2 * r + 1]);
#pragma unroll
      for (int rg = 0; rg < 4; ++rg) *(uint2*)(vnt + (4 * tt + rg) * 1024) = make_uint2(pk[2 * rg], pk[2 * rg + 1]);
      u32x4 f0 = {pk[0], pk[1], pk[2], pk[3]}, f1 = {pk[4], pk[5], pk[6], pk[7]};
      vf[2 * tt] = __builtin_bit_cast(bf16x8, f0);
      vf[2 * tt + 1] = __builtin_bit_cast(bf16x8, f1);
    }
#pragma unroll
    for (int m = 0; m < 4; ++m) {
#pragma unroll
      for (int r = 0; r < 16; ++r) S[m][r] *= gl;
    }
#pragma unroll
    for (int ks = 0; ks < 4; ++ks) {
#pragma unroll
      for (int m = 0; m < 4; ++m) {
        bf16x8 a = *(const bf16x8*)(buf + 17408 + (l31 * 144 + 16 * hh) + (m * 4608 + 32 * ks));
        S[m] = MFMA32(a, vf[ks], S[m]);
      }
      __builtin_amdgcn_sched_barrier(0);
    }
    if (n + 1 < 64) {
#pragma unroll
      for (int i = 0; i < 4; ++i) { *(u32x4*)(nbuf + wbase + i * 4352) = sw[i]; *(u32x4*)(nbuf + kbase + i * 4608) = sk[i]; }
    }
    __syncthreads();
  }
}

DI void phase3(const Params& P, char* lds) {
  const int G = gridDim.x;
  const int nscan = G > 32 ? 16 : 0;
  int first = KB_SPLIT + (int)blockIdx.x - nscan, stride = G - nscan;
  if ((int)blockIdx.x < 16 || nscan == 0) {
    for (int bh = blockIdx.x; bh < 16; bh += G) ka2_scan(P, bh, lds);
    if (nscan) first = 4096;
  }
  if (nscan && (G & 3) == 0) {
    if ((int)blockIdx.x >= 16) {
      const int bb = blockIdx.x & 3;
      unsigned* ctr = (unsigned*)(P.ws + OFF_BAR) + 64 + 16 * bb;
      for (;;) {
        const int k = KB_SPLIT / 4 + pull_item(ctr, lds);
        if (k >= 1024) break;
        kb_item(P, 4 * k + bb, lds);
      }
    }
  } else {
    for (int it = first; it < 4096; it += stride) kb_item(P, it, lds);
  }
}

DI void phase4(const Params& P, char* lds) {
  const int tid4 = otid(), lane = tid4 & 63, wave = tid4 >> 6, l15 = lane & 15, g4 = lane >> 4;
  char* ws = P.ws;
  float nw[8];
#pragma unroll
  for (int nt = 0; nt < 8; ++nt) nw[nt] = P.a_out_norm_w[16 * nt + l15];
  for (int ch = blockIdx.x; ch < 1024; ch += gridDim.x) {
    const int b = ch >> 8, h = (ch >> 6) & 3, n = ch & 63;
    const int tok0 = b * 4096 + n * 64;
    const u16* QD = (const u16*)(ws + OFF_QD) + (size_t)ch * 8192;
    const u16* ATT = (const u16*)(ws + OFF_ATT) + (size_t)ch * 4096;
    const u16* HST = (const u16*)((const char*)P.out + OOFF_HST) + (size_t)ch * 16384;
    const u16* VNT = (const u16*)((const char*)P.out + OOFF_VNT) + (size_t)ch * 8192;
    __syncthreads();
    {
      u32x4 st[12];
#pragma unroll
      for (int i = 0; i < 8; ++i) st[i] = *(const u32x4*)(HST + (size_t)(tid4 + 256 * i) * 8);
#pragma unroll
      for (int i = 0; i < 4; ++i) st[8 + i] = *(const u32x4*)(VNT + (size_t)(tid4 + 256 * i) * 8);
#pragma unroll
      for (int i = 0; i < 8; ++i) *(u32x4*)(lds + (tid4 + 256 * i) * 16) = st[i];
#pragma unroll
      for (int i = 0; i < 4; ++i) *(u32x4*)(lds + 32768 + (tid4 + 256 * i) * 16) = st[8 + i];
    }
    __syncthreads();
    const u16* HSl = (const u16*)lds;
    const u16* VNl = (const u16*)(lds + 32768);
    f32x4 acc[8];
#pragma unroll
    for (int nt = 0; nt < 8; ++nt) acc[nt] = zero4();
#pragma unroll
    for (int ks = 0; ks < 4; ++ks) {
      bf16x8 a = *(const bf16x8*)(QD + (16 * wave + l15) * 128 + 32 * ks + 8 * g4);
#pragma unroll
      for (int nt = 0; nt < 8; ++nt) {
        bf16x8 bb = *(const bf16x8*)(HSl + (4 * ks + g4) * 1024 + (16 * nt + l15) * 8);
        acc[nt] = MFMA16(a, bb, acc[nt]);
      }
    }
#pragma unroll
    for (int ks = 0; ks < 2; ++ks) {
      bf16x8 a = *(const bf16x8*)(ATT + (16 * wave + l15) * 64 + 32 * ks + 8 * g4);
#pragma unroll
      for (int nt = 0; nt < 8; ++nt) {
        bf16x8 bb = *(const bf16x8*)(VNl + (4 * ks + g4) * 1024 + (16 * nt + l15) * 8);
        acc[nt] = MFMA16(a, bb, acc[nt]);
      }
    }
    float zg[4][8];
#pragma unroll
    for (int r = 0; r < 4; ++r) {
      const u16* az = (const u16*)(ws + OFF_AZ) + (size_t)(tok0 + 16 * wave + 4 * g4 + r) * 512 + h * 128;
#pragma unroll
      for (int nt = 0; nt < 8; ++nt) zg[r][nt] = bf2f(az[16 * nt + l15]);
    }
#pragma unroll
    for (int r = 0; r < 4; ++r) {
      float ss = 0.f;
#pragma unroll
      for (int nt = 0; nt < 8; ++nt) ss += acc[nt][r] * acc[nt][r];
      ss += __shfl_xor(ss, 1); ss += __shfl_xor(ss, 2); ss += __shfl_xor(ss, 4); ss += __shfl_xor(ss, 8);
      const float rs = rsqrtf(ss * (1.f / 128.f) + EPS);
      const int t = tok0 + 16 * wave + 4 * g4 + r;
      u16* mix = (u16*)(ws + OFF_MIXA) + (size_t)t * 512 + h * 128;
#pragma unroll
      for (int nt = 0; nt < 8; ++nt) {
        const int dv = 16 * nt + l15;
        mix[dv] = f2bf(acc[nt][r] * rs * nw[nt] * siluf_(zg[r][nt]));
      }
    }
  }
}

DI void phase5(const Params& P, char* lds) {
  char* ws = P.ws;
  const u16* MIXA = (const u16*)(ws + OFF_MIXA);
  const u16* MIXB = (const u16*)(ws + OFF_MIXB);
  const u16* WT = (const u16*)(ws + OFF_WT_OUT);
  float* X1 = (float*)(ws + OFF_X1);
  u16* X1B = (u16*)(ws + OFF_X1B);
  float* SS = (float*)(ws + OFF_SUMSQ);
  const int lane = otid() & 63, wave = otid() >> 6;
  const int wm = wave & 1, wn = wave >> 1, l31 = lane & 31, hh = lane >> 5;
  const bool xswz = (gridDim.x & 7) == 0;
  const int xq = blockIdx.x >> 3, xn = gridDim.x >> 3, xx = blockIdx.x & 7;
  for (int tile = xswz ? xq : (int)blockIdx.x; tile < (xswz ? 64 : 512); tile += (xswz ? xn : (int)gridDim.x)) {
    const int mt = xswz ? 8 * xx + (tile & 7) : (tile >> 3), nt = xswz ? (tile >> 3) : (tile & 7);
    f32x16 acc[4][2];
#pragma unroll
    for (int i = 0; i < 4; ++i)
#pragma unroll
      for (int j = 0; j < 2; ++j) acc[i][j] = zero16();
    gemm_mainloop<4>(MIXA, 512, WT, 1024, 512, mt * 256, nt * 128, lds, acc);
    gemm_mainloop<4>(MIXB, 512, WT + 512, 1024, 512, mt * 256, nt * 128, lds, acc);
    {
      const size_t e0 = (size_t)(mt * 256 + wm * 128 + 4 * hh) * 1024 + nt * 128 + wn * 64 + l31;
      float* ssp0 = SS + (mt * 256 + wm * 128 + 4 * hh);
#pragma unroll
      for (int i = 0; i < 4; ++i) {
        float xa[16], xb[16];
        {
          const float* xp = P.x + e0 + (size_t)i * 32 * 1024;
#pragma unroll
          for (int r = 0; r < 16; ++r) {
            xa[r] = xp[0]; xb[r] = xp[32];
            xp += (((r & 3) == 3) ? 5 : 1) * 1024;
            asm volatile("" : "+v"(xp));
          }
        }
        float* x1p = X1 + e0 + (size_t)i * 32 * 1024;
        u16* x1bp = X1B + e0 + (size_t)i * 32 * 1024;
        float* ssp = ssp0 + i * 32;
#pragma unroll
        for (int r = 0; r < 16; ++r) {
          const float va = xa[r] + acc[i][0][r], vb = xb[r] + acc[i][1][r];
          x1p[0] = va; x1p[32] = vb;
          x1bp[0] = f2bf(va); x1bp[32] = f2bf(vb);
          float ss = va * va + vb * vb;
          ss += dpp_xor1(ss); ss += dpp_xor2(ss); ss += __shfl_xor(ss, 4); ss += dpp_xor8(ss); ss += __shfl_xor(ss, 16);
          if (l31 == 0) atomicAdd(ssp, ss);
          const int step = ((r & 3) == 3) ? 5 : 1;
          x1p += step * 1024; x1bp += step * 1024; ssp += step;
          asm volatile("" : "+v"(x1p), "+v"(x1bp), "+v"(ssp));
        }
      }
    }
  }
}

DI void phase6(const Params& P, char* lds) {
  char* ws = P.ws;
  const u16* X1B = (const u16*)(ws + OFF_X1B);
  const float* X1 = (const float*)(ws + OFF_X1);
  const u16* WG = (const u16*)(ws + OFF_WT_GATE);
  const u16* WP = (const u16*)(ws + OFF_WT_PLE);
  const u16* PB = (const u16*)(ws + OFF_PB);
  const float* SS = (const float*)(ws + OFF_SUMSQ);
  const int lane = otid() & 63, wave = otid() >> 6;
  const int wm = wave & 1, wn = wave >> 1, l31 = lane & 31, hh = lane >> 5;
  const bool xswz = (gridDim.x & 7) == 0;
  const int xq = blockIdx.x >> 3, xn = gridDim.x >> 3, xx = blockIdx.x & 7;
  for (int tile = xswz ? xq : (int)blockIdx.x; tile < (xswz ? 128 : 1024); tile += (xswz ? xn : (int)gridDim.x)) {
    const int mt = xswz ? 16 * xx + (tile & 15) : (tile >> 3), nt = xswz ? (tile >> 4) : (tile & 7);
    f32x16 ag[2][2], ap[2][2];
#pragma unroll
    for (int i = 0; i < 2; ++i)
#pragma unroll
      for (int j = 0; j < 2; ++j) { ag[i][j] = zero16(); ap[i][j] = zero16(); }
    gemm_mainloop<2>(X1B, 1024, WG, 1024, 1024, mt * 128, nt * 128, lds, ag);
    gemm_mainloop<2>(PB, 256, WP, 256, 256, mt * 128, nt * 128, lds, ap);
    const size_t e0 = (size_t)(mt * 128 + wm * 64 + 4 * hh) * 1024 + nt * 128 + wn * 64 + l31;
    const float b0 = P.b_ple_gate[nt * 128 + wn * 64 + l31], b1 = P.b_ple_gate[nt * 128 + wn * 64 + 32 + l31];
    const float* ssp0 = SS + (mt * 128 + wm * 64 + 4 * hh);
#pragma unroll
    for (int i = 0; i < 2; ++i) {
      float rsv[16], xa[16], xb[16];
#pragma unroll
      for (int r = 0; r < 16; ++r) rsv[r] = ssp0[i * 32 + (r & 3) + 8 * (r >> 2)];
      {
        const float* x1p = X1 + e0 + (size_t)i * 32 * 1024;
#pragma unroll
        for (int r = 0; r < 16; ++r) {
          xa[r] = x1p[0]; xb[r] = x1p[32];
          x1p += (((r & 3) == 3) ? 5 : 1) * 1024;
          asm volatile("" : "+v"(x1p));
        }
      }
      float* op = P.out + e0 + (size_t)i * 32 * 1024;
#pragma unroll
      for (int r = 0; r < 16; ++r) {
        const float rs = rsqrtf(rsv[r] * (1.f / 1024.f) + EPS);
        op[0] = xa[r] + ap[i][0][r] * sigmoidf_(rs * ag[i][0][r] + b0);
        op[32] = xb[r] + ap[i][1][r] * sigmoidf_(rs * ag[i][1][r] + b1);
        op += (((r & 3) == 3) ? 5 : 1) * 1024;
        asm volatile("" : "+v"(op));
      }
    }
  }
}

template <int PH>
DI void run_phase(const Params& P, char* lds) {
  if (PH == 0) phase0(P);
  else if (PH == 1) phase1(P, lds);
  else if (PH == 2) phase2(P, lds);
  else if (PH == 3) phase3(P, lds);
  else if (PH == 4) phase4(P, lds);
  else if (PH == 5) phase5(P, lds);
  else phase6(P, lds);
}

template <int PH>
__global__ void __launch_bounds__(256, 2) phase_kernel(Params P) {
  __shared__ __attribute__((aligned(16))) char lds[LDS_BYTES];
  run_phase<PH>(P, lds);
}

__global__ void __launch_bounds__(256, 2) mega(Params P) {
  __shared__ __attribute__((aligned(16))) char lds[LDS_BYTES];
  volatile LAS unsigned* st = (volatile LAS unsigned*)(lds + LDS_BYTES - 16);
  if (threadIdx.x == 0) { st[0] = 0u; st[1] = 0u; }
  __syncthreads();
  if (P.ws == nullptr) cg::this_grid().sync();
  XcdBarrier xb = xcd_barrier_post((unsigned*)(P.ws + OFF_BAR), st);
  run_phase<0>(P, lds); xcd_barrier(xb);
  run_phase<1>(P, lds); xcd_barrier(xb);
  run_phase<2>(P, lds); xcd_barrier(xb);
  run_phase<3>(P, lds); xcd_barrier(xb);
  run_phase<4>(P, lds); xcd_barrier(xb);
  run_phase<5>(P, lds); xcd_barrier(xb);
  run_phase<6>(P, lds);
}

extern "C" void kernel_launch(void* const* d_in, const int* in_sizes, int n_in, void* d_out, int out_size, void* d_ws,
                              size_t ws_size, hipStream_t stream) {
  Params P{};
  P.x = (const float*)d_in[0]; P.p = (const float*)d_in[1]; P.attn_norm_w = (const float*)d_in[2];
  P.w_in = (const float*)d_in[3]; P.conv_w = (const float*)d_in[4]; P.a_log = (const float*)d_in[5];
  P.dt_bias = (const float*)d_in[6]; P.a_out_norm_w = (const float*)d_in[7]; P.b_q_norm_w = (const float*)d_in[8];
  P.b_k_norm_w = (const float*)d_in[9]; P.w_out = (const float*)d_in[10]; P.w_ple = (const float*)d_in[11];
  P.ple_gate_norm_w = (const float*)d_in[12]; P.w_ple_gate = (const float*)d_in[13]; P.b_ple_gate = (const float*)d_in[14];
  P.out = (float*)d_out; P.ws = (char*)d_ws;
  static int grid_blocks = 0;
  if (!grid_blocks) {
    int dev = 0, cus = 0, per_cu = 0;
    (void)hipGetDevice(&dev);
    (void)hipDeviceGetAttribute(&cus, hipDeviceAttributeMultiprocessorCount, dev);
    (void)hipOccupancyMaxActiveBlocksPerMultiprocessor(&per_cu, mega, 256, 0);
    if (per_cu > 2) per_cu = 2;
    if (per_cu < 1) per_cu = 1;
    grid_blocks = cus * per_cu;
  }
#ifdef MULTI_LAUNCH
  hipLaunchKernelGGL(phase_kernel<0>, dim3(grid_blocks), dim3(256), 0, stream, P);
  hipLaunchKernelGGL(phase_kernel<1>, dim3(grid_blocks), dim3(256), 0, stream, P);
  hipLaunchKernelGGL(phase_kernel<2>, dim3(grid_blocks), dim3(256), 0, stream, P);
  hipLaunchKernelGGL(phase_kernel<3>, dim3(grid_blocks), dim3(256), 0, stream, P);
  hipLaunchKernelGGL(phase_kernel<4>, dim3(grid_blocks), dim3(256), 0, stream, P);
  hipLaunchKernelGGL(phase_kernel<5>, dim3(grid_blocks), dim3(256), 0, stream, P);
  hipLaunchKernelGGL(phase_kernel<6>, dim3(grid_blocks), dim3(256), 0, stream, P);
#else
  (void)hipMemsetAsync((char*)d_ws + OFF_BAR, 0, XCD_BAR_WORDS * 4, stream);
  void* args[] = {&P};
  hipError_t e = hipLaunchCooperativeKernel((void*)mega, dim3(grid_blocks), dim3(256), args, 0, stream);
  if (e != hipSuccess) fprintf(stderr, "cooperative launch failed: %s (grid %d)\n", hipGetErrorString(e), grid_blocks);
#endif
}
```
